# Optimizing an MI355X kernel written in HIP

```python
import jax, jax.numpy as jnp
from jax import lax
import numpy as np

D_MODEL = 2048
BATCH = 1
SEQ = 8192
DEPTH = 1
DEC_BATCH = 128
DEC_SEQ = 1
PAST_LEN = 2048
PAGE_SIZE = 128

N_META = 16
ATTN_WIDTH = D_MODEL // 2
POOL_WIDTH = D_MODEL - ATTN_WIDTH
HEAD_DIM = 128
N_HEADS = ATTN_WIDTH // HEAD_DIM
N_KV_HEADS = 2
N_IDX_HEADS = 16
IDX_DIM = 64
TOPK_MAX = 256
POOL_WINDOWS = (2, 4, 8, 16)
N_POOL_GROUPS = len(POOL_WINDOWS)
POOL_GROUP_WIDTH = POOL_WIDTH // N_POOL_GROUPS
POOL_HIST = max(POOL_WINDOWS) - 1
D_FF = 4 * D_MODEL
ROPE_THETA = 10000.0
EPS = 1e-6
Q_BLOCK = 128
NEG = -1e30
SPLIT_SIZES = (N_HEADS * HEAD_DIM, N_KV_HEADS * HEAD_DIM, N_KV_HEADS * HEAD_DIM,
               N_IDX_HEADS * IDX_DIM, IDX_DIM, N_IDX_HEADS, POOL_WIDTH)
IN_WIDTH = sum(SPLIT_SIZES)

kernel_name = "hymba_dsa_pool_decode_step"


def rmsnorm(x, g):
    xf = x.astype(jnp.float32)
    y = xf * lax.rsqrt(jnp.mean(xf * xf, axis=-1, keepdims=True) + EPS)
    return (y * g.astype(jnp.float32)).astype(x.dtype)


def rope(x, pos):
    d = x.shape[-1]
    inv = ROPE_THETA ** (-jnp.arange(0, d, 2, dtype=jnp.float32) / d)
    ang = pos.astype(jnp.float32)[:, None] * inv[None, :]
    cos = jnp.cos(ang)[:, None, :]
    sin = jnp.sin(ang)[:, None, :]
    xf = x.astype(jnp.float32)
    x1, x2 = xf[..., : d // 2], xf[..., d // 2:]
    return jnp.concatenate([x1 * cos - x2 * sin, x1 * sin + x2 * cos], axis=-1).astype(x.dtype)


def mixer_inputs(x, pos, g_mix, w_in):
    b, t, _ = x.shape
    z = rmsnorm(x, g_mix) @ w_in
    idx = [int(v) for v in np.cumsum(SPLIT_SIZES)[:-1]]
    q, k, v, qi, ki, wi, u = jnp.split(z, idx, axis=-1)
    q = rope(q.reshape(b, t, N_HEADS, HEAD_DIM), pos)
    k = rope(k.reshape(b, t, N_KV_HEADS, HEAD_DIM), pos)
    v = v.reshape(b, t, N_KV_HEADS, HEAD_DIM)
    qi = rope(qi.reshape(b, t, N_IDX_HEADS, IDX_DIM), pos)
    ki = rope(ki[:, :, None, :], pos)[:, :, 0, :]
    wi = wi * (N_IDX_HEADS ** -0.5)
    return q, k, v, qi, ki, wi, u


def indexer_scores(q_idx, w_idx, k_idx, q_pos, k_pos):
    dots = jnp.einsum('bthd,bsd->bths', q_idx.astype(jnp.float32), k_idx.astype(jnp.float32))
    s = jnp.einsum('bths,bth->bts', jax.nn.relu(dots) * (IDX_DIM ** -0.5), w_idx.astype(jnp.float32))
    causal = k_pos[None, :] <= q_pos[:, None]
    return jnp.where(causal[None], s, NEG)


def sparse_attend(q, k_sel, v_sel, valid):
    b, t = q.shape[:2]
    qg = q.reshape(b, t, N_KV_HEADS, N_HEADS // N_KV_HEADS, HEAD_DIM).astype(jnp.float32)
    sc = jnp.einsum('btngd,btsnd->btngs', qg, k_sel.astype(jnp.float32)) * (HEAD_DIM ** -0.5)
    sc = jnp.where(valid[:, :, None, None, :], sc, NEG)
    p = jax.nn.softmax(sc, axis=-1)
    o = jnp.einsum('btngs,btsnd->btngd', p, v_sel.astype(jnp.float32))
    return o.reshape(b, t, ATTN_WIDTH).astype(q.dtype)


def gather_rows(a, idx):
    return jax.vmap(lambda ab, ib: ab[ib])(a, idx)


def prompt_attention(q, k, v, q_idx, w_idx, k_idx):
    b, t_len = q.shape[:2]
    n_blk = -(-t_len // Q_BLOCK)
    t_pad = n_blk * Q_BLOCK
    pad = t_pad - t_len
    padt = lambda a: jnp.pad(a, [(0, 0), (0, pad)] + [(0, 0)] * (a.ndim - 2))
    q, k, v, q_idx, w_idx, k_idx = (padt(a) for a in (q, k, v, q_idx, w_idx, k_idx))
    pos_pad = jnp.arange(t_pad, dtype=jnp.int32)
    top_k = min(TOPK_MAX, t_len // 4)

    def to_blocks(a):
        return jnp.moveaxis(a.reshape((b, n_blk, Q_BLOCK) + a.shape[2:]), 1, 0)

    def block(args):
        qb, qib, wb, pb = args
        sc = indexer_scores(qib, wb, k_idx, pb, pos_pad)
        sel = lax.top_k(sc, top_k)[1]
        valid = sel <= pb[None, :, None]
        return sparse_attend(qb, gather_rows(k, sel), gather_rows(v, sel), valid)

    out = lax.map(block, (to_blocks(q), to_blocks(q_idx), to_blocks(w_idx), pos_pad.reshape(n_blk, Q_BLOCK)))
    return jnp.moveaxis(out, 0, 1).reshape(b, t_pad, ATTN_WIDTH)[:, :t_len]


def sample_attention(q, k_new, v_new, q_idx, w_idx, kidx_new, pos, cache_k, cache_v, cache_kidx, page_table):
    db, s_len = q.shape[:2]
    past = page_table.shape[1] * PAGE_SIZE
    L = past + s_len
    kidx_past = cache_kidx[page_table].reshape(db, past, IDX_DIM)
    kidx_all = jnp.concatenate([kidx_past, kidx_new.astype(kidx_past.dtype)], axis=1)
    sc = indexer_scores(q_idx, w_idx, kidx_all, pos, jnp.arange(L, dtype=jnp.int32))
    sel = lax.top_k(sc, min(TOPK_MAX, L // 4))[1]
    valid = sel <= pos[None, :, None]
    in_past = sel < past
    sel_p = jnp.minimum(sel, past - 1)
    phys = jnp.take_along_axis(page_table, (sel_p // PAGE_SIZE).reshape(db, -1), axis=1).reshape(sel.shape)
    off = sel_p % PAGE_SIZE
    sel_n = jnp.clip(sel - past, 0, s_len - 1)

    def pick(cache, new):
        from_past = cache[phys, off]
        from_new = gather_rows(new, sel_n).astype(from_past.dtype)
        return jnp.where(in_past[..., None, None], from_past, from_new)

    return sparse_attend(q, pick(cache_k, k_new), pick(cache_v, v_new), valid)


def pool_mixer(u_ext, pos, w_pool, pool_scale):
    b = u_ext.shape[0]
    t = pos.shape[0]
    uf = u_ext.astype(jnp.float32)
    cs = jnp.concatenate([jnp.zeros((b, 1, POOL_WIDTH), jnp.float32), jnp.cumsum(uf, axis=1)], axis=1)
    end = cs[:, POOL_HIST + 1:]
    cur = uf[:, POOL_HIST:]
    outs = []
    for g, w in enumerate(POOL_WINDOWS):
        sl = slice(g * POOL_GROUP_WIDTH, (g + 1) * POOL_GROUP_WIDTH)
        start = cs[:, POOL_HIST + 1 - w: POOL_HIST + 1 - w + t, sl]
        cnt = jnp.minimum(w, pos + 1).astype(jnp.float32)[None, :, None]
        outs.append((end[..., sl] - start) / cnt - cur[..., sl])
    d = jnp.stack(outs, axis=2)
    y = jnp.einsum('btgc,gcd->btgd', d, w_pool.astype(jnp.float32)).reshape(b, t, POOL_WIDTH)
    return (y * pool_scale.astype(jnp.float32)).astype(u_ext.dtype)


def squared_relu_mlp(h, g_mlp, w_up, w_down):
    a = jax.nn.relu(rmsnorm(h, g_mlp) @ w_up)
    return (a * a) @ w_down


def setup_inputs(seed: int = 0) -> dict:
    key = jax.random.key(seed)
    ks = jax.random.split(key, 17)
    n_pages = PAST_LEN // PAGE_SIZE
    n_used = DEC_BATCH * n_pages
    n_phys = n_used + max(1, n_used // 4)
    nrm = lambda k, shape, scale=1.0: jax.random.normal(k, shape, jnp.float32) * scale
    perm = jax.random.permutation(ks[0], n_phys)
    page_table = perm[:n_used].reshape(DEC_BATCH, n_pages).astype(jnp.int32)
    return {
        "x_prompt": nrm(ks[1], (BATCH, SEQ, D_MODEL)),
        "x_sample": nrm(ks[2], (DEC_BATCH, DEC_SEQ, D_MODEL)),
        "cache_k": nrm(ks[3], (DEPTH, n_phys, PAGE_SIZE, N_KV_HEADS, HEAD_DIM)),
        "cache_v": nrm(ks[4], (DEPTH, n_phys, PAGE_SIZE, N_KV_HEADS, HEAD_DIM)),
        "cache_kidx": nrm(ks[5], (DEPTH, n_phys, PAGE_SIZE, IDX_DIM)),
        "state_pool": nrm(ks[6], (DEPTH, DEC_BATCH, POOL_HIST, POOL_WIDTH)),
        "page_table": page_table,
        "meta_tokens": nrm(ks[7], (N_META, D_MODEL)),
        "g_mix": 1.0 + nrm(ks[8], (DEPTH, D_MODEL), 0.02),
        "w_in": nrm(ks[9], (DEPTH, D_MODEL, IN_WIDTH), D_MODEL ** -0.5),
        "w_pool": nrm(ks[10], (DEPTH, N_POOL_GROUPS, POOL_GROUP_WIDTH, POOL_GROUP_WIDTH), POOL_GROUP_WIDTH ** -0.5),
        "pool_scale": 1.0 + nrm(ks[11], (DEPTH, POOL_WIDTH), 0.1),
        "w_out": nrm(ks[12], (DEPTH, D_MODEL, D_MODEL), D_MODEL ** -0.5),
        "g_mlp": 1.0 + nrm(ks[13], (DEPTH, D_MODEL), 0.02),
        "w_up": nrm(ks[14], (DEPTH, D_MODEL, D_FF), D_MODEL ** -0.5),
        "w_down": nrm(ks[15], (DEPTH, D_FF, D_MODEL), D_FF ** -0.5),
        "g_final": 1.0 + nrm(ks[16], (D_MODEL,), 0.02),
    }


def reference(x_prompt, x_sample, cache_k, cache_v, cache_kidx, state_pool, page_table,
              meta_tokens, g_mix, w_in, w_pool, pool_scale, w_out, g_mlp, w_up, w_down, g_final):
    b = x_prompt.shape[0]
    meta = jnp.broadcast_to(meta_tokens[None].astype(x_prompt.dtype), (b, N_META, D_MODEL))
    hp = jnp.concatenate([meta, x_prompt], axis=1)
    pos_p = jnp.arange(hp.shape[1], dtype=jnp.int32)
    hs = x_sample
    past = page_table.shape[1] * PAGE_SIZE
    pos_s = past + jnp.arange(hs.shape[1], dtype=jnp.int32)
    kp_l, vp_l, kip_l, pp_l, ks_l, vs_l, kis_l, ps_l = [], [], [], [], [], [], [], []
    for l in range(DEPTH):
        q, k, v, qi, ki, wi, u = mixer_inputs(hp, pos_p, g_mix[l], w_in[l])
        att = prompt_attention(q, k, v, qi, wi, ki)
        u_ext = jnp.concatenate([jnp.zeros((b, POOL_HIST, POOL_WIDTH), u.dtype), u], axis=1)
        pool = pool_mixer(u_ext, pos_p, w_pool[l], pool_scale[l])
        hp = hp + jnp.concatenate([att, pool], axis=-1) @ w_out[l]
        hp = hp + squared_relu_mlp(hp, g_mlp[l], w_up[l], w_down[l])
        kp_l.append(k); vp_l.append(v); kip_l.append(ki); pp_l.append(u_ext[:, -POOL_HIST:])
        q, k, v, qi, ki, wi, u = mixer_inputs(hs, pos_s, g_mix[l], w_in[l])
        att = sample_attention(q, k, v, qi, wi, ki, pos_s, cache_k[l], cache_v[l], cache_kidx[l], page_table)
        u_ext = jnp.concatenate([state_pool[l].astype(u.dtype), u], axis=1)
        pool = pool_mixer(u_ext, pos_s, w_pool[l], pool_scale[l])
        hs = hs + jnp.concatenate([att, pool], axis=-1) @ w_out[l]
        hs = hs + squared_relu_mlp(hs, g_mlp[l], w_up[l], w_down[l])
        ks_l.append(k); vs_l.append(v); kis_l.append(ki); ps_l.append(u_ext[:, -POOL_HIST:])
    y_prompt = rmsnorm(hp, g_final)[:, N_META:]
    y_sample = rmsnorm(hs, g_final)
    return (y_prompt, y_sample,
            jnp.stack(kp_l), jnp.stack(vp_l), jnp.stack(kip_l), jnp.stack(pp_l),
            jnp.stack(ks_l), jnp.stack(vs_l), jnp.stack(kis_l), jnp.stack(ps_l))
```

```cpp
#include <hip/hip_runtime.h>
#include <hip/hip_cooperative_groups.h>
#include <cstdio>
#include <cstdint>
namespace cg = cooperative_groups;

namespace pg8 {
#define PG8_LAS __attribute__((address_space(3)))
typedef unsigned short bf16_t;
typedef short bf16x8 __attribute__((ext_vector_type(8)));
typedef float f32x4 __attribute__((ext_vector_type(4)));
typedef unsigned u32x4 __attribute__((ext_vector_type(4)));
constexpr int BM = 256, BK = 64, HALF = 128, HTB = HALF * BK * 2  , STAGE_BYTES = 8 * HTB, NXCD = 8, WGM = 8;

__host__ __device__ __forceinline__ int lds_byte(int r, int c) { const int st = (r >> 4) * 2 + (c >> 5), rr = r & 15, cc = c & 31, ob = rr * 64 + cc * 2; return st * 1024 + (ob ^ (((ob >> 9) & 1) << 5)); }
__host__ __device__ __forceinline__ void stage_rc(int b, int& R, int& C) { const int st = b / 1024, sb = b % 1024, swz = sb ^ (((sb >> 9) & 1) << 5); R = (st >> 1) * 16 + swz / 64; C = (st & 1) * 32 + (swz % 64) / 2; }
__host__ __device__ __forceinline__ int perm32(int rho) { const int n = rho >> 4, i = rho & 15; return 8 * (i >> 2) + 4 * n + (i & 3); }

struct Unit { int pm, pn; };
struct Gemm { const bf16_t* A; const bf16_t* Bt; int M, N, K, lda, ldb, acs; };

struct StaticOrder {
    int nM, nN, nwg, G, c;
    __host__ __device__ void init(int M, int N, int G_, int c_) { nM = M / BM; nN = N / BM; nwg = nM * nN; G = G_; c = c_; }
    __host__ __device__ bool next(int i, Unit& u) const {
        const long L = (long)i * G + c; if (L >= nwg) return false;
        int wgid = (int)L; { const int q = nwg / NXCD, r = nwg % NXCD, xcd = wgid % NXCD, off = wgid / NXCD; wgid = (xcd < r ? xcd * (q + 1) : r * (q + 1) + (xcd - r) * q) + off; }
        const int nig = WGM * nN, gid = wgid / nig, fm = gid * WGM, gsz = (nM - fm) < WGM ? (nM - fm) : WGM;
        u.pm = fm + ((wgid % nig) % gsz); u.pn = (wgid % nig) / gsz; return true;
    }
    __device__ __forceinline__ void a_ready(const Unit&) const {}
    __device__ __forceinline__ void done(const Unit&) const {}
};


__device__ __forceinline__ unsigned cvt_pk_bf16(float lo, float hi) { unsigned r; asm volatile("v_cvt_pk_bf16_f32 %0, %1, %2" : "=v"(r) : "v"(lo), "v"(hi)); return r; }

struct EpiF32 {
    static constexpr bool PERM = false, AFTER_DRAIN = false;
    float* C; int ldc;
    __device__ __forceinline__ void operator()(const f32x4 (&acc)[2][2][4][2], const Unit& u, int wr, int wc, int fr, int fq) const {
        const int row0 = u.pm * BM + wr * 64 + fr, col0 = u.pn * BM + wc * 32 + 4 * fq;
#pragma unroll
        for (int ai = 0; ai < 2; ++ai)
#pragma unroll
            for (int m = 0; m < 4; ++m) { float* rowp = C + (size_t)(row0 + ai * HALF + m * 16) * ldc + col0;
#pragma unroll
                for (int bj = 0; bj < 2; ++bj)
#pragma unroll
                    for (int n = 0; n < 2; ++n) *(f32x4*)(rowp + bj * HALF + n * 16) = acc[ai][bj][m][n]; }
    }
};
template <int ACT> struct EpiBf16 {
    static constexpr bool PERM = true, AFTER_DRAIN = false;
    bf16_t* O; int ldc; int col_off; const float* colscale;
    __device__ __forceinline__ void operator()(const f32x4 (&acc)[2][2][4][2], const Unit& u, int wr, int wc, int fr, int fq) const {
        const int row0 = u.pm * BM + wr * 64 + fr; const int col0 = u.pn * BM + wc * 32 + 8 * fq;
#pragma unroll
        for (int bj = 0; bj < 2; ++bj) {
            f32x4 sv0 = (f32x4){1.f, 1.f, 1.f, 1.f}, sv1 = sv0;
            if (ACT == 0) { sv0 = *(const f32x4*)(colscale + col0 + bj * HALF); sv1 = *(const f32x4*)(colscale + col0 + bj * HALF + 4); }
#pragma unroll
            for (int ai = 0; ai < 2; ++ai)
#pragma unroll
                for (int m = 0; m < 4; ++m) { bf16_t* rowp = O + (size_t)(row0 + ai * HALF + m * 16) * ldc + col_off + col0;
                    f32x4 v0 = acc[ai][bj][m][0], v1 = acc[ai][bj][m][1];
                    if (ACT == 0) { v0 = v0 * sv0; v1 = v1 * sv1; }
                    if (ACT == 1) {
#pragma unroll
                        for (int j = 0; j < 4; ++j) { const float a = fmaxf(v0[j], 0.f), b = fmaxf(v1[j], 0.f); v0[j] = a * a; v1[j] = b * b; } }
                    u32x4 w; w.x = cvt_pk_bf16(v0[0], v0[1]); w.y = cvt_pk_bf16(v0[2], v0[3]); w.z = cvt_pk_bf16(v1[0], v1[1]); w.w = cvt_pk_bf16(v1[2], v1[3]);
                    *(u32x4*)(rowp + bj * HALF) = w; }
        }
    }
};
struct EpiRes {
    static constexpr bool PERM = false, AFTER_DRAIN = false;
    float* C; const float* H; const float* meta; const float* xp; const float* xs;
    __device__ __forceinline__ void operator()(const f32x4 (&acc)[2][2][4][2], const Unit& u, int wr, int wc, int fr, int fq) const {
        const int row0 = u.pm * BM + wr * 64 + fr, col0 = u.pn * BM + wc * 32 + 4 * fq;
#pragma unroll
        for (int ai = 0; ai < 2; ++ai)
#pragma unroll
            for (int m = 0; m < 4; ++m) { const int r = row0 + ai * HALF + m * 16;
                const float* res = H ? H + (size_t)r * 2048 : (r < 16 ? meta + (size_t)r * 2048 : r < 8208 ? xp + (size_t)(r - 16) * 2048 : r < 8336 ? xs + (size_t)(r - 8208) * 2048 : (const float*)nullptr);
                float* rowp = C + (size_t)r * 2048 + col0;
#pragma unroll
                for (int bj = 0; bj < 2; ++bj)
#pragma unroll
                    for (int n = 0; n < 2; ++n) { f32x4 rv = (f32x4){0.f, 0.f, 0.f, 0.f}; if (res) rv = *(const f32x4*)(res + col0 + bj * HALF + n * 16);
                        *(f32x4*)(rowp + bj * HALF + n * 16) = acc[ai][bj][m][n] + rv; } }
    }
};


template <class Epi, class Sched, bool ALIGN_EPI = false, bool SP2 = false>
__device__ __forceinline__ void gemm_phase(PG8_LAS unsigned char* lds, const Gemm g, const Sched& S, const Epi& E) {
    const int tid = threadIdx.x, wid = __builtin_amdgcn_readfirstlane(tid >> 6), lane = tid & 63, wr = wid >> 2, wc = wid & 3, fr = lane & 15, fq = lane >> 4;
    const int K = g.K, nt = K / BK;
    unsigned voffA[2], voffB[2];
#pragma unroll
    for (int i = 0; i < 2; ++i) { int R, C; stage_rc(tid * 16 + i * 8192, R, C); const int Rb = Epi::PERM ? ((R & ~31) + perm32(R & 31)) : R;
        voffA[i] = (unsigned)(R * g.lda + C) * 2u; voffB[i] = (unsigned)(Rb * g.ldb + C) * 2u; }
    const size_t kstep = (size_t)(BK * 2);
    const size_t hstepA = (size_t)HALF * g.lda * 2, hstepB = (size_t)HALF * g.ldb * 2;
    const size_t tstepA = 2 * hstepA, tstepB = 2 * hstepB;
    const size_t acs2 = (size_t)g.acs * 2;
    const unsigned ldsw = (unsigned)wid * 1024u;
    const int aoff = lds_byte(wr * 64 + fr, fq * 8), boff = lds_byte(wc * 32 + fr, fq * 8);
#define PG8_SA(b, h) (((b) * 2 + (h)) * HTB)
#define PG8_SB(b, h) ((4 + (b) * 2 + (h)) * HTB)
#define PG8_STAGE(bufoff, gbase, voff) do { _Pragma("unroll") for (int _i = 0; _i < 2; ++_i) \
        __builtin_amdgcn_global_load_lds((const unsigned*)((const char*)(gbase) + (voff)[_i]), (PG8_LAS unsigned*)(lds + (bufoff) + ldsw + _i * 8192), 16, 0, 0); } while (0)
#define PG8_LDA(dst, b, h) do { _Pragma("unroll") for (int m = 0; m < 4; ++m) _Pragma("unroll") for (int k = 0; k < 2; ++k) dst[m][k] = *(const PG8_LAS bf16x8*)(lds + PG8_SA(b, h) + aoff + m * 2048 + k * 1024); } while (0)
#define PG8_LDB(dst, b, h) do { _Pragma("unroll") for (int n = 0; n < 2; ++n) _Pragma("unroll") for (int k = 0; k < 2; ++k) dst[n][k] = *(const PG8_LAS bf16x8*)(lds + PG8_SB(b, h) + boff + n * 2048 + k * 1024); } while (0)
#define PG8_MMA(ai, bj, At, Bt) do { __builtin_amdgcn_s_setprio(1); _Pragma("unroll") for (int m = 0; m < 4; ++m) _Pragma("unroll") for (int n = 0; n < 2; ++n) _Pragma("unroll") for (int k = 0; k < 2; ++k) \
        acc[ai][bj][m][n] = __builtin_amdgcn_mfma_f32_16x16x32_bf16(Bt[n][k], At[m][k], acc[ai][bj][m][n], 0, 0, 0); __builtin_amdgcn_s_setprio(0); } while (0)
#define PG8_WAIT_V(n) asm volatile("s_waitcnt vmcnt(" #n ")" ::: "memory")
#define PG8_WAIT_L(n) asm volatile("s_waitcnt lgkmcnt(" #n ")" ::: "memory")
#define PG8_BAR __builtin_amdgcn_s_barrier()
#define PG8_SCHED __builtin_amdgcn_sched_barrier(0)
    Unit cur, nxt; int ui = 0;
    if (!S.next(0, cur)) return;
    f32x4 acc[2][2][4][2];
#pragma unroll
    for (int a = 0; a < 2; ++a)
#pragma unroll
        for (int b = 0; b < 2; ++b)
#pragma unroll
            for (int m = 0; m < 4; ++m)
#pragma unroll
                for (int n = 0; n < 2; ++n) acc[a][b][m][n] = (f32x4){0.f, 0.f, 0.f, 0.f};
    bf16x8 At[4][2], B0[2][2], B1[2][2];
    const char* cA = (const char*)g.A + (size_t)cur.pm * tstepA + (size_t)cur.pn * acs2; const char* cB = (const char*)g.Bt + (size_t)cur.pn * tstepB;
    S.a_ready(cur);
    if constexpr (SP2) {
        PG8_STAGE(PG8_SB(0, 0), cB, voffB); PG8_STAGE(PG8_SB(0, 1), cB + hstepB, voffB); PG8_STAGE(PG8_SA(0, 0), cA, voffA); PG8_STAGE(PG8_SA(0, 1), cA + hstepA, voffA);
        if (wr == 1) PG8_BAR;
        PG8_WAIT_V(2); PG8_BAR;
        PG8_STAGE(PG8_SB(1, 0), cB + kstep, voffB); PG8_STAGE(PG8_SA(1, 0), cA + kstep, voffA); PG8_STAGE(PG8_SB(1, 1), cB + hstepB + kstep, voffB);
        PG8_WAIT_V(6); PG8_BAR;
    } else {
        PG8_STAGE(PG8_SB(0, 0), cB, voffB); PG8_STAGE(PG8_SA(0, 0), cA, voffA); PG8_STAGE(PG8_SB(0, 1), cB + hstepB, voffB); PG8_STAGE(PG8_SA(0, 1), cA + hstepA, voffA);
        if (wr == 1) PG8_BAR;
        PG8_WAIT_V(4); PG8_BAR;
        PG8_STAGE(PG8_SB(1, 0), cB + kstep, voffB); PG8_STAGE(PG8_SA(1, 0), cA + kstep, voffA); PG8_STAGE(PG8_SB(1, 1), cB + hstepB + kstep, voffB);
        PG8_WAIT_V(6); PG8_BAR;
    }
    for (;;) {
        const bool has_next = S.next(ui + 1, nxt);
        const char* nA = has_next ? (const char*)g.A + (size_t)nxt.pm * tstepA + (size_t)nxt.pn * acs2 : cA; const char* nB = has_next ? (const char*)g.Bt + (size_t)nxt.pn * tstepB : cB;
        for (int t = 0; t < nt; t += 2) {
            const bool last = (t == nt - 2);
            const char* a1 = cA + (size_t)(t + 1) * kstep;
            const char* a2 = last ? nA : cA + (size_t)(t + 2) * kstep; const char* b2 = last ? nB : cB + (size_t)(t + 2) * kstep;
            const char* a3 = a2 + kstep; const char* b3 = b2 + kstep;
            if (last && has_next) S.a_ready(nxt);
            if constexpr (SP2) {
            PG8_LDB(B0, 0, 0); PG8_LDB(B1, 0, 1); PG8_SCHED; PG8_LDA(At, 0, 0); PG8_STAGE(PG8_SA(1, 1), a1 + hstepA, voffA);
            PG8_WAIT_V(8); PG8_WAIT_L(0); PG8_BAR; PG8_MMA(0, 0, At, B0); PG8_MMA(0, 1, At, B1); PG8_BAR; PG8_SCHED;
            PG8_LDA(At, 0, 1); PG8_STAGE(PG8_SB(0, 0), b2, voffB); PG8_STAGE(PG8_SB(0, 1), b2 + hstepB, voffB); PG8_STAGE(PG8_SA(0, 0), a2, voffA);
            PG8_WAIT_V(8); PG8_WAIT_L(0); PG8_BAR; PG8_MMA(1, 0, At, B0); PG8_MMA(1, 1, At, B1); PG8_BAR; PG8_SCHED;
            PG8_LDB(B0, 1, 0); PG8_LDB(B1, 1, 1); PG8_SCHED; PG8_LDA(At, 1, 0); PG8_STAGE(PG8_SA(0, 1), a2 + hstepA, voffA);
            PG8_WAIT_V(8); PG8_WAIT_L(0); PG8_BAR; PG8_MMA(0, 0, At, B0); PG8_MMA(0, 1, At, B1); PG8_BAR; PG8_SCHED;
            PG8_LDA(At, 1, 1); PG8_STAGE(PG8_SB(1, 0), b3, voffB); PG8_STAGE(PG8_SB(1, 1), b3 + hstepB, voffB); PG8_STAGE(PG8_SA(1, 0), a3, voffA);
            PG8_WAIT_V(8); PG8_WAIT_L(0); PG8_BAR; PG8_MMA(1, 0, At, B0); PG8_MMA(1, 1, At, B1); PG8_BAR; PG8_SCHED;
            } else {
            PG8_LDB(B0, 0, 0); PG8_SCHED; PG8_LDA(At, 0, 0); PG8_STAGE(PG8_SA(1, 1), a1 + hstepA, voffA);
            PG8_WAIT_L(8); PG8_BAR; PG8_WAIT_L(0); PG8_MMA(0, 0, At, B0); PG8_BAR; PG8_SCHED;
            PG8_LDB(B1, 0, 1); PG8_STAGE(PG8_SB(0, 0), b2, voffB);
            PG8_BAR; PG8_WAIT_L(0); PG8_MMA(0, 1, At, B1); PG8_BAR;
            PG8_LDA(At, 0, 1); PG8_STAGE(PG8_SA(0, 0), a2, voffA);
            PG8_BAR; PG8_WAIT_L(0); PG8_MMA(1, 0, At, B0); PG8_BAR; PG8_SCHED;
            PG8_STAGE(PG8_SB(0, 1), b2 + hstepB, voffB);
            PG8_WAIT_V(6); PG8_BAR; PG8_MMA(1, 1, At, B1); PG8_BAR;
            PG8_LDB(B0, 1, 0); PG8_SCHED; PG8_LDA(At, 1, 0); PG8_STAGE(PG8_SA(0, 1), a2 + hstepA, voffA);
            PG8_WAIT_L(8); PG8_BAR; PG8_WAIT_L(0); PG8_MMA(0, 0, At, B0); PG8_BAR; PG8_SCHED;
            PG8_LDB(B1, 1, 1); PG8_STAGE(PG8_SB(1, 0), b3, voffB);
            PG8_BAR; PG8_WAIT_L(0); PG8_MMA(0, 1, At, B1); PG8_BAR;
            PG8_LDA(At, 1, 1); PG8_STAGE(PG8_SA(1, 0), a3, voffA);
            PG8_BAR; PG8_WAIT_L(0); PG8_MMA(1, 0, At, B0); PG8_BAR; PG8_SCHED;
            PG8_STAGE(PG8_SB(1, 1), b3 + hstepB, voffB);
            PG8_WAIT_V(6); PG8_BAR; PG8_MMA(1, 1, At, B1); PG8_BAR;
            }
        }
        if constexpr (ALIGN_EPI) { if (wr == 0) PG8_BAR; }
        if constexpr (!Epi::AFTER_DRAIN) { E(acc, cur, wr, wc, fr, fq); S.done(cur); }
        if (!has_next) break;
#pragma unroll
        for (int a = 0; a < 2; ++a)
#pragma unroll
            for (int b = 0; b < 2; ++b)
#pragma unroll
                for (int m = 0; m < 4; ++m)
#pragma unroll
                    for (int n = 0; n < 2; ++n) acc[a][b][m][n] = (f32x4){0.f, 0.f, 0.f, 0.f};
        cur = nxt; cA = nA; cB = nB; ++ui;
        if constexpr (ALIGN_EPI) { if (wr == 1) PG8_BAR; }
    }
    PG8_WAIT_V(0);
    if constexpr (!ALIGN_EPI) { if (wr == 0) PG8_BAR; }
    PG8_BAR;
    if constexpr (Epi::AFTER_DRAIN) { E.fused(acc, cur, wr, wc, fr, fq, lds, wid, lane); S.done(cur); }
#undef PG8_SA
#undef PG8_SB
#undef PG8_STAGE
#undef PG8_LDA
#undef PG8_LDB
#undef PG8_MMA
#undef PG8_WAIT_V
#undef PG8_WAIT_L
#undef PG8_BAR
#undef PG8_SCHED
}
}

#ifndef PG8_SP2
#define PG8_SP2 true
#endif
#ifndef PG8_ALIGN
#define PG8_ALIGN true
#endif
#ifndef MK_ONE_LAUNCH
#define MK_ONE_LAUNCH 0
#endif

constexpr int DM = 2048, SEQ = 8192, NMETA = 16, TP = SEQ + NMETA, DB = 128, MR = TP + DB, MP = 8448;
constexpr int HD = 128, NH = 8, NKV = 2, NIH = 16, IDD = 64, TOPK = 256, NZR = 3664, NZ = 3840, DFF = 8192;
constexpr int PAST = 2048, PAGE = 128, NPAGES = 16, LS = PAST + 1;
constexpr int ZQ = 0, ZK = 1024, ZV = 1280, ZQI = 1536, ZKI = 2560, ZWI = 2624, ZU = 2640;
constexpr float EPS = 1e-6f;
constexpr int SCLD = 8256, SCROWS = 8224, SCSLD = 2064;
constexpr size_t O_YP = 0, O_YS = O_YP + (size_t)SEQ * DM, O_KP = O_YS + (size_t)DB * DM, O_VP = O_KP + (size_t)TP * 256, O_KIP = O_VP + (size_t)TP * 256,
                 O_PP = O_KIP + (size_t)TP * 64, O_KS = O_PP + 15 * 1024, O_VS = O_KS + DB * 256, O_KIS = O_VS + DB * 256, O_PS = O_KIS + DB * 64, O_END = O_PS + (size_t)DB * 15 * 1024;
constexpr size_t MiB = 1u << 20;
constexpr size_t WS_CTL = 0, WS_WIN = 2 * MiB, WS_WOUT = 18 * MiB, WS_WUP = 26 * MiB, WS_WDN = 58 * MiB, WS_WPOOL = 90 * MiB, WS_XN = 92 * MiB, WS_Z = 126 * MiB,
                 WS_QF = 250 * MiB, WS_QI = 284 * MiB, WS_KI = 302 * MiB, WS_WI = 304 * MiB, WS_U = 306 * MiB, WS_QI32 = 340 * MiB, WS_SCS = 341 * MiB, WS_SEL = 344 * MiB,
                 WS_DPOOL = 356 * MiB, WS_CAT = 374 * MiB, WS_H1 = 408 * MiB, WS_ACT = 476 * MiB, WS_H2 = 608 * MiB, WS_SC = 676 * MiB, WS_END = 936 * MiB;
static_assert(WS_Z + (size_t)MP * NZ * 4 <= WS_QF && WS_SC + (size_t)SCROWS * SCLD * 4 <= WS_END && WS_ACT + (size_t)MP * DFF * 2 <= WS_H2, "ws map");
constexpr int LDS_BYTES = 147456;
constexpr int NPH = 12;

#define LAS __attribute__((address_space(3)))
typedef unsigned short bf16;
typedef unsigned v4u __attribute__((ext_vector_type(4)));
typedef float f32x4 __attribute__((ext_vector_type(4)));
typedef float f32x16 __attribute__((ext_vector_type(16)));
typedef _Float16 f16x8 __attribute__((ext_vector_type(8)));
typedef _Float16 f16;

__device__ const double INV_FREQ[64] = { 1.00000000000000000e+00, 8.65964323360065347e-01, 7.49894209332455874e-01, 6.49381631576211316e-01, 5.62341325190349073e-01, 4.86967525165863113e-01, 4.21696503428582226e-01, 3.65174127254837722e-01, 3.16227766016837941e-01, 2.73841963426436130e-01, 2.37137370566165517e-01, 2.05352502645714613e-01, 1.77827941003892293e-01, 1.53992652605949187e-01, 1.33352143216332403e-01, 1.15478198468945817e-01, 1.00000000000000006e-01, 8.65964323360065291e-02, 7.49894209332455791e-02, 6.49381631576211316e-02, 5.62341325190349114e-02, 4.86967525165863113e-02, 4.21696503428582239e-02, 3.65174127254837694e-02, 3.16227766016837913e-02, 2.73841963426436144e-02, 2.37137370566165538e-02, 2.05352502645714599e-02, 1.77827941003892293e-02, 1.53992652605949194e-02, 1.33352143216332406e-02, 1.15478198468945813e-02, 1.00000000000000002e-02, 8.65964323360065430e-03, 7.49894209332455791e-03, 6.49381631576211298e-03, 5.62341325190349097e-03, 4.86967525165863096e-03, 4.21696503428582292e-03, 3.65174127254837711e-03, 3.16227766016837939e-03, 2.73841963426436127e-03, 2.37137370566165538e-03, 2.05352502645714599e-03, 1.77827941003892275e-03, 1.53992652605949203e-03, 1.33352143216332406e-03, 1.15478198468945813e-03, 1.00000000000000002e-03, 8.65964323360065387e-04, 7.49894209332455856e-04, 6.49381631576211342e-04, 5.62341325190349097e-04, 4.86967525165863096e-04, 4.21696503428582237e-04, 3.65174127254837700e-04, 3.16227766016837939e-04, 2.73841963426436105e-04, 2.37137370566165538e-04, 2.05352502645714610e-04, 1.77827941003892270e-04, 1.53992652605949192e-04, 1.33352143216332395e-04, 1.15478198468945822e-04 };

struct Args { const float* in[17]; float* out; unsigned char* ws; int ph_lo, ph_hi; };

#define LDS_WAIT() asm volatile("s_waitcnt lgkmcnt(0)" ::: "memory")
__device__ __forceinline__ unsigned f2bf(float f) { unsigned u = __builtin_bit_cast(unsigned, f); return (u + 0x7fffu + ((u >> 16) & 1u)) >> 16; }
__device__ __forceinline__ unsigned pk2(float lo, float hi) { return f2bf(lo) | (f2bf(hi) << 16); }
__device__ __forceinline__ float wave_sum(float v) {
#pragma unroll
    for (int o = 1; o < 64; o <<= 1) v += __shfl_xor(v, o);
    return v;
}
__device__ __forceinline__ const float* in_row(const Args& a, int r) {
    return r < NMETA ? a.in[7] + (size_t)r * DM : r < TP ? a.in[0] + (size_t)(r - NMETA) * DM : r < MR ? a.in[1] + (size_t)(r - TP) * DM : (const float*)nullptr;
}

__device__ __forceinline__ void p0_transpose_item(const float* W, int K, int N, bf16* WT, LAS float* scr, int item, int nblk, int lane) {
    const int kb = item / nblk, nb = item % nblk, k0 = 64 * kb, n0 = 32 * nb;
    const int n_rd = n0 + (lane & 31);
#pragma unroll 8
    for (int i = 0; i < 32; ++i) { const int kk = 2 * i + (lane >> 5); scr[kk * 33 + (lane & 31)] = n_rd < N ? W[(size_t)(k0 + kk) * N + n_rd] : 0.f; }
    LDS_WAIT();
    const int c = lane & 7;
#pragma unroll
    for (int j = 0; j < 4; ++j) { const int n = (lane >> 3) + 8 * j; const LAS float* s = scr + (8 * c) * 33 + n;
        v4u o; o.x = pk2(s[0 * 33], s[1 * 33]); o.y = pk2(s[2 * 33], s[3 * 33]); o.z = pk2(s[4 * 33], s[5 * 33]); o.w = pk2(s[6 * 33], s[7 * 33]);
        *(v4u*)(WT + (size_t)(n0 + n) * K + k0 + 8 * c) = o; }
    LDS_WAIT();
}
__device__ __forceinline__ void rms_row_to_bf16(const float* xrow, const float* gain, bf16* orow, int lane) {
    const f32x4* xr = (const f32x4*)xrow + lane; const f32x4* gr = (const f32x4*)gain + lane;
    f32x4 v[8]; float s = 0.f;
#pragma unroll
    for (int j = 0; j < 8; ++j) { v[j] = xr[64 * j]; s += (v[j].x * v[j].x + v[j].y * v[j].y) + (v[j].z * v[j].z + v[j].w * v[j].w); }
    const float rstd = 1.f / sqrtf(wave_sum(s) * (1.f / DM) + EPS);
    unsigned long long* o8 = (unsigned long long*)orow + lane;
#pragma unroll
    for (int j = 0; j < 8; ++j) { const f32x4 g = gr[64 * j]; o8[64 * j] = (unsigned long long)pk2(v[j].x * rstd * g.x, v[j].y * rstd * g.y) | ((unsigned long long)pk2(v[j].z * rstd * g.z, v[j].w * rstd * g.w) << 32); }
}
__device__ __forceinline__ void p0_prep(const Args& a, LAS unsigned char* lds, int gw, int NGW, int wave, int lane) {
    LAS float* scr = (LAS float*)(lds + wave * 16384);
    unsigned char* ws = a.ws;
    constexpr int I_IN = 32 * 120, I_OUT = 32 * 64, I_UP = 32 * 256, I_DN = 128 * 64, I_PL = 4 * 32;
    constexpr int NITEMS = I_IN + I_OUT + I_UP + I_DN + I_PL;
    for (int it = gw; it < NITEMS; it += NGW) {
        int r = it;
        if (r < I_IN) { p0_transpose_item(a.in[9], DM, NZR, (bf16*)(ws + WS_WIN), scr, r, 120, lane); continue; } r -= I_IN;
        if (r < I_OUT) { p0_transpose_item(a.in[12], DM, DM, (bf16*)(ws + WS_WOUT), scr, r, 64, lane); continue; } r -= I_OUT;
        if (r < I_UP) { p0_transpose_item(a.in[14], DM, DFF, (bf16*)(ws + WS_WUP), scr, r, 256, lane); continue; } r -= I_UP;
        if (r < I_DN) { p0_transpose_item(a.in[15], DFF, DM, (bf16*)(ws + WS_WDN), scr, r, 64, lane); continue; } r -= I_DN;
        { const int g = r >> 5; p0_transpose_item(a.in[10] + (size_t)g * 65536, 256, 256, (bf16*)(ws + WS_WPOOL) + (size_t)g * 65536, scr, r & 31, 8, lane); }
    }
    bf16* XN = (bf16*)(ws + WS_XN);
    for (int m = gw; m < MP; m += NGW) {
        const float* xr = in_row(a, m);
        if (xr) rms_row_to_bf16(xr, a.in[8], XN + (size_t)m * DM, lane);
        else { v4u z = {0u, 0u, 0u, 0u}; v4u* o = (v4u*)(XN + (size_t)m * DM) + lane;
#pragma unroll
            for (int j = 0; j < 4; ++j) o[64 * j] = z; }
    }
}

__device__ __forceinline__ void rope_cs(int pos, int j, float& c, float& s) {
    const double x = (double)pos * INV_FREQ[j];
    const double n = __builtin_rint(x * 0.15915494309189535);
    const double r = __builtin_fma(-n, 6.283185307179586, x);
    const float rf = (float)r; c = cosf(rf); s = sinf(rf);
}
__device__ __forceinline__ void p2_rope(const Args& a, int gw, int NGW, int lane) {
    unsigned char* ws = a.ws; float* out = a.out;
    const float* Z = (const float*)(ws + WS_Z);
    float* QF = (float*)(ws + WS_QF); f16* QI = (f16*)(ws + WS_QI); f16* KI = (f16*)(ws + WS_KI); float* WI = (float*)(ws + WS_WI); float* U = (float*)(ws + WS_U); float* QI32 = (float*)(ws + WS_QI32);
    for (int r = gw; r < MR; r += NGW) {
        const float* z = Z + (size_t)r * NZ;
        const bool smp = r >= TP; const int b = r - TP; const int pos = smp ? PAST : r;
        float c1, s1, c2, s2; rope_cs(pos, lane, c1, s1); rope_cs(pos, 2 * (lane & 31), c2, s2);
#pragma unroll
        for (int h = 0; h < NH; ++h) { const float x1 = z[ZQ + h * 128 + lane], x2 = z[ZQ + h * 128 + 64 + lane];
            QF[(size_t)r * 1024 + h * 128 + lane] = x1 * c1 - x2 * s1; QF[(size_t)r * 1024 + h * 128 + 64 + lane] = x1 * s1 + x2 * c1; }
        float* ko = smp ? out + O_KS + (size_t)b * 256 : out + O_KP + (size_t)r * 256;
#pragma unroll
        for (int h = 0; h < NKV; ++h) { const float x1 = z[ZK + h * 128 + lane], x2 = z[ZK + h * 128 + 64 + lane];
            ko[h * 128 + lane] = x1 * c1 - x2 * s1; ko[h * 128 + 64 + lane] = x1 * s1 + x2 * c1; }
        float* vo = smp ? out + O_VS + (size_t)b * 256 : out + O_VP + (size_t)r * 256;
        *((f32x4*)vo + lane) = *((const f32x4*)(z + ZV) + lane);
        const int jj = lane & 31, hh = lane >> 5;
#pragma unroll
        for (int i = 0; i < 8; ++i) { const int h = 2 * i + hh; const float x1 = z[ZQI + h * 64 + jj], x2 = z[ZQI + h * 64 + 32 + jj];
            const float o1 = x1 * c2 - x2 * s2, o2 = x1 * s2 + x2 * c2;
            QI[(size_t)r * 1024 + h * 64 + jj] = (f16)o1; QI[(size_t)r * 1024 + h * 64 + 32 + jj] = (f16)o2;
            if (smp) { QI32[(size_t)b * 1024 + h * 64 + jj] = o1; QI32[(size_t)b * 1024 + h * 64 + 32 + jj] = o2; } }
        if (lane < 32) { const float x1 = z[ZKI + jj], x2 = z[ZKI + 32 + jj]; const float o1 = x1 * c2 - x2 * s2, o2 = x1 * s2 + x2 * c2;
            float* kio = smp ? out + O_KIS + (size_t)b * 64 : out + O_KIP + (size_t)r * 64;
            kio[jj] = o1; kio[32 + jj] = o2; KI[(size_t)r * 64 + jj] = (f16)o1; KI[(size_t)r * 64 + 32 + jj] = (f16)o2; }
        if (lane < 16) WI[(size_t)r * 16 + lane] = z[ZWI + lane] * 0.25f;
#pragma unroll
        for (int j = 0; j < 4; ++j) { const f32x4 uv = *((const f32x4*)(z + ZU) + lane + 64 * j);
            *((f32x4*)(U + (size_t)r * 1024) + lane + 64 * j) = uv;
            if (!smp && r >= TP - 15) *((f32x4*)(out + O_PP + (size_t)(r - (TP - 15)) * 1024) + lane + 64 * j) = uv;
            if (smp) *((f32x4*)(out + O_PS + ((size_t)b * 15 + 14) * 1024) + lane + 64 * j) = uv; }
        if (smp) { const f32x4* sp = (const f32x4*)(a.in[5] + ((size_t)b * 15 + 1) * 1024); f32x4* po = (f32x4*)(out + O_PS + (size_t)b * 15 * 1024);
            for (int i = lane; i < 14 * 256; i += 64) po[i] = sp[i]; }
    }
}

__device__ __forceinline__ void p3_indexer_prompt(const Args& a, LAS unsigned char* lds, int bid, int G, int tid, int wave, int lane) {
    unsigned char* ws = a.ws;
    const f16* QI = (const f16*)(ws + WS_QI); const f16* KI = (const f16*)(ws + WS_KI); const float* WI = (const float*)(ws + WS_WI); float* SC = (float*)(ws + WS_SC);
    const int r = lane & 31, hh = lane >> 5;
    int idx = 0;
    for (int q = 256; q >= 0; --q) {
        const int t0 = q * 32; const int nkb = (t0 + 31) / 64 + 1;
        const int nch = (nkb + 15) / 16;
        for (int kc = 0; kc < nch; ++kc, ++idx) {
            if (idx % G != bid) continue;
            __syncthreads();
#pragma unroll
            for (int i = 0; i < 8; ++i) { const int cid = tid + 512 * i; const int rr = cid >> 7, c = cid & 127; const int h = c >> 3, ks = (c >> 1) & 3, h2 = c & 1;
                const v4u v = *(const v4u*)(QI + (size_t)(t0 + rr) * 1024 + c * 8);
                *(LAS v4u*)(lds + ((((h * 4 + ks) * 2 + h2) * 32) + rr) * 16) = v; }
            { const float wx = WI[(size_t)(t0 + (tid & 31)) * 16 + (tid >> 5)]; *(LAS float*)(lds + 65536 + ((tid >> 5) * 32 + (tid & 31)) * 4) = wx; }
            __syncthreads();
            const int kb_end = (kc * 16 + 16 < nkb) ? kc * 16 + 16 : nkb;
            for (int kb = kc * 16 + wave; kb < kb_end; kb += 8) {
                const int s0 = kb * 64;
                f16x8 af[2][4];
#pragma unroll
                for (int blk = 0; blk < 2; ++blk)
#pragma unroll
                    for (int ks = 0; ks < 4; ++ks) af[blk][ks] = *(const f16x8*)(KI + (size_t)(s0 + blk * 32 + r) * 64 + ks * 16 + hh * 8);
                f32x16 sc0 = {}, sc1 = {};
#pragma unroll 2
                for (int h = 0; h < 16; ++h) {
                    const float wh = *(const LAS float*)(lds + 65536 + (h * 32 + r) * 4);
                    f32x16 d0 = {}, d1 = {};
#pragma unroll
                    for (int ks = 0; ks < 4; ++ks) { const f16x8 bfr = *(const LAS f16x8*)(lds + ((((h * 4 + ks) * 2 + hh) * 32) + r) * 16);
                        d0 = __builtin_amdgcn_mfma_f32_32x32x16_f16(af[0][ks], bfr, d0, 0, 0, 0); d1 = __builtin_amdgcn_mfma_f32_32x32x16_f16(af[1][ks], bfr, d1, 0, 0, 0); }
#pragma unroll
                    for (int i = 0; i < 16; ++i) { sc0[i] += wh * fmaxf(d0[i], 0.f); sc1[i] += wh * fmaxf(d1[i], 0.f); }
                }
                float* row = SC + (size_t)(t0 + r) * SCLD + s0 + 4 * hh;
#pragma unroll
                for (int q4 = 0; q4 < 4; ++q4) {
                    *(f32x4*)(row + 8 * q4) = (f32x4){sc0[4 * q4] * 0.125f, sc0[4 * q4 + 1] * 0.125f, sc0[4 * q4 + 2] * 0.125f, sc0[4 * q4 + 3] * 0.125f};
                    *(f32x4*)(row + 32 + 8 * q4) = (f32x4){sc1[4 * q4] * 0.125f, sc1[4 * q4 + 1] * 0.125f, sc1[4 * q4 + 2] * 0.125f, sc1[4 * q4 + 3] * 0.125f}; }
            }
        }
    }
}
__device__ __forceinline__ void p3_indexer_sample(const Args& a, int gw, int NGW, int lane) {
    unsigned char* ws = a.ws;
    const float* QI32 = (const float*)(ws + WS_QI32); const float* WI = (const float*)(ws + WS_WI); float* SCS = (float*)(ws + WS_SCS);
    const float* ckidx = a.in[4]; const int* pt = (const int*)a.in[6];
    for (int it = gw; it < DB * 17; it += NGW) {
        const int b = __builtin_amdgcn_readfirstlane(it / 17), p = __builtin_amdgcn_readfirstlane(it % 17);
        const float* q = QI32 + (size_t)b * 1024; const float* w = WI + (size_t)(TP + b) * 16;
        const int nkeys = p < 16 ? PAGE : 1;
        for (int kk = lane; kk < nkeys; kk += 64) {
            const float* krow = p < 16 ? ckidx + ((size_t)pt[b * NPAGES + p] * PAGE + kk) * IDD : a.out + O_KIS + (size_t)b * IDD;
            float k[64];
#pragma unroll
            for (int j = 0; j < 16; ++j) { const f32x4 v = *((const f32x4*)krow + j); k[4 * j] = v.x; k[4 * j + 1] = v.y; k[4 * j + 2] = v.z; k[4 * j + 3] = v.w; }
            float score = 0.f;
#pragma unroll 1
            for (int h = 0; h < 16; ++h) { float d = 0.f;
#pragma unroll
                for (int dd = 0; dd < 64; ++dd) d = fmaf(q[h * 64 + dd], k[dd], d);
                score += w[h] * fmaxf(d, 0.f); }
            SCS[(size_t)b * SCSLD + p * PAGE + kk] = score * 0.125f;
        }
    }
}

__device__ __forceinline__ unsigned tokey(float x) { const unsigned u = __builtin_bit_cast(unsigned, x); return u ^ (((unsigned)((int)u >> 31)) | 0x80000000u); }
__device__ __forceinline__ void topk_row(const float* row, int n, int* sel, LAS unsigned* hist, int lane) {
    if (n <= TOPK) { for (int i = lane; i < TOPK; i += 64) sel[i] = i < n ? i : 0; return; }
    unsigned prefix = 0u; int need = TOPK;
#pragma unroll 1
    for (int pass = 0; pass < 3; ++pass) {
        const int shift = pass == 0 ? 21 : pass == 1 ? 10 : 0;
        const unsigned mask = pass == 2 ? 1023u : 2047u;
        const int pshift = pass == 1 ? 21 : 10;
        for (int i = lane; i < 2048; i += 64) hist[i] = 0u;
        LDS_WAIT();
        for (int i = lane; i < n; i += 64) { const unsigned key = tokey(row[i]);
            if (pass == 0 || (key >> pshift) == prefix) __hip_atomic_fetch_add(hist + ((key >> shift) & mask), 1u, __ATOMIC_RELAXED, __HIP_MEMORY_SCOPE_WORKGROUP); }
        LDS_WAIT();
        unsigned tot = 0u;
#pragma unroll 8
        for (int j = 0; j < 32; ++j) tot += hist[32 * lane + j];
        unsigned s = tot;
#pragma unroll
        for (int o = 1; o < 64; o <<= 1) { const unsigned t = __shfl_down(s, o); if (lane + o < 64) s += t; }
        const unsigned s_excl = s - tot;
        const bool found = (s_excl < (unsigned)need) && ((unsigned)need <= s);
        const unsigned long long bal = __ballot(found);
        const int L = bal ? (int)__builtin_ctzll(bal) : 0;
        unsigned digit = 0u, above = 0u;
        if (lane == L) { unsigned c = s_excl;
            for (int j = 31; j >= 0; --j) { const unsigned h = hist[32 * lane + j]; if (c + h >= (unsigned)need) { digit = 32u * lane + j; above = c; break; } c += h; } }
        digit = __shfl(digit, L); above = __shfl(above, L);
        need -= (int)above;
        prefix = pass == 2 ? ((prefix << 10) | digit) : ((prefix << 11) | digit);
        LDS_WAIT();
    }
    const unsigned thr = prefix; const int need_eq = need;
    int outpos = 0, eqtaken = 0;
    const unsigned long long lt = (1ull << lane) - 1ull;
    for (int base = 0; base < n; base += 64) {
        const int i = base + lane; const bool valid = i < n; const unsigned key = valid ? tokey(row[i]) : 0u;
        const bool gt = valid && key > thr, eq = valid && key == thr;
        const unsigned long long beq = __ballot(eq);
        const int eq_rank = eqtaken + __builtin_popcountll(beq & lt);
        const bool take = gt || (eq && eq_rank < need_eq);
        const unsigned long long bt = __ballot(take);
        const int pos = outpos + __builtin_popcountll(bt & lt);
        if (take && pos < TOPK) sel[pos] = i;
        outpos += __builtin_popcountll(bt); eqtaken += __builtin_popcountll(beq);
    }
}
__device__ __forceinline__ void p4_topk(const Args& a, LAS unsigned char* lds, int gw, int NGW, int wave, int lane) {
    unsigned char* ws = a.ws;
    const float* SC = (const float*)(ws + WS_SC); const float* SCS = (const float*)(ws + WS_SCS); int* SEL = (int*)(ws + WS_SEL);
    LAS unsigned* hist = (LAS unsigned*)(lds + wave * 8192);
    for (int it = gw; it < SEQ + DB; it += NGW) {
        if (it < SEQ) { const int t = NMETA + it; topk_row(SC + (size_t)t * SCLD, t + 1, SEL + (size_t)t * TOPK, hist, lane); }
        else { const int b = it - SEQ; topk_row(SCS + (size_t)b * SCSLD, LS, SEL + (size_t)(TP + b) * TOPK, hist, lane); }
    }
}

template <int CTRL> __device__ __forceinline__ float dpp_f(float v) { return __builtin_bit_cast(float, __builtin_amdgcn_update_dpp(0, __builtin_bit_cast(int, v), CTRL, 0xf, 0xf, false)); }
__device__ __forceinline__ float row16_sum(float v) {
    v += dpp_f<0xB1>(v);
    v += dpp_f<0x4E>(v);
    v += dpp_f<0x124>(v);
    v += dpp_f<0x128>(v);
    return v;
}
__device__ __forceinline__ const float* kv_row(const Args& a, bool smp, int b, int s, int kvh, bool isv) {
    if (!smp) return a.out + (isv ? O_VP : O_KP) + (size_t)s * 256 + kvh * 128;
    if (s < PAST) { const int phys = ((const int*)a.in[6])[b * NPAGES + (s >> 7)]; return (isv ? a.in[3] : a.in[2]) + (((size_t)phys * PAGE + (s & 127)) * 2 + kvh) * 128; }
    return a.out + (isv ? O_VS : O_KS) + (size_t)b * 256 + kvh * 128;
}
__device__ __forceinline__ void attn_unit(const Args& a, LAS unsigned char* wl, int row, int kvh, int lane) {
    unsigned char* ws = a.ws;
    const float* QF = (const float*)(ws + WS_QF); const int* SEL = (const int*)(ws + WS_SEL); bf16* CAT = (bf16*)(ws + WS_CAT);
    LAS int* lsel = (LAS int*)wl; LAS float* lsc = (LAS float*)(wl + 1024);
    const bool smp = row >= TP; const int b = row - TP;
    const int cnt = smp ? TOPK : (row + 1 < TOPK ? row + 1 : TOPK);
    const int l16 = lane & 15, kg = lane >> 4;
#pragma unroll
    for (int j = 0; j < 4; ++j) { const int kidx = 64 * j + lane; const int sv = SEL[(size_t)row * TOPK + kidx]; lsel[kidx] = kidx < cnt ? sv : 0; }
    float qf[4][8];
    const float qs = 0.08838834764831845f;
#pragma unroll
    for (int g = 0; g < 4; ++g) { const f32x4* qp = (const f32x4*)(QF + (size_t)row * 1024 + (kvh * 4 + g) * 128 + 8 * l16);
        const f32x4 x = qp[0], y = qp[1]; qf[g][0] = x.x * qs; qf[g][1] = x.y * qs; qf[g][2] = x.z * qs; qf[g][3] = x.w * qs; qf[g][4] = y.x * qs; qf[g][5] = y.y * qs; qf[g][6] = y.z * qs; qf[g][7] = y.w * qs; }
    LDS_WAIT();
#pragma unroll 2
    for (int i = 0; i < 64; ++i) {
        const int kidx = 4 * i + kg; const bool valid = kidx < cnt;
        const int s = lsel[kidx];
        const f32x4* kp = (const f32x4*)(kv_row(a, smp, b, s, kvh, false) + 8 * l16);
        const f32x4 x = kp[0], y = kp[1];
        float part[4];
#pragma unroll
        for (int g = 0; g < 4; ++g) { float d = qf[g][0] * x.x; d = fmaf(qf[g][1], x.y, d); d = fmaf(qf[g][2], x.z, d); d = fmaf(qf[g][3], x.w, d);
            d = fmaf(qf[g][4], y.x, d); d = fmaf(qf[g][5], y.y, d); d = fmaf(qf[g][6], y.z, d); d = fmaf(qf[g][7], y.w, d); part[g] = row16_sum(d); }
        float mine = l16 == 0 ? part[0] : l16 == 1 ? part[1] : l16 == 2 ? part[2] : part[3];
        mine = valid ? mine : -INFINITY;
        if (l16 < 4) lsc[l16 * 256 + kidx] = mine;
    }
    LDS_WAIT();
    float pm[4][4], mx[4], lsum[4];
#pragma unroll
    for (int g = 0; g < 4; ++g) { float m = -INFINITY;
#pragma unroll
        for (int j = 0; j < 4; ++j) { pm[g][j] = lsc[g * 256 + 64 * j + lane]; m = fmaxf(m, pm[g][j]); }
#pragma unroll
        for (int o = 1; o < 64; o <<= 1) m = fmaxf(m, __shfl_xor(m, o));
        mx[g] = m; float l = 0.f;
#pragma unroll
        for (int j = 0; j < 4; ++j) { const float p = __expf(pm[g][j] - m); l += p; lsc[g * 256 + 64 * j + lane] = p; }
        lsum[g] = wave_sum(l); }
    LDS_WAIT();
    float acc[4][8];
#pragma unroll
    for (int g = 0; g < 4; ++g)
#pragma unroll
        for (int d = 0; d < 8; ++d) acc[g][d] = 0.f;
#pragma unroll 2
    for (int i = 0; i < 64; ++i) {
        const int kidx = 4 * i + kg;
        const int s = lsel[kidx];
        const f32x4* vp = (const f32x4*)(kv_row(a, smp, b, s, kvh, true) + 8 * l16);
        const f32x4 x = vp[0], y = vp[1];
#pragma unroll
        for (int g = 0; g < 4; ++g) { const float p = lsc[g * 256 + kidx];
            acc[g][0] = fmaf(p, x.x, acc[g][0]); acc[g][1] = fmaf(p, x.y, acc[g][1]); acc[g][2] = fmaf(p, x.z, acc[g][2]); acc[g][3] = fmaf(p, x.w, acc[g][3]);
            acc[g][4] = fmaf(p, y.x, acc[g][4]); acc[g][5] = fmaf(p, y.y, acc[g][5]); acc[g][6] = fmaf(p, y.z, acc[g][6]); acc[g][7] = fmaf(p, y.w, acc[g][7]); }
    }
#pragma unroll
    for (int g = 0; g < 4; ++g) {
        const float inv = 1.f / lsum[g];
#pragma unroll
        for (int d = 0; d < 8; ++d) { float v = acc[g][d]; v += __shfl_xor(v, 16); v += __shfl_xor(v, 32); acc[g][d] = v * inv; }
        if (lane < 16) { v4u o; o.x = pk2(acc[g][0], acc[g][1]); o.y = pk2(acc[g][2], acc[g][3]); o.z = pk2(acc[g][4], acc[g][5]); o.w = pk2(acc[g][6], acc[g][7]);
            *(v4u*)(CAT + (size_t)row * 2048 + (kvh * 4 + g) * 128 + 8 * l16) = o; }
    }
    LDS_WAIT();
}
__device__ __forceinline__ void p5_attn(const Args& a, LAS unsigned char* lds, int gw, int NGW, int wave, int lane) {
    for (int it = gw; it < (SEQ + DB) * 2; it += NGW) { const int ri = it >> 1, kvh = it & 1; const int row = ri < SEQ ? NMETA + ri : TP + (ri - SEQ); attn_unit(a, lds + wave * 5120, row, kvh, lane); }
}
__device__ __forceinline__ void p5_dpool(const Args& a, int bid, int G, int tid) {
    unsigned char* ws = a.ws;
    const float* U = (const float*)(ws + WS_U); bf16* DP = (bf16*)(ws + WS_DPOOL); const float* SP = a.in[5];
    for (size_t e = (size_t)bid * 512 + tid; e < (size_t)MP * 256; e += (size_t)G * 512) {
        const int r = (int)(e >> 8), c4 = (int)(e & 255); const int grp = c4 >> 6; const int w = 2 << grp;
        f32x4 d = {0.f, 0.f, 0.f, 0.f};
        if (r < MR) {
            const f32x4 cur = *((const f32x4*)(U + (size_t)r * 1024) + c4); f32x4 sum = cur; float cnt;
            if (r < TP) { const int nb = (r + 1 < w) ? r + 1 : w; cnt = (float)nb;
                for (int j = 1; j < nb; ++j) sum += *((const f32x4*)(U + (size_t)(r - j) * 1024) + c4); }
            else { const int b = r - TP; cnt = (float)w;
                for (int j = 1; j < w; ++j) sum += *((const f32x4*)(SP + ((size_t)b * 15 + (15 - j)) * 1024) + c4); }
            d = sum / cnt - cur;
        }
        unsigned long long o = (unsigned long long)pk2(d.x, d.y) | ((unsigned long long)pk2(d.z, d.w) << 32);
        *((unsigned long long*)(DP + (size_t)r * 1024) + c4) = o;
    }
}
__device__ __forceinline__ void rms_row_to_f32(const float* xrow, const float* gain, float* orow, int lane) {
    const f32x4* xr = (const f32x4*)xrow + lane; const f32x4* gr = (const f32x4*)gain + lane;
    f32x4 v[8]; float s = 0.f;
#pragma unroll
    for (int j = 0; j < 8; ++j) { v[j] = xr[64 * j]; s += (v[j].x * v[j].x + v[j].y * v[j].y) + (v[j].z * v[j].z + v[j].w * v[j].w); }
    const float rstd = 1.f / sqrtf(wave_sum(s) * (1.f / DM) + EPS);
#pragma unroll
    for (int j = 0; j < 8; ++j) { const f32x4 g = gr[64 * j]; *((f32x4*)orow + lane + 64 * j) = v[j] * rstd * g; }
}

__global__ void __launch_bounds__(512, 2) mk_fwd(Args a) {
    extern __shared__ __attribute__((aligned(16))) unsigned char lds_raw[];
    LAS unsigned char* lds = (LAS unsigned char*)lds_raw;
    const int tid = threadIdx.x, lane = tid & 63, wave = __builtin_amdgcn_readfirstlane(tid >> 6);
    const int G = gridDim.x, bid = blockIdx.x;
    const int gw = bid * 8 + wave, NGW = G * 8;
    unsigned char* ws = a.ws;
    const int lo = a.ph_lo, hi = a.ph_hi;
#ifndef PHASE_MASK
#define PHASE_MASK 0xFFF
#endif
#define IN(k) ((((PHASE_MASK) >> (k)) & 1) && lo <= (k) && (k) < hi)
#if MK_ONE_LAUNCH
#define SEAM(k) do { if (IN(k) && IN((k) + 1)) cg::this_grid().sync(); } while (0)
#else
#define SEAM(k) do { } while (0)
#endif
    if (IN(0)) { p0_prep(a, lds, gw, NGW, wave, lane); __syncthreads(); } SEAM(0);
    if (IN(1)) { pg8::Gemm g{(const pg8::bf16_t*)(ws + WS_XN), (const pg8::bf16_t*)(ws + WS_WIN), MP, NZ, DM, DM, DM, 0}; pg8::StaticOrder S; S.init(MP, NZ, G, bid);
        pg8::EpiF32 E{(float*)(ws + WS_Z), NZ};
        pg8::gemm_phase<pg8::EpiF32, pg8::StaticOrder, PG8_ALIGN, PG8_SP2>(lds, g, S, E); } SEAM(1);
    if (IN(2)) { p2_rope(a, gw, NGW, lane); } SEAM(2);
    #ifndef SUB3
#define SUB3 7
#endif
    if (IN(3)) { if (SUB3 & 1) p3_indexer_prompt(a, lds, bid, G, tid, wave, lane); if (SUB3 & 2) p3_indexer_sample(a, gw, NGW, lane); if (SUB3 & 4) p5_dpool(a, bid, G, tid); __syncthreads(); } SEAM(3);
    if (IN(4)) { p4_topk(a, lds, gw, NGW, wave, lane); __syncthreads(); } SEAM(4);
    if (IN(5)) { p5_attn(a, lds, gw, NGW, wave, lane); __syncthreads(); } SEAM(5);
    if (IN(6)) { pg8::Gemm g{(const pg8::bf16_t*)(ws + WS_DPOOL), (const pg8::bf16_t*)(ws + WS_WPOOL), MP, 1024, 256, 1024, 256, 256}; pg8::StaticOrder S; S.init(MP, 1024, G, bid);
        pg8::EpiBf16<0> E{(pg8::bf16_t*)(ws + WS_CAT), 2048, 1024, a.in[11]};
        pg8::gemm_phase<pg8::EpiBf16<0>, pg8::StaticOrder, PG8_ALIGN, PG8_SP2>(lds, g, S, E); } SEAM(6);
    if (IN(7)) { pg8::Gemm g{(const pg8::bf16_t*)(ws + WS_CAT), (const pg8::bf16_t*)(ws + WS_WOUT), MP, DM, DM, DM, DM, 0}; pg8::StaticOrder S; S.init(MP, DM, G, bid);
        pg8::EpiRes E{(float*)(ws + WS_H1), nullptr, a.in[7], a.in[0], a.in[1]};
        pg8::gemm_phase<pg8::EpiRes, pg8::StaticOrder, PG8_ALIGN, PG8_SP2>(lds, g, S, E); } SEAM(7);
    if (IN(8)) { const float* H1 = (const float*)(ws + WS_H1); bf16* XN = (bf16*)(ws + WS_XN);
        for (int m = gw; m < MR; m += NGW) rms_row_to_bf16(H1 + (size_t)m * DM, a.in[13], XN + (size_t)m * DM, lane); } SEAM(8);
    if (IN(9)) { pg8::Gemm g{(const pg8::bf16_t*)(ws + WS_XN), (const pg8::bf16_t*)(ws + WS_WUP), MP, DFF, DM, DM, DM, 0}; pg8::StaticOrder S; S.init(MP, DFF, G, bid);
        pg8::EpiBf16<1> E{(pg8::bf16_t*)(ws + WS_ACT), DFF, 0, nullptr};
        pg8::gemm_phase<pg8::EpiBf16<1>, pg8::StaticOrder, PG8_ALIGN, PG8_SP2>(lds, g, S, E); } SEAM(9);
    if (IN(10)) { pg8::Gemm g{(const pg8::bf16_t*)(ws + WS_ACT), (const pg8::bf16_t*)(ws + WS_WDN), MP, DM, DFF, DFF, DFF, 0}; pg8::StaticOrder S; S.init(MP, DM, G, bid);
        pg8::EpiRes E{(float*)(ws + WS_H2), (const float*)(ws + WS_H1), nullptr, nullptr, nullptr};
        pg8::gemm_phase<pg8::EpiRes, pg8::StaticOrder, PG8_ALIGN, PG8_SP2>(lds, g, S, E); } SEAM(10);
    if (IN(11)) { const float* H2 = (const float*)(ws + WS_H2);
        for (int m = gw; m < SEQ + DB; m += NGW) { const int r = NMETA + m; float* o = m < SEQ ? a.out + O_YP + (size_t)m * DM : a.out + O_YS + (size_t)(m - SEQ) * DM;
            rms_row_to_f32(H2 + (size_t)r * DM, a.in[16], o, lane); } }
#undef IN
#undef SEAM
}

extern "C" void kernel_launch(void* const* d_in, const int* in_sizes, int n_in, void* d_out, int out_size, void* d_ws, size_t ws_size, hipStream_t stream) {
    static int grid = 0;
    if (grid == 0) {
        if (n_in != 17 || (size_t)out_size != O_END || ws_size < WS_END) { fprintf(stderr, "kernel_launch: unexpected shapes: n_in %d out_size %d (want %zu) ws %zu (want >= %zu)\n", n_in, out_size, (size_t)O_END, ws_size, (size_t)WS_END); grid = -1; return; }
        int dev = 0, cus = 0, per_cu = 0;
        if (hipGetDevice(&dev) != hipSuccess || hipDeviceGetAttribute(&cus, hipDeviceAttributeMultiprocessorCount, dev) != hipSuccess) { grid = -1; return; }
        if (hipFuncSetAttribute((const void*)mk_fwd, hipFuncAttributeMaxDynamicSharedMemorySize, LDS_BYTES) != hipSuccess) { fprintf(stderr, "kernel_launch: hipFuncSetAttribute failed\n"); grid = -1; return; }
        if (hipOccupancyMaxActiveBlocksPerMultiprocessor(&per_cu, (const void*)mk_fwd, 512, LDS_BYTES) != hipSuccess || per_cu < 1) { fprintf(stderr, "kernel_launch: occupancy query says %d\n", per_cu); grid = -1; return; }
        grid = cus;
        fprintf(stderr, "kernel_launch: grid %d (cus %d, per_cu %d)\n", grid, cus, per_cu);
    }
    if (grid < 0) return;
    Args a{};
    for (int i = 0; i < 17; ++i) a.in[i] = (const float*)d_in[i];
    a.out = (float*)d_out; a.ws = (unsigned char*)d_ws;
#if MK_ONE_LAUNCH
    a.ph_lo = 0; a.ph_hi = NPH;
    void* args[] = {&a};
    hipError_t e = hipLaunchCooperativeKernel((const void*)mk_fwd, dim3(grid), dim3(512), args, LDS_BYTES, stream);
    if (e != hipSuccess) fprintf(stderr, "kernel_launch: cooperative launch failed: %s (grid %d)\n", hipGetErrorString(e), grid);
#else
    for (int p = 0; p < NPH; ++p) { a.ph_lo = p; a.ph_hi = p + 1; hipLaunchKernelGGL(mk_fwd, dim3(grid), dim3(512), LDS_BYTES, stream, a); }
#endif
}
```

```cpp
#include <hip/hip_runtime.h>
#include <hip/hip_cooperative_groups.h>
#include <cstdio>
#include <cstdint>
namespace cg = cooperative_groups;

namespace pg8 {
#define PG8_LAS __attribute__((address_space(3)))
typedef unsigned short bf16_t;
typedef short bf16x8 __attribute__((ext_vector_type(8)));
typedef float f32x4 __attribute__((ext_vector_type(4)));
typedef unsigned u32x4 __attribute__((ext_vector_type(4)));
constexpr int BM = 256, BK = 64, HALF = 128, HTB = HALF * BK * 2  , STAGE_BYTES = 8 * HTB, NXCD = 8, WGM = 8;

__host__ __device__ __forceinline__ int lds_byte(int r, int c) { const int st = (r >> 4) * 2 + (c >> 5), rr = r & 15, cc = c & 31, ob = rr * 64 + cc * 2; return st * 1024 + (ob ^ (((ob >> 9) & 1) << 5)); }
__host__ __device__ __forceinline__ void stage_rc(int b, int& R, int& C) { const int st = b / 1024, sb = b % 1024, swz = sb ^ (((sb >> 9) & 1) << 5); R = (st >> 1) * 16 + swz / 64; C = (st & 1) * 32 + (swz % 64) / 2; }
__host__ __device__ __forceinline__ int perm32(int rho) { const int n = rho >> 4, i = rho & 15; return 8 * (i >> 2) + 4 * n + (i & 3); }

struct Unit { int pm, pn; };
struct Gemm { const bf16_t* A; const bf16_t* Bt; int M, N, K, lda, ldb, acs; };

struct StaticOrder {
    int nM, nN, nwg, G, c, rep;
    __host__ __device__ void init(int M, int N, int G_, int c_, int rep_ = 1) { nM = M / BM; nN = N / BM; nwg = nM * nN; G = G_; c = c_; rep = rep_; }
    __host__ __device__ bool next(int i, Unit& u) const {
        const int R = (nwg + G - 1) / G;
        if (i >= R * rep) return false;
        const long L = (long)(i % R) * G + c; if (L >= nwg) return (i + 1 < R * rep) ? next(i + 1, u) : false;
        int wgid = (int)L; { const int q = nwg / NXCD, r = nwg % NXCD, xcd = wgid % NXCD, off = wgid / NXCD; wgid = (xcd < r ? xcd * (q + 1) : r * (q + 1) + (xcd - r) * q) + off; }
        const int nig = WGM * nN, gid = wgid / nig, fm = gid * WGM, gsz = (nM - fm) < WGM ? (nM - fm) : WGM;
        u.pm = fm + ((wgid % nig) % gsz); u.pn = (wgid % nig) / gsz; return true;
    }
    __device__ __forceinline__ void a_ready(const Unit&) const {}
    __device__ __forceinline__ void done(const Unit&) const {}
};


__device__ __forceinline__ unsigned cvt_pk_bf16(float lo, float hi) { unsigned r; asm volatile("v_cvt_pk_bf16_f32 %0, %1, %2" : "=v"(r) : "v"(lo), "v"(hi)); return r; }

struct EpiF32 {
    static constexpr bool PERM = false, AFTER_DRAIN = false;
    float* C; int ldc;
    __device__ __forceinline__ void operator()(const f32x4 (&acc)[2][2][4][2], const Unit& u, int wr, int wc, int fr, int fq) const {
        const int row0 = u.pm * BM + wr * 64 + fr, col0 = u.pn * BM + wc * 32 + 4 * fq;
#pragma unroll
        for (int ai = 0; ai < 2; ++ai)
#pragma unroll
            for (int m = 0; m < 4; ++m) { float* rowp = C + (size_t)(row0 + ai * HALF + m * 16) * ldc + col0;
#pragma unroll
                for (int bj = 0; bj < 2; ++bj)
#pragma unroll
                    for (int n = 0; n < 2; ++n) *(f32x4*)(rowp + bj * HALF + n * 16) = acc[ai][bj][m][n]; }
    }
};
template <int ACT> struct EpiBf16 {
    static constexpr bool PERM = true, AFTER_DRAIN = false;
    bf16_t* O; int ldc; int col_off; const float* colscale;
    __device__ __forceinline__ void operator()(const f32x4 (&acc)[2][2][4][2], const Unit& u, int wr, int wc, int fr, int fq) const {
        const int row0 = u.pm * BM + wr * 64 + fr; const int col0 = u.pn * BM + wc * 32 + 8 * fq;
#pragma unroll
        for (int bj = 0; bj < 2; ++bj) {
            f32x4 sv0 = (f32x4){1.f, 1.f, 1.f, 1.f}, sv1 = sv0;
            if (ACT == 0) { sv0 = *(const f32x4*)(colscale + col0 + bj * HALF); sv1 = *(const f32x4*)(colscale + col0 + bj * HALF + 4); }
#pragma unroll
            for (int ai = 0; ai < 2; ++ai)
#pragma unroll
                for (int m = 0; m < 4; ++m) { bf16_t* rowp = O + (size_t)(row0 + ai * HALF + m * 16) * ldc + col_off + col0;
                    f32x4 v0 = acc[ai][bj][m][0], v1 = acc[ai][bj][m][1];
                    if (ACT == 0) { v0 = v0 * sv0; v1 = v1 * sv1; }
                    if (ACT == 1) {
#pragma unroll
                        for (int j = 0; j < 4; ++j) { const float a = fmaxf(v0[j], 0.f), b = fmaxf(v1[j], 0.f); v0[j] = a * a; v1[j] = b * b; } }
                    u32x4 w; w.x = cvt_pk_bf16(v0[0], v0[1]); w.y = cvt_pk_bf16(v0[2], v0[3]); w.z = cvt_pk_bf16(v1[0], v1[1]); w.w = cvt_pk_bf16(v1[2], v1[3]);
                    *(u32x4*)(rowp + bj * HALF) = w; }
        }
    }
};
struct EpiRes {
    static constexpr bool PERM = false, AFTER_DRAIN = false;
    float* C; const float* R;
    __device__ __forceinline__ void operator()(const f32x4 (&acc)[2][2][4][2], const Unit& u, int wr, int wc, int fr, int fq) const {
        const int row0 = u.pm * BM + wr * 64 + fr, col0 = u.pn * BM + wc * 32 + 4 * fq;
#pragma unroll
        for (int ai = 0; ai < 2; ++ai)
#pragma unroll
            for (int m = 0; m < 4; ++m) { const size_t off = (size_t)(row0 + ai * HALF + m * 16) * 2048 + col0;
#pragma unroll
                for (int bj = 0; bj < 2; ++bj)
#pragma unroll
                    for (int n = 0; n < 2; ++n) { const f32x4 rv = *(const f32x4*)(R + off + bj * HALF + n * 16);
                        *(f32x4*)(C + off + bj * HALF + n * 16) = acc[ai][bj][m][n] + rv; } }
    }
};


template <class Epi, class Sched, bool ALIGN_EPI = false, bool SP2 = false>
__device__ __forceinline__ void gemm_phase(PG8_LAS unsigned char* lds, const Gemm g, const Sched& S, const Epi& E) {
    const int tid = threadIdx.x, wid = __builtin_amdgcn_readfirstlane(tid >> 6), lane = tid & 63, wr = wid >> 2, wc = wid & 3, fr = lane & 15, fq = lane >> 4;
    const int K = g.K, nt = K / BK;
    unsigned voffA[2], voffB[2];
#pragma unroll
    for (int i = 0; i < 2; ++i) { int R, C; stage_rc(tid * 16 + i * 8192, R, C); const int Rb = Epi::PERM ? ((R & ~31) + perm32(R & 31)) : R;
        voffA[i] = (unsigned)(R * g.lda + C) * 2u; voffB[i] = (unsigned)(Rb * g.ldb + C) * 2u; }
    const size_t kstep = (size_t)(BK * 2);
    const size_t hstepA = (size_t)HALF * g.lda * 2, hstepB = (size_t)HALF * g.ldb * 2;
    const size_t tstepA = 2 * hstepA, tstepB = 2 * hstepB;
    const size_t acs2 = (size_t)g.acs * 2;
    const unsigned ldsw = (unsigned)wid * 1024u;
    const int aoff = lds_byte(wr * 64 + fr, fq * 8), boff = lds_byte(wc * 32 + fr, fq * 8);
#define PG8_SA(b, h) (((b) * 2 + (h)) * HTB)
#define PG8_SB(b, h) ((4 + (b) * 2 + (h)) * HTB)
#define PG8_STAGE(bufoff, gbase, voff) do { _Pragma("unroll") for (int _i = 0; _i < 2; ++_i) \
        __builtin_amdgcn_global_load_lds((const unsigned*)((const char*)(gbase) + (voff)[_i]), (PG8_LAS unsigned*)(lds + (bufoff) + ldsw + _i * 8192), 16, 0, 0); } while (0)
#define PG8_LDA(dst, b, h) do { _Pragma("unroll") for (int m = 0; m < 4; ++m) _Pragma("unroll") for (int k = 0; k < 2; ++k) dst[m][k] = *(const PG8_LAS bf16x8*)(lds + PG8_SA(b, h) + aoff + m * 2048 + k * 1024); } while (0)
#define PG8_LDB(dst, b, h) do { _Pragma("unroll") for (int n = 0; n < 2; ++n) _Pragma("unroll") for (int k = 0; k < 2; ++k) dst[n][k] = *(const PG8_LAS bf16x8*)(lds + PG8_SB(b, h) + boff + n * 2048 + k * 1024); } while (0)
#define PG8_MMA(ai, bj, At, Bt) do { __builtin_amdgcn_s_setprio(1); _Pragma("unroll") for (int m = 0; m < 4; ++m) _Pragma("unroll") for (int n = 0; n < 2; ++n) _Pragma("unroll") for (int k = 0; k < 2; ++k) \
        acc[ai][bj][m][n] = __builtin_amdgcn_mfma_f32_16x16x32_bf16(Bt[n][k], At[m][k], acc[ai][bj][m][n], 0, 0, 0); __builtin_amdgcn_s_setprio(0); } while (0)
#define PG8_WAIT_V(n) asm volatile("s_waitcnt vmcnt(" #n ")" ::: "memory")
#define PG8_WAIT_L(n) asm volatile("s_waitcnt lgkmcnt(" #n ")" ::: "memory")
#define PG8_BAR __builtin_amdgcn_s_barrier()
#define PG8_SCHED __builtin_amdgcn_sched_barrier(0)
    Unit cur, nxt; int ui = 0;
    if (!S.next(0, cur)) return;
    f32x4 acc[2][2][4][2];
#pragma unroll
    for (int a = 0; a < 2; ++a)
#pragma unroll
        for (int b = 0; b < 2; ++b)
#pragma unroll
            for (int m = 0; m < 4; ++m)
#pragma unroll
                for (int n = 0; n < 2; ++n) acc[a][b][m][n] = (f32x4){0.f, 0.f, 0.f, 0.f};
    bf16x8 At[4][2], B0[2][2], B1[2][2];
    const char* cA = (const char*)g.A + (size_t)cur.pm * tstepA + (size_t)cur.pn * acs2; const char* cB = (const char*)g.Bt + (size_t)cur.pn * tstepB;
    S.a_ready(cur);
    if constexpr (SP2) {
        PG8_STAGE(PG8_SB(0, 0), cB, voffB); PG8_STAGE(PG8_SB(0, 1), cB + hstepB, voffB); PG8_STAGE(PG8_SA(0, 0), cA, voffA); PG8_STAGE(PG8_SA(0, 1), cA + hstepA, voffA);
        if (wr == 1) PG8_BAR;
        PG8_WAIT_V(2); PG8_BAR;
        PG8_STAGE(PG8_SB(1, 0), cB + kstep, voffB); PG8_STAGE(PG8_SA(1, 0), cA + kstep, voffA); PG8_STAGE(PG8_SB(1, 1), cB + hstepB + kstep, voffB);
        PG8_WAIT_V(6); PG8_BAR;
    } else {
        PG8_STAGE(PG8_SB(0, 0), cB, voffB); PG8_STAGE(PG8_SA(0, 0), cA, voffA); PG8_STAGE(PG8_SB(0, 1), cB + hstepB, voffB); PG8_STAGE(PG8_SA(0, 1), cA + hstepA, voffA);
        if (wr == 1) PG8_BAR;
        PG8_WAIT_V(4); PG8_BAR;
        PG8_STAGE(PG8_SB(1, 0), cB + kstep, voffB); PG8_STAGE(PG8_SA(1, 0), cA + kstep, voffA); PG8_STAGE(PG8_SB(1, 1), cB + hstepB + kstep, voffB);
        PG8_WAIT_V(6); PG8_BAR;
    }
    for (;;) {
        const bool has_next = S.next(ui + 1, nxt);
        const char* nA = has_next ? (const char*)g.A + (size_t)nxt.pm * tstepA + (size_t)nxt.pn * acs2 : cA; const char* nB = has_next ? (const char*)g.Bt + (size_t)nxt.pn * tstepB : cB;
        for (int t = 0; t < nt; t += 2) {
            const bool last = (t == nt - 2);
            const char* a1 = cA + (size_t)(t + 1) * kstep;
            const char* a2 = last ? nA : cA + (size_t)(t + 2) * kstep; const char* b2 = last ? nB : cB + (size_t)(t + 2) * kstep;
            const char* a3 = a2 + kstep; const char* b3 = b2 + kstep;
            if (last && has_next) S.a_ready(nxt);
            if constexpr (SP2) {
            PG8_LDB(B0, 0, 0); PG8_LDB(B1, 0, 1); PG8_SCHED; PG8_LDA(At, 0, 0); PG8_STAGE(PG8_SA(1, 1), a1 + hstepA, voffA);
            PG8_WAIT_V(8); PG8_WAIT_L(0); PG8_BAR; PG8_MMA(0, 0, At, B0); PG8_MMA(0, 1, At, B1); PG8_BAR; PG8_SCHED;
            PG8_LDA(At, 0, 1); PG8_STAGE(PG8_SB(0, 0), b2, voffB); PG8_STAGE(PG8_SB(0, 1), b2 + hstepB, voffB); PG8_STAGE(PG8_SA(0, 0), a2, voffA);
            PG8_WAIT_V(8); PG8_WAIT_L(0); PG8_BAR; PG8_MMA(1, 0, At, B0); PG8_MMA(1, 1, At, B1); PG8_BAR; PG8_SCHED;
            PG8_LDB(B0, 1, 0); PG8_LDB(B1, 1, 1); PG8_SCHED; PG8_LDA(At, 1, 0); PG8_STAGE(PG8_SA(0, 1), a2 + hstepA, voffA);
            PG8_WAIT_V(8); PG8_WAIT_L(0); PG8_BAR; PG8_MMA(0, 0, At, B0); PG8_MMA(0, 1, At, B1); PG8_BAR; PG8_SCHED;
            PG8_LDA(At, 1, 1); PG8_STAGE(PG8_SB(1, 0), b3, voffB); PG8_STAGE(PG8_SB(1, 1), b3 + hstepB, voffB); PG8_STAGE(PG8_SA(1, 0), a3, voffA);
            PG8_WAIT_V(8); PG8_WAIT_L(0); PG8_BAR; PG8_MMA(1, 0, At, B0); PG8_MMA(1, 1, At, B1); PG8_BAR; PG8_SCHED;
            } else {
            PG8_LDB(B0, 0, 0); PG8_SCHED; PG8_LDA(At, 0, 0); PG8_STAGE(PG8_SA(1, 1), a1 + hstepA, voffA);
            PG8_WAIT_L(8); PG8_BAR; PG8_WAIT_L(0); PG8_MMA(0, 0, At, B0); PG8_BAR; PG8_SCHED;
            PG8_LDB(B1, 0, 1); PG8_STAGE(PG8_SB(0, 0), b2, voffB);
            PG8_BAR; PG8_WAIT_L(0); PG8_MMA(0, 1, At, B1); PG8_BAR;
            PG8_LDA(At, 0, 1); PG8_STAGE(PG8_SA(0, 0), a2, voffA);
            PG8_BAR; PG8_WAIT_L(0); PG8_MMA(1, 0, At, B0); PG8_BAR; PG8_SCHED;
            PG8_STAGE(PG8_SB(0, 1), b2 + hstepB, voffB);
            PG8_WAIT_V(6); PG8_BAR; PG8_MMA(1, 1, At, B1); PG8_BAR;
            PG8_LDB(B0, 1, 0); PG8_SCHED; PG8_LDA(At, 1, 0); PG8_STAGE(PG8_SA(0, 1), a2 + hstepA, voffA);
            PG8_WAIT_L(8); PG8_BAR; PG8_WAIT_L(0); PG8_MMA(0, 0, At, B0); PG8_BAR; PG8_SCHED;
            PG8_LDB(B1, 1, 1); PG8_STAGE(PG8_SB(1, 0), b3, voffB);
            PG8_BAR; PG8_WAIT_L(0); PG8_MMA(0, 1, At, B1); PG8_BAR;
            PG8_LDA(At, 1, 1); PG8_STAGE(PG8_SA(1, 0), a3, voffA);
            PG8_BAR; PG8_WAIT_L(0); PG8_MMA(1, 0, At, B0); PG8_BAR; PG8_SCHED;
            PG8_STAGE(PG8_SB(1, 1), b3 + hstepB, voffB);
            PG8_WAIT_V(6); PG8_BAR; PG8_MMA(1, 1, At, B1); PG8_BAR;
            }
        }
        if constexpr (ALIGN_EPI) { if (wr == 0) PG8_BAR; }
        if constexpr (!Epi::AFTER_DRAIN) { E(acc, cur, wr, wc, fr, fq); S.done(cur); }
        if (!has_next) break;
#pragma unroll
        for (int a = 0; a < 2; ++a)
#pragma unroll
            for (int b = 0; b < 2; ++b)
#pragma unroll
                for (int m = 0; m < 4; ++m)
#pragma unroll
                    for (int n = 0; n < 2; ++n) acc[a][b][m][n] = (f32x4){0.f, 0.f, 0.f, 0.f};
        cur = nxt; cA = nA; cB = nB; ++ui;
        if constexpr (ALIGN_EPI) { if (wr == 1) PG8_BAR; }
    }
    PG8_WAIT_V(0);
    if constexpr (!ALIGN_EPI) { if (wr == 0) PG8_BAR; }
    PG8_BAR;
    if constexpr (Epi::AFTER_DRAIN) { E.fused(acc, cur, wr, wc, fr, fq, lds, wid, lane); S.done(cur); }
#undef PG8_SA
#undef PG8_SB
#undef PG8_STAGE
#undef PG8_LDA
#undef PG8_LDB
#undef PG8_MMA
#undef PG8_WAIT_V
#undef PG8_WAIT_L
#undef PG8_BAR
#undef PG8_SCHED
}
}

#ifndef PG8_SP2
#define PG8_SP2 true
#endif
#ifndef PG8_ALIGN
#define PG8_ALIGN true
#endif
#ifndef MK_ONE_LAUNCH
#define MK_ONE_LAUNCH 1
#endif

constexpr int DM = 2048, SEQ = 8192, NMETA = 16, TP = SEQ + NMETA, DB = 128, MR = TP + DB, MP = 8448;
constexpr int HD = 128, NH = 8, NKV = 2, NIH = 16, IDD = 64, TOPK = 256, NZR = 3664, NZ = 3840, DFF = 8192;
constexpr int PAST = 2048, PAGE = 128, NPAGES = 16, LS = PAST + 1;
constexpr int ZQ = 0, ZK = 1024, ZV = 1280, ZQI = 1536, ZKI = 2560, ZWI = 2624, ZU = 2640;
constexpr float EPS = 1e-6f;
constexpr int SCLD = 8256, SCROWS = 8224, SCSLD = 2304;
constexpr size_t O_YP = 0, O_YS = O_YP + (size_t)SEQ * DM, O_KP = O_YS + (size_t)DB * DM, O_VP = O_KP + (size_t)TP * 256, O_KIP = O_VP + (size_t)TP * 256,
                 O_PP = O_KIP + (size_t)TP * 64, O_KS = O_PP + 15 * 1024, O_VS = O_KS + DB * 256, O_KIS = O_VS + DB * 256, O_PS = O_KIS + DB * 64, O_END = O_PS + (size_t)DB * 15 * 1024;
constexpr size_t MiB = 1u << 20;
constexpr size_t WS_CTL = 0, WS_WIN = 2 * MiB, WS_WOUT = 18 * MiB, WS_WUP = 26 * MiB, WS_WDN = 58 * MiB, WS_WPOOL = 90 * MiB, WS_XN = 92 * MiB, WS_Z = 126 * MiB,
                 WS_QF = 250 * MiB, WS_QI = 284 * MiB, WS_KI = 302 * MiB, WS_WI = 304 * MiB, WS_U = 306 * MiB, WS_QI32 = 340 * MiB, WS_SCS = 341 * MiB, WS_SEL = 344 * MiB,
                 WS_DPOOL = 356 * MiB, WS_CAT = 374 * MiB, WS_H1 = 408 * MiB, WS_ACT = 476 * MiB, WS_H2 = 608 * MiB, WS_SC = 676 * MiB, WS_PS1 = 936 * MiB, WS_PS2 = 944 * MiB, WS_QB = 952 * MiB, WS_KB = 970 * MiB, WS_VB = 975 * MiB, WS_QL = 980 * MiB, WS_CS = 984 * MiB, WS_END = 992 * MiB;
static_assert(WS_Z + (size_t)MP * NZ * 4 <= WS_QF && WS_SC + (size_t)SCROWS * SCLD * 4 <= WS_PS1 && WS_ACT + (size_t)MP * DFF * 2 <= WS_H2, "ws map");
constexpr int LDS_BYTES = 163840;
constexpr int NPH = 12;

#define LAS __attribute__((address_space(3)))
typedef unsigned short bf16;
typedef unsigned v4u __attribute__((ext_vector_type(4)));
typedef float f32x4 __attribute__((ext_vector_type(4)));
typedef float f32x16 __attribute__((ext_vector_type(16)));
typedef _Float16 f16x8 __attribute__((ext_vector_type(8)));
typedef _Float16 f16;
typedef short bf16x8_t __attribute__((ext_vector_type(8)));

__device__ const double INV_FREQ[64] = { 1.00000000000000000e+00, 8.65964323360065347e-01, 7.49894209332455874e-01, 6.49381631576211316e-01, 5.62341325190349073e-01, 4.86967525165863113e-01, 4.21696503428582226e-01, 3.65174127254837722e-01, 3.16227766016837941e-01, 2.73841963426436130e-01, 2.37137370566165517e-01, 2.05352502645714613e-01, 1.77827941003892293e-01, 1.53992652605949187e-01, 1.33352143216332403e-01, 1.15478198468945817e-01, 1.00000000000000006e-01, 8.65964323360065291e-02, 7.49894209332455791e-02, 6.49381631576211316e-02, 5.62341325190349114e-02, 4.86967525165863113e-02, 4.21696503428582239e-02, 3.65174127254837694e-02, 3.16227766016837913e-02, 2.73841963426436144e-02, 2.37137370566165538e-02, 2.05352502645714599e-02, 1.77827941003892293e-02, 1.53992652605949194e-02, 1.33352143216332406e-02, 1.15478198468945813e-02, 1.00000000000000002e-02, 8.65964323360065430e-03, 7.49894209332455791e-03, 6.49381631576211298e-03, 5.62341325190349097e-03, 4.86967525165863096e-03, 4.21696503428582292e-03, 3.65174127254837711e-03, 3.16227766016837939e-03, 2.73841963426436127e-03, 2.37137370566165538e-03, 2.05352502645714599e-03, 1.77827941003892275e-03, 1.53992652605949203e-03, 1.33352143216332406e-03, 1.15478198468945813e-03, 1.00000000000000002e-03, 8.65964323360065387e-04, 7.49894209332455856e-04, 6.49381631576211342e-04, 5.62341325190349097e-04, 4.86967525165863096e-04, 4.21696503428582237e-04, 3.65174127254837700e-04, 3.16227766016837939e-04, 2.73841963426436105e-04, 2.37137370566165538e-04, 2.05352502645714610e-04, 1.77827941003892270e-04, 1.53992652605949192e-04, 1.33352143216332395e-04, 1.15478198468945822e-04 };

struct Args { const float* in[17]; float* out; unsigned char* ws; int ph_lo, ph_hi; };
constexpr int CW_BAR = 4096;
constexpr int LDSCTL_OFF = 159744, MISC_OFF = LDSCTL_OFF + 320;

#define LDS_WAIT() asm volatile("s_waitcnt lgkmcnt(0)" ::: "memory")
__device__ __forceinline__ unsigned f2bf(float f) { unsigned u = __builtin_bit_cast(unsigned, f); return (u + 0x7fffu + ((u >> 16) & 1u)) >> 16; }
__device__ __forceinline__ unsigned pk2(float lo, float hi) { return f2bf(lo) | (f2bf(hi) << 16); }
__device__ __forceinline__ float wave_sum(float v) {
#pragma unroll
    for (int o = 1; o < 64; o <<= 1) v += __shfl_xor(v, o);
    return v;
}
__device__ __forceinline__ const float* in_row(const Args& a, int r) {
    return r < NMETA ? a.in[7] + (size_t)r * DM : r < TP ? a.in[0] + (size_t)(r - NMETA) * DM : r < MR ? a.in[1] + (size_t)(r - TP) * DM : (const float*)nullptr;
}

__device__ __forceinline__ int win_src_col(int n) {
    const int pn = n >> 8, c = n & 255, half = c >> 7, cc = c & 127;
    if (pn < 4) return ZQ + (2 * pn + (cc >> 6)) * 128 + half * 64 + (cc & 63);
    if (pn == 4) return ZK + (cc >> 6) * 128 + half * 64 + (cc & 63);
    if (pn == 5) return ZV + c;
    if (pn < 10) return ZQI + (4 * (pn - 6) + (cc >> 5)) * 64 + half * 32 + (cc & 31);
    if (pn == 10) return c < 32 ? ZKI + c : c < 48 ? ZWI + (c - 32) : (c >= 128 && c < 160) ? ZKI + 32 + (c - 128) : -1;
    return ZU + (pn - 11) * 256 + c;
}
template <bool WIN = false>
__device__ __forceinline__ void p0_transpose_item(const float* W, int K, int N, bf16* WT, LAS float* scr, int item, int nblk, int lane) {
    const int kb = item / nblk, nb = item % nblk, k0 = 64 * kb, n0 = 32 * nb;
    const int n_rd = WIN ? win_src_col(n0 + (lane & 31)) : ((n0 + (lane & 31)) < N ? n0 + (lane & 31) : -1);
    float rv[32];
#pragma unroll
    for (int i = 0; i < 32; ++i) { const int kk = 2 * i + (lane >> 5); rv[i] = n_rd >= 0 ? W[(size_t)(k0 + kk) * N + n_rd] : 0.f; }
#pragma unroll
    for (int i = 0; i < 32; ++i) { const int kk = 2 * i + (lane >> 5); scr[kk * 33 + (lane & 31)] = rv[i]; }
    LDS_WAIT();
    const int c = lane & 7;
#pragma unroll
    for (int j = 0; j < 4; ++j) { const int n = (lane >> 3) + 8 * j; const LAS float* s = scr + (8 * c) * 33 + n;
        v4u o; o.x = pk2(s[0 * 33], s[1 * 33]); o.y = pk2(s[2 * 33], s[3 * 33]); o.z = pk2(s[4 * 33], s[5 * 33]); o.w = pk2(s[6 * 33], s[7 * 33]);
        *(v4u*)(WT + (size_t)(n0 + n) * K + k0 + 8 * c) = o; }
    LDS_WAIT();
}
#ifndef CONV_IN_ATTN
#define CONV_IN_ATTN 1
#endif
constexpr int CV_OUT = 32 * 64, CV_UP = 32 * 256, CV_DN = 128 * 64, CV_N = CV_OUT + CV_UP + CV_DN;
__device__ __forceinline__ void conv_item(const Args& a, LAS float* scr, int it, int lane) {
    unsigned char* ws = a.ws;
    if (it < CV_OUT) { p0_transpose_item(a.in[12], DM, DM, (bf16*)(ws + WS_WOUT), scr, it, 64, lane); return; } it -= CV_OUT;
    if (it < CV_UP) { p0_transpose_item(a.in[14], DM, DFF, (bf16*)(ws + WS_WUP), scr, it, 256, lane); return; } it -= CV_UP;
    p0_transpose_item(a.in[15], DFF, DM, (bf16*)(ws + WS_WDN), scr, it, 64, lane);
}
__device__ __forceinline__ void p0_transpose_pair(const float* W, int K, int N, bf16* WT, LAS float* scrA, LAS float* scrB, int itemA, int itemB, int nblk, int lane) {
    const int k0a = 64 * (itemA / nblk), n0a = 32 * (itemA % nblk), k0b = 64 * (itemB / nblk), n0b = 32 * (itemB % nblk);
    const int na = n0a + (lane & 31), nb = n0b + (lane & 31);
    float ra[32], rb[32];
#pragma unroll
    for (int i = 0; i < 32; ++i) { const int kk = 2 * i + (lane >> 5); ra[i] = W[(size_t)(k0a + kk) * N + na]; rb[i] = W[(size_t)(k0b + kk) * N + nb]; }
#pragma unroll
    for (int i = 0; i < 32; ++i) { const int kk = 2 * i + (lane >> 5); scrA[kk * 33 + (lane & 31)] = ra[i]; scrB[kk * 33 + (lane & 31)] = rb[i]; }
    LDS_WAIT();
    const int c = lane & 7;
#pragma unroll
    for (int j = 0; j < 4; ++j) { const int n = (lane >> 3) + 8 * j; const LAS float* sa = scrA + (8 * c) * 33 + n; const LAS float* sb = scrB + (8 * c) * 33 + n;
        v4u o; o.x = pk2(sa[0 * 33], sa[1 * 33]); o.y = pk2(sa[2 * 33], sa[3 * 33]); o.z = pk2(sa[4 * 33], sa[5 * 33]); o.w = pk2(sa[6 * 33], sa[7 * 33]);
        *(v4u*)(WT + (size_t)(n0a + n) * K + k0a + 8 * c) = o;
        v4u q; q.x = pk2(sb[0 * 33], sb[1 * 33]); q.y = pk2(sb[2 * 33], sb[3 * 33]); q.z = pk2(sb[4 * 33], sb[5 * 33]); q.w = pk2(sb[6 * 33], sb[7 * 33]);
        *(v4u*)(WT + (size_t)(n0b + n) * K + k0b + 8 * c) = q; }
    LDS_WAIT();
}
__device__ __forceinline__ void conv_pair(const Args& a, LAS float* scrA, LAS float* scrB, int itA, int itB, int lane) {
    unsigned char* ws = a.ws;
    if (itB < CV_OUT) { p0_transpose_pair(a.in[12], DM, DM, (bf16*)(ws + WS_WOUT), scrA, scrB, itA, itB, 64, lane); return; }
    if (itA >= CV_OUT && itB < CV_OUT + CV_UP) { p0_transpose_pair(a.in[14], DM, DFF, (bf16*)(ws + WS_WUP), scrA, scrB, itA - CV_OUT, itB - CV_OUT, 256, lane); return; }
    if (itA >= CV_OUT + CV_UP) { p0_transpose_pair(a.in[15], DFF, DM, (bf16*)(ws + WS_WDN), scrA, scrB, itA - CV_OUT - CV_UP, itB - CV_OUT - CV_UP, 64, lane); return; }
    conv_item(a, scrA, itA, lane); conv_item(a, scrA, itB, lane);
}
__device__ __forceinline__ void rms_row_to_bf16(const float* xrow, const float* gain, bf16* orow, int lane) {
    const f32x4* xr = (const f32x4*)xrow + lane; const f32x4* gr = (const f32x4*)gain + lane;
    f32x4 v[8]; float s = 0.f;
#pragma unroll
    for (int j = 0; j < 8; ++j) { v[j] = xr[64 * j]; s += (v[j].x * v[j].x + v[j].y * v[j].y) + (v[j].z * v[j].z + v[j].w * v[j].w); }
    const float rstd = 1.f / sqrtf(wave_sum(s) * (1.f / DM) + EPS);
    unsigned long long* o8 = (unsigned long long*)orow + lane;
#pragma unroll
    for (int j = 0; j < 8; ++j) { const f32x4 g = gr[64 * j]; o8[64 * j] = (unsigned long long)pk2(v[j].x * rstd * g.x, v[j].y * rstd * g.y) | ((unsigned long long)pk2(v[j].z * rstd * g.z, v[j].w * rstd * g.w) << 32); }
}
__device__ __forceinline__ void rope_cs(int pos, int j, float& c, float& s) {
    const double x = (double)pos * INV_FREQ[j];
    const double n = __builtin_rint(x * 0.15915494309189535);
    const double r = __builtin_fma(-n, 6.283185307179586, x);
    const float rf = (float)r; c = cosf(rf); s = sinf(rf);
}
__device__ __forceinline__ void p0_prep(const Args& a, LAS unsigned char* lds, int gw, int NGW, int wave, int lane) {
    LAS float* scr = (LAS float*)(lds + wave * 16384);
    unsigned char* ws = a.ws;
    constexpr int I_IN = 32 * 120, I_PL = 4 * 32;
    for (int it = gw; it < I_IN + I_PL + (CONV_IN_ATTN ? 0 : CV_N); it += NGW) {
        if (it < I_IN) p0_transpose_item<true>(a.in[9], DM, NZR, (bf16*)(ws + WS_WIN), scr, it, 120, lane);
        else if (it < I_IN + I_PL) { const int r = it - I_IN, g = r >> 5; p0_transpose_item(a.in[10] + (size_t)g * 65536, 256, 256, (bf16*)(ws + WS_WPOOL) + (size_t)g * 65536, scr, r & 31, 8, lane); }
        else conv_item(a, scr, it - I_IN - I_PL, lane);
    }
    bf16* XN = (bf16*)(ws + WS_XN);
    for (int m = gw; m < MP; m += NGW) {
        const float* xr = in_row(a, m);
        if (xr) rms_row_to_bf16(xr, a.in[8], XN + (size_t)m * DM, lane);
        else { v4u z = {0u, 0u, 0u, 0u}; v4u* o = (v4u*)(XN + (size_t)m * DM) + lane;
#pragma unroll
            for (int j = 0; j < 4; ++j) o[64 * j] = z; }
    }
    float* CS = (float*)(ws + WS_CS);
    for (int pos = gw; pos < TP; pos += NGW) { float c1, s1; rope_cs(pos, lane, c1, s1); CS[(size_t)pos * 192 + lane] = c1; CS[(size_t)pos * 192 + 64 + lane] = s1;
        if (lane < 32) { float c2, s2; rope_cs(pos, 2 * lane, c2, s2); CS[(size_t)pos * 192 + 128 + lane] = c2; CS[(size_t)pos * 192 + 160 + lane] = s2; } }
    for (int i = gw * 64 + lane; i < DB * 14 * 256; i += NGW * 64) { const int b = i / (14 * 256), rem = i % (14 * 256);
        *((f32x4*)(a.out + O_PS + (size_t)b * 15 * 1024) + rem) = *((const f32x4*)(a.in[5] + ((size_t)b * 15 + 1) * 1024) + rem); }
}

namespace pg8 {
struct EpiIn {
    static constexpr bool PERM = true, AFTER_DRAIN = false;
    float* out; unsigned char* ws;
    __device__ __forceinline__ void operator()(const f32x4 (&acc)[2][2][4][2], const Unit& u, int wr, int wc, int fr, int fq) const {
        constexpr float QSCALE = 0.12751743074602957f;
        typedef _Float16 f16x8v __attribute__((ext_vector_type(8)));
        const float* CS = (const float*)(ws + WS_CS);
        const int pn = u.pn;
        const int c0 = 32 * wc + 8 * fq;
#pragma unroll
        for (int ai = 0; ai < 2; ++ai)
#pragma unroll
            for (int m = 0; m < 4; ++m) {
                const int r = u.pm * BM + ai * HALF + wr * 64 + m * 16 + fr;
                if (r >= MR) continue;
                const bool smp = r >= TP; const int b = r - TP; const float* cs = CS + (size_t)(smp ? PAST : r) * 192;
                if (pn < 5) {
                    const int hd = c0 >> 6, j0 = c0 & 63;
                    f32x4 o1[2], o2[2];
#pragma unroll
                    for (int n = 0; n < 2; ++n) { const f32x4 co = *(const f32x4*)(cs + j0 + 4 * n), si = *(const f32x4*)(cs + 64 + j0 + 4 * n), x1 = acc[ai][0][m][n], x2 = acc[ai][1][m][n];
                        o1[n] = x1 * co - x2 * si; o2[n] = x1 * si + x2 * co; }
                    if (pn < 4) { ::bf16* q = (::bf16*)(ws + WS_QB) + (size_t)r * 1024 + (2 * pn + hd) * 128 + j0;
                        v4u a_, b_; a_.x = pk2(o1[0].x * QSCALE, o1[0].y * QSCALE); a_.y = pk2(o1[0].z * QSCALE, o1[0].w * QSCALE); a_.z = pk2(o1[1].x * QSCALE, o1[1].y * QSCALE); a_.w = pk2(o1[1].z * QSCALE, o1[1].w * QSCALE);
                        b_.x = pk2(o2[0].x * QSCALE, o2[0].y * QSCALE); b_.y = pk2(o2[0].z * QSCALE, o2[0].w * QSCALE); b_.z = pk2(o2[1].x * QSCALE, o2[1].y * QSCALE); b_.w = pk2(o2[1].z * QSCALE, o2[1].w * QSCALE);
                        *(v4u*)q = a_; *(v4u*)(q + 64) = b_; }
                    else { float* ko = (smp ? out + O_KS + (size_t)b * 256 : out + O_KP + (size_t)r * 256) + hd * 128 + j0;
                        *(f32x4*)ko = o1[0]; *(f32x4*)(ko + 4) = o1[1]; *(f32x4*)(ko + 64) = o2[0]; *(f32x4*)(ko + 68) = o2[1];
                        ::bf16* kb = (::bf16*)(ws + WS_KB) + (size_t)r * 256 + hd * 128 + j0;
                        v4u a_, b_; a_.x = pk2(o1[0].x, o1[0].y); a_.y = pk2(o1[0].z, o1[0].w); a_.z = pk2(o1[1].x, o1[1].y); a_.w = pk2(o1[1].z, o1[1].w);
                        b_.x = pk2(o2[0].x, o2[0].y); b_.y = pk2(o2[0].z, o2[0].w); b_.z = pk2(o2[1].x, o2[1].y); b_.w = pk2(o2[1].z, o2[1].w);
                        *(v4u*)kb = a_; *(v4u*)(kb + 64) = b_; }
                } else if (pn == 5) {
#pragma unroll
                    for (int bj = 0; bj < 2; ++bj) { const int c = 128 * bj + c0; const f32x4 v0 = acc[ai][bj][m][0], v1 = acc[ai][bj][m][1];
                        float* vo = (smp ? out + O_VS + (size_t)b * 256 : out + O_VP + (size_t)r * 256) + c; *(f32x4*)vo = v0; *(f32x4*)(vo + 4) = v1;
                        v4u a_; a_.x = pk2(v0.x, v0.y); a_.y = pk2(v0.z, v0.w); a_.z = pk2(v1.x, v1.y); a_.w = pk2(v1.z, v1.w);
                        *(v4u*)((::bf16*)(ws + WS_VB) + (size_t)r * 256 + c) = a_; }
                } else if (pn < 10) {
                    const int hd = 4 * (pn - 6) + (c0 >> 5), j0 = c0 & 31;
                    f32x4 o1[2], o2[2];
#pragma unroll
                    for (int n = 0; n < 2; ++n) { const f32x4 co = *(const f32x4*)(cs + 128 + j0 + 4 * n), si = *(const f32x4*)(cs + 160 + j0 + 4 * n), x1 = acc[ai][0][m][n], x2 = acc[ai][1][m][n];
                        o1[n] = x1 * co - x2 * si; o2[n] = x1 * si + x2 * co; }
                    f16* qi = (f16*)(ws + WS_QI) + (size_t)r * 1024 + hd * 64 + j0;
                    *(f16x8v*)qi = (f16x8v){(f16)o1[0].x, (f16)o1[0].y, (f16)o1[0].z, (f16)o1[0].w, (f16)o1[1].x, (f16)o1[1].y, (f16)o1[1].z, (f16)o1[1].w};
                    *(f16x8v*)(qi + 32) = (f16x8v){(f16)o2[0].x, (f16)o2[0].y, (f16)o2[0].z, (f16)o2[0].w, (f16)o2[1].x, (f16)o2[1].y, (f16)o2[1].z, (f16)o2[1].w};
                    if (smp) { float* q32 = (float*)(ws + WS_QI32) + (size_t)b * 1024 + hd * 64 + j0; *(f32x4*)q32 = o1[0]; *(f32x4*)(q32 + 4) = o1[1]; *(f32x4*)(q32 + 32) = o2[0]; *(f32x4*)(q32 + 36) = o2[1]; }
                } else if (pn == 10) {
                    if (wc == 0) { const int j0 = c0;
                        f32x4 o1[2], o2[2];
#pragma unroll
                        for (int n = 0; n < 2; ++n) { const f32x4 co = *(const f32x4*)(cs + 128 + j0 + 4 * n), si = *(const f32x4*)(cs + 160 + j0 + 4 * n), x1 = acc[ai][0][m][n], x2 = acc[ai][1][m][n];
                            o1[n] = x1 * co - x2 * si; o2[n] = x1 * si + x2 * co; }
                        float* kio = (smp ? out + O_KIS + (size_t)b * 64 : out + O_KIP + (size_t)r * 64) + j0; *(f32x4*)kio = o1[0]; *(f32x4*)(kio + 4) = o1[1]; *(f32x4*)(kio + 32) = o2[0]; *(f32x4*)(kio + 36) = o2[1];
                        f16* ki = (f16*)(ws + WS_KI) + (size_t)r * 64 + j0;
                        *(f16x8v*)ki = (f16x8v){(f16)o1[0].x, (f16)o1[0].y, (f16)o1[0].z, (f16)o1[0].w, (f16)o1[1].x, (f16)o1[1].y, (f16)o1[1].z, (f16)o1[1].w};
                        *(f16x8v*)(ki + 32) = (f16x8v){(f16)o2[0].x, (f16)o2[0].y, (f16)o2[0].z, (f16)o2[0].w, (f16)o2[1].x, (f16)o2[1].y, (f16)o2[1].z, (f16)o2[1].w};
                    } else if (wc == 1 && fq < 2) { float* wo = (float*)(ws + WS_WI) + (size_t)r * 16 + 8 * fq; *(f32x4*)wo = acc[ai][0][m][0] * 0.25f; *(f32x4*)(wo + 4) = acc[ai][0][m][1] * 0.25f; }
                } else {
#pragma unroll
                    for (int bj = 0; bj < 2; ++bj) { const int c = (pn - 11) * 256 + 128 * bj + c0; const f32x4 v0 = acc[ai][bj][m][0], v1 = acc[ai][bj][m][1];
                        float* uo = (float*)(ws + WS_U) + (size_t)r * 1024 + c; *(f32x4*)uo = v0; *(f32x4*)(uo + 4) = v1;
                        if (!smp && r >= TP - 15) { float* po = out + O_PP + (size_t)(r - (TP - 15)) * 1024 + c; *(f32x4*)po = v0; *(f32x4*)(po + 4) = v1; }
                        if (smp) { float* po = out + O_PS + ((size_t)b * 15 + 14) * 1024 + c; *(f32x4*)po = v0; *(f32x4*)(po + 4) = v1; } }
                }
            }
    }
};
}

template <int PMODE = 0> __device__ __forceinline__ void p3_indexer_prompt(const Args& a, LAS unsigned char* lds, int bid, int G, int tid, int wave, int lane, bool dostore = true) {
    unsigned char* ws = a.ws;
    const f16* QI = (const f16*)(ws + WS_QI); const f16* KI = (const f16*)(ws + WS_KI); const float* WI = (const float*)(ws + WS_WI); float* SC = (float*)(ws + WS_SC);
    const int r = lane & 31, hh = lane >> 5;
    constexpr int WOFF = 18 * 4096;
    constexpr int CB = 20, T = 129 * 129 + 257 * CB;
    const int lo = (int)((long)bid * T / G), hi = (int)((long)(bid + 1) * T / G);
    int q = 0, P = 0;
    while (P + CB + (q >> 1) + 1 <= lo) { P += CB + (q >> 1) + 1; ++q; }
    for (; q <= 256 && P < hi; P += CB + (q >> 1) + 1, ++q) {
        const int t0 = q * 32; const int nkb = (q >> 1) + 1;
        const int kb_lo = lo - (P + CB) > 0 ? lo - (P + CB) : 0; const int kb_end = hi - (P + CB) < nkb ? hi - (P + CB) : nkb;
        if (kb_lo >= kb_end) continue;
        {
            __syncthreads();
            int tidv = tid; asm volatile("" : "+v"(tidv));
#pragma unroll
            for (int i = 0; i < 8; ++i) { const int rr = tidv & 31, c = 2 * (8 * i + (tidv >> 6)) + ((tidv >> 5) & 1);
                const v4u v = *(const v4u*)(QI + (size_t)(t0 + rr) * 1024 + c * 8);
                *(LAS v4u*)(lds + (c * 32 + rr) * 16) = v; }
            { const float wx = WI[(size_t)(t0 + (tidv & 31)) * 16 + (tidv >> 5)]; *(LAS float*)(lds + WOFF + ((tidv >> 5) * 32 + (tidv & 31)) * 4) = wx * 0.0625f; }
            __syncthreads();
            {
                const int rr = tidv & 31, dg = tidv >> 5; const int ks = dg >> 2, h2 = (dg >> 1) & 1, e0 = (dg & 1) * 4;
                float qa[4] = {0.f, 0.f, 0.f, 0.f};
#pragma unroll 4
                for (int h = 0; h < 16; ++h) { const float wh = *(const LAS float*)(lds + WOFF + (h * 32 + rr) * 4);
                    typedef _Float16 f16x4 __attribute__((ext_vector_type(4)));
                    const f16x4 qv = *(const LAS f16x4*)(lds + ((((h * 4 + ks) * 2 + h2) * 32) + rr) * 16 + e0 * 2);
                    qa[0] = fmaf(wh, (float)qv[0], qa[0]); qa[1] = fmaf(wh, (float)qv[1], qa[1]); qa[2] = fmaf(wh, (float)qv[2], qa[2]); qa[3] = fmaf(wh, (float)qv[3], qa[3]); }
                typedef _Float16 f16x4 __attribute__((ext_vector_type(4)));
                f16x4 hi, lo;
#pragma unroll
                for (int e = 0; e < 4; ++e) { hi[e] = (f16)qa[e]; lo[e] = (f16)(qa[e] - (float)hi[e]); }
                *(LAS f16x4*)(lds + ((((16 * 4 + ks) * 2 + h2) * 32) + rr) * 16 + e0 * 2) = hi;
                *(LAS f16x4*)(lds + ((((17 * 4 + ks) * 2 + h2) * 32) + rr) * 16 + e0 * 2) = lo;
            }
            __syncthreads();
            f16x8 afn[2][4];
            if (kb_lo + wave < kb_end) {
#pragma unroll
                for (int blk = 0; blk < 2; ++blk)
#pragma unroll
                    for (int ks = 0; ks < 4; ++ks) afn[blk][ks] = *(const f16x8*)(KI + (size_t)((kb_lo + wave) * 64 + blk * 32 + r) * 64 + ks * 16 + hh * 8); }
            for (int kb = kb_lo + wave; kb < kb_end; kb += 8) {
                const int s0 = kb * 64;
                f16x8 af[2][4];
#pragma unroll
                for (int blk = 0; blk < 2; ++blk)
#pragma unroll
                    for (int ks = 0; ks < 4; ++ks) af[blk][ks] = afn[blk][ks];
                if (kb + 8 < kb_end) {
#pragma unroll
                    for (int blk = 0; blk < 2; ++blk)
#pragma unroll
                        for (int ks = 0; ks < 4; ++ks) afn[blk][ks] = *(const f16x8*)(KI + (size_t)(s0 + 512 + blk * 32 + r) * 64 + ks * 16 + hh * 8); }
                float sa0[16], sa1[16];
#pragma unroll
                for (int i = 0; i < 16; ++i) { sa0[i] = 0.f; sa1[i] = 0.f; }
#define IDX_FRAG(h, ks) (*(const LAS f16x8*)(lds + (((((h) * 4 + (ks)) * 2 + hh) * 32) + r) * 16))
#define IDX_W(h) (*(const LAS float*)(lds + WOFF + ((h) * 32 + r) * 4))
#define IDX_STEP(m, D0, D1, Bc, P0, P1, Bn, DOVALU, DOLOAD, WCUR, WNXT) do { const float wP_ = WCUR; \
        WNXT = IDX_W(m);                                      \
        __builtin_amdgcn_sched_barrier(0); \
        if (DOLOAD && PMODE != 2) { _Pragma("unroll") for (int ks = 0; ks < 4; ++ks) Bn[ks] = IDX_FRAG((m) + 1, ks); } \
        _Pragma("unroll") for (int ks = 0; ks < 4; ++ks) { \
            if (PMODE != 4) { \
            if (ks == 0) { D0 = __builtin_amdgcn_mfma_f32_32x32x16_f16(af[0][0], Bc[0], (f32x16){}, 0, 0, 0); D1 = __builtin_amdgcn_mfma_f32_32x32x16_f16(af[1][0], Bc[0], (f32x16){}, 0, 0, 0); } \
            else { D0 = __builtin_amdgcn_mfma_f32_32x32x16_f16(af[0][ks], Bc[ks], D0, 0, 0, 0); D1 = __builtin_amdgcn_mfma_f32_32x32x16_f16(af[1][ks], Bc[ks], D1, 0, 0, 0); } } \
            else if (ks == 0) { _Pragma("unroll") for (int i_ = 0; i_ < 16; ++i_) { D0[i_] = (float)Bc[0][0] * (float)i_; D1[i_] = D0[i_]; } } \
            __builtin_amdgcn_sched_barrier(0); \
            if (DOVALU && PMODE != 1) { if (ks == 0) asm volatile("s_nop 7" : "+v"(P0), "+v"(P1)); \
                _Pragma("unroll") for (int i = 4 * ks; i < 4 * ks + 4; ++i) { if (PMODE == 3) { asm volatile("v_fma_f32 %0, %1, |%1|, %0" : "+v"(sa0[i]) : "v"(wP_)); asm volatile("v_fma_f32 %0, %1, |%1|, %0" : "+v"(sa1[i]) : "v"(wP_)); } else { \
                    asm volatile("v_fma_f32 %0, %1, |%2|, %0" : "+v"(sa0[(i + 1) & 15]) : "v"(wP_), "v"(P0[i])); asm volatile("v_fma_f32 %0, %1, |%2|, %0" : "+v"(sa1[(i + 1) & 15]) : "v"(wP_), "v"(P1[i])); } } } \
            __builtin_amdgcn_sched_barrier(0); } } while (0)
                {
                    f16x8 bA[4], bB[4]; f32x16 dA0, dA1, dB0, dB1;
#pragma unroll
                    for (int ks = 0; ks < 4; ++ks) { bA[ks] = IDX_FRAG(0, ks); if (PMODE == 2) bB[ks] = IDX_FRAG(1, ks); }
                    float wA = 0.f, wB = 0.f;
                    IDX_STEP(0, dA0, dA1, bA, dB0, dB1, bB, false, true, wB, wA);
#pragma unroll 1
                    for (int m = 1; m < 15; m += 2) {
                        IDX_STEP(m, dB0, dB1, bB, dA0, dA1, bA, true, true, wA, wB);
                        IDX_STEP(m + 1, dA0, dA1, bA, dB0, dB1, bB, true, true, wB, wA);
                    }
                    IDX_STEP(15, dB0, dB1, bB, dA0, dA1, bA, true, false, wA, wB);
                    { const float wP_ = wB; asm volatile("s_nop 15" : "+v"(dB0), "+v"(dB1));
#pragma unroll
                      for (int i = 0; i < 16; ++i) { asm volatile("v_fma_f32 %0, %1, |%2|, %0" : "+v"(sa0[(i + 1) & 15]) : "v"(wP_), "v"(dB0[i])); asm volatile("v_fma_f32 %0, %1, |%2|, %0" : "+v"(sa1[(i + 1) & 15]) : "v"(wP_), "v"(dB1[i])); } }
                }
#undef IDX_STEP
                f32x16 sc0, sc1;
#pragma unroll
                for (int i = 0; i < 16; ++i) { sc0[i] = sa0[(i + 1) & 15]; sc1[i] = sa1[(i + 1) & 15]; }
#pragma unroll
                for (int h = 16; h < 18; ++h)
#pragma unroll
                    for (int ks = 0; ks < 4; ++ks) { const f16x8 bfr = IDX_FRAG(h, ks);
                        sc0 = __builtin_amdgcn_mfma_f32_32x32x16_f16(af[0][ks], bfr, sc0, 0, 0, 0); sc1 = __builtin_amdgcn_mfma_f32_32x32x16_f16(af[1][ks], bfr, sc1, 0, 0, 0); }
#undef IDX_FRAG
#undef IDX_W
                float* row = SC + (size_t)(t0 + r) * SCLD + s0 + 4 * hh;
                if (!dostore) { if (sc0[0] + sc1[3] != 12345.678f) continue; }
                if (s0 + 63 > t0) {
                    const int tq = t0 + r;
#pragma unroll
                    for (int i = 0; i < 16; ++i) { const int sk = s0 + (i & 3) + 8 * (i >> 2) + 4 * hh; if (sk > tq) sc0[i] = -INFINITY; if (sk + 32 > tq) sc1[i] = -INFINITY; } }
#pragma unroll
                for (int q4 = 0; q4 < 4; ++q4) {
                    *(f32x4*)(row + 8 * q4) = (f32x4){sc0[4 * q4], sc0[4 * q4 + 1], sc0[4 * q4 + 2], sc0[4 * q4 + 3]};
                    *(f32x4*)(row + 32 + 8 * q4) = (f32x4){sc1[4 * q4], sc1[4 * q4 + 1], sc1[4 * q4 + 2], sc1[4 * q4 + 3]}; }
                if (kb == nkb - 1) {
                    const int pend = ((t0 + 32 + 255) >> 8) << 8; float* prow = SC + (size_t)(t0 + r) * SCLD;
                    for (int sp = 64 * nkb + 4 * hh; sp < pend; sp += 8) *(f32x4*)(prow + sp) = (f32x4){-INFINITY, -INFINITY, -INFINITY, -INFINITY}; }
            }
        }
    }
}
__device__ __forceinline__ void p3_indexer_sample(const Args& a, LAS unsigned char* lds, int gw, int NGW, int wave, int lane) {
    unsigned char* ws = a.ws;
    const float* QI32 = (const float*)(ws + WS_QI32); const float* WI = (const float*)(ws + WS_WI); float* SCS = (float*)(ws + WS_SCS);
    const float* ckidx = a.in[4]; const int* pt = (const int*)a.in[6];
    LAS float* lq = (LAS float*)(lds + wave * 4096);
    for (int it = gw; it < DB * 17; it += NGW) {
        const int b = it / 17, p = it % 17;
        const float* w = WI + (size_t)(TP + b) * 16;
        const bool newk = p == 16;
        const float* kr0 = newk ? a.out + O_KIS + (size_t)b * IDD : ckidx + ((size_t)pt[b * NPAGES + p] * PAGE + lane) * IDD;
        const float* kr1 = newk ? kr0 : kr0 + 64 * IDD;
        f32x4 k0[16], k1[16];
#pragma unroll
        for (int j = 0; j < 16; ++j) { k0[j] = *((const f32x4*)kr0 + j); k1[j] = *((const f32x4*)kr1 + j); }
#pragma unroll
        for (int j = 0; j < 4; ++j) *((LAS f32x4*)lq + lane + 64 * j) = *((const f32x4*)(QI32 + (size_t)b * 1024) + lane + 64 * j);
        LDS_WAIT();
        float s0 = 0.f, s1 = 0.f;
#pragma unroll 1
        for (int h = 0; h < 16; ++h) { float d0 = 0.f, d1 = 0.f;
#pragma unroll
            for (int j = 0; j < 16; ++j) { const f32x4 q4 = *((const LAS f32x4*)(lq + h * 64) + j);
                d0 = fmaf(q4.x, k0[j].x, d0); d0 = fmaf(q4.y, k0[j].y, d0); d0 = fmaf(q4.z, k0[j].z, d0); d0 = fmaf(q4.w, k0[j].w, d0);
                d1 = fmaf(q4.x, k1[j].x, d1); d1 = fmaf(q4.y, k1[j].y, d1); d1 = fmaf(q4.z, k1[j].z, d1); d1 = fmaf(q4.w, k1[j].w, d1); }
            const float wh = w[h]; s0 += wh * fmaxf(d0, 0.f); s1 += wh * fmaxf(d1, 0.f); }
        if (!newk) { SCS[(size_t)b * SCSLD + p * PAGE + lane] = s0 * 0.125f; SCS[(size_t)b * SCSLD + p * PAGE + 64 + lane] = s1 * 0.125f; }
        else { if (lane == 0) SCS[(size_t)b * SCSLD + PAST] = s0 * 0.125f; for (int sp = LS + lane; sp < SCSLD; sp += 64) SCS[(size_t)b * SCSLD + sp] = -INFINITY; }
        LDS_WAIT();
    }
}

__device__ __forceinline__ unsigned tokey(float x) { const unsigned u = __builtin_bit_cast(unsigned, x); return u ^ (((unsigned)((int)u >> 31)) | 0x80000000u); }
__device__ __forceinline__ void hist_find(LAS unsigned* hist, int need, int lane, unsigned& digit, unsigned& above, unsigned& inbin) {
    unsigned tot = 0u;
#pragma unroll 8
    for (int j = 0; j < 32; ++j) tot += hist[32 * lane + j];
    unsigned s = tot;
#pragma unroll
    for (int o = 1; o < 64; o <<= 1) { const unsigned t = __shfl_down(s, o); if (lane + o < 64) s += t; }
    const unsigned s_excl = s - tot;
    const bool found = (s_excl < (unsigned)need) && ((unsigned)need <= s);
    const unsigned long long bal = __ballot(found);
    const int L = bal ? (int)__builtin_ctzll(bal) : 0;
    const unsigned sxL = __shfl(s_excl, L);
    const unsigned hb = lane < 32 ? hist[32 * L + lane] : 0u;
    unsigned s2 = hb;
#pragma unroll
    for (int o = 1; o < 32; o <<= 1) { const unsigned t = __shfl_down(s2, o); if (lane + o < 32) s2 += t; }
    const unsigned tot2 = sxL + s2, ex2 = tot2 - hb;
    const bool f2 = lane < 32 && ex2 < (unsigned)need && (unsigned)need <= tot2;
    const unsigned long long b2 = __ballot(f2);
    const int L2 = b2 ? (int)__builtin_ctzll(b2) : 0;
    digit = 32u * L + L2; above = __shfl(ex2, L2); inbin = __shfl(hb, L2);
}
constexpr int KB0 = 22785;
__device__ __forceinline__ int coarse_bin(unsigned k) { const int v = (int)(k >> 17) - KB0; return v < 0 ? 0 : (v > 2047 ? 2047 : v); }
#define TOPK_LOAD(v, base) do { _Pragma("unroll") for (int j = 0; j < 8; ++j) { v[j] = (f32x4){0.f, 0.f, 0.f, 0.f}; if ((base) + 256 * j < n) v[j] = *(const f32x4*)(row + (base) + 256 * j + 4 * lane); } } while (0)
__device__ __forceinline__ void topk_row(const float* row, int n, int* sel, LAS unsigned* hist, int lane) {
    if (n <= TOPK) { for (int i = lane; i < TOPK; i += 64) sel[i] = i < n ? i : 0; return; }
    int need = TOPK; unsigned digit, above, inbin;
    for (int i = lane; i < 2048; i += 64) hist[i] = 0u;
    LDS_WAIT();
    unsigned cnt0 = 0u;
    f32x4 vn[8]; TOPK_LOAD(vn, 0);
#pragma unroll 1
    for (int base = 0; base < n; base += 2048) { f32x4 v[8];
#pragma unroll
        for (int j = 0; j < 8; ++j) v[j] = vn[j];
        if (base + 2048 < n) TOPK_LOAD(vn, base + 2048);
#pragma unroll
        for (int j = 0; j < 8; ++j) if (base + 256 * j < n) {
#pragma unroll
            for (int e = 0; e < 4; ++e) { const int cb = coarse_bin(tokey(v[j][e]));
                if (cb != 0) __hip_atomic_fetch_add(hist + cb, 1u, __ATOMIC_RELAXED, __HIP_MEMORY_SCOPE_WORKGROUP); else ++cnt0; } } }
    { unsigned c0 = cnt0;
#pragma unroll
      for (int o = 1; o < 64; o <<= 1) c0 += __shfl_xor(c0, o);
      if (lane == 0) hist[0] = c0; }
    TOPK_LOAD(vn, 0);
    LDS_WAIT();
    hist_find(hist, need, lane, digit, above, inbin); need -= (int)above;
    const int b1 = (int)digit;
    const unsigned klo = b1 == 0 ? 0u : ((unsigned)(KB0 + b1)) << 17;
    const unsigned kspan = b1 == 0 ? ((unsigned)(KB0 + 1)) << 17 : (b1 == 2047 ? 0u - klo : 1u << 17);
    const bool fast = inbin <= 64u; const int m = (int)inbin;
    LDS_WAIT();
    unsigned thr = 0u; int need_eq = 0; bool ties = false;
    if (!fast) {
        unsigned prefix = 0u; int toteq = 0;
#pragma unroll 1
        for (int pass = 0; pass < 3; ++pass) {
            const int shift = pass == 0 ? 21 : pass == 1 ? 10 : 0; const unsigned mask = pass == 2 ? 1023u : 2047u; const int pshift = pass == 1 ? 21 : 10;
            for (int i = lane; i < 2048; i += 64) hist[i] = 0u;
            LDS_WAIT();
#pragma unroll 1
            for (int base = 0; base < n; base += 2048) { f32x4 v[8];
#pragma unroll
                for (int j = 0; j < 8; ++j) v[j] = vn[j];
                TOPK_LOAD(vn, (base + 2048 < n) ? base + 2048 : 0);
#pragma unroll
                for (int j = 0; j < 8; ++j) if (base + 256 * j < n)
#pragma unroll
                    for (int e = 0; e < 4; ++e) { const unsigned k = tokey(v[j][e]);
                        if (k >= klo && (k - klo) < kspan && (pass == 0 || (k >> pshift) == prefix)) __hip_atomic_fetch_add(hist + ((k >> shift) & mask), 1u, __ATOMIC_RELAXED, __HIP_MEMORY_SCOPE_WORKGROUP); } }
            LDS_WAIT();
            hist_find(hist, need, lane, digit, above, inbin);
            need -= (int)above; toteq = (int)inbin;
            prefix = pass == 2 ? ((prefix << 10) | digit) : ((prefix << 11) | digit);
            LDS_WAIT();
        }
        thr = prefix; need_eq = need; ties = toteq != need_eq;
    }
    LAS unsigned* lkey = hist; LAS unsigned* lidx = hist + 64; LAS unsigned* lcnt = hist + 128;
    if (lane == 0) *lcnt = 0u;
    LDS_WAIT();
    const unsigned long long lt = (1ull << lane) - 1ull;
    int outbase = fast ? need : 0, eqtaken = 0;
#pragma unroll 1
    for (int base = 0; base < n; base += 2048) { f32x4 v[8];
#pragma unroll
        for (int j = 0; j < 8; ++j) v[j] = vn[j];
        if (base + 2048 < n) TOPK_LOAD(vn, base + 2048);
        unsigned mask = 0u;
#pragma unroll
        for (int j = 0; j < 8; ++j) if (base + 256 * j < n) {
            unsigned kk[4]; bool eq[4];
#pragma unroll
            for (int e = 0; e < 4; ++e) { const int idx = base + 256 * j + 4 * lane + e; const bool valid = true; kk[e] = tokey(v[j][e]); eq[e] = false; bool take;
                if (fast) { const bool inr = valid && kk[e] >= klo; const unsigned dk = kk[e] - klo; take = inr && dk >= kspan;
                    if (inr && dk < kspan) { const unsigned p_ = __hip_atomic_fetch_add(lcnt, 1u, __ATOMIC_RELAXED, __HIP_MEMORY_SCOPE_WORKGROUP); if (p_ < 64u) { lkey[p_] = kk[e]; lidx[p_] = (unsigned)idx; } } }
                else { take = valid && (kk[e] > thr || (kk[e] == thr && !ties)); eq[e] = valid && ties && kk[e] == thr; }
                mask |= take ? (1u << (4 * j + e)) : 0u; }
            if (!fast && ties) {
                int lower = 0, tot = 0, own = 0;
#pragma unroll
                for (int e = 0; e < 4; ++e) { const unsigned long long be = __ballot(eq[e]); lower += __builtin_popcountll(be & lt); tot += __builtin_popcountll(be); }
#pragma unroll
                for (int e = 0; e < 4; ++e) { if (eq[e]) { if (eqtaken + lower + own < need_eq) mask |= 1u << (4 * j + e); ++own; } }
                eqtaken += tot; }
        }
        const int cnt = __builtin_popcount(mask);
        int pre = cnt;
#pragma unroll
        for (int o = 1; o < 64; o <<= 1) { const int t = __shfl_up(pre, o); if (lane >= o) pre += t; }
        int pos = outbase + pre - cnt; outbase += __shfl(pre, 63);
        while (mask) { const int bpos = __builtin_ctz(mask); mask &= mask - 1u; if (pos < TOPK) sel[pos] = base + 256 * (bpos >> 2) + 4 * lane + (bpos & 3); ++pos; }
    }
    if (fast) {
        LDS_WAIT();
        const unsigned mykey = lane < m ? lkey[lane] : 0u; const int myidx = lane < m ? (int)lidx[lane] : 0x7fffffff;
        int rk = 0;
        for (int j = 0; j < m; ++j) { const unsigned kj = __shfl(mykey, j); const int ij = __shfl(myidx, j); rk += (kj > mykey || (kj == mykey && ij < myidx)) ? 1 : 0; }
        if (lane < m && rk < need) sel[rk] = myidx;
    }
    LDS_WAIT();
}
#undef TOPK_LOAD
__device__ __forceinline__ void p4_topk(const Args& a, LAS unsigned char* lds, int gw, int NGW, int wave, int lane) {
    unsigned char* ws = a.ws;
    const float* SC = (const float*)(ws + WS_SC); const float* SCS = (const float*)(ws + WS_SCS); int* SEL = (int*)(ws + WS_SEL);
    LAS unsigned* hist = (LAS unsigned*)(lds + wave * 16896); LAS float* scr = (LAS float*)(lds + wave * 16896 + 8192);
#ifndef TOPK_REP
#define TOPK_REP 1
#endif
    for (int it0 = gw; it0 < (SEQ + DB) * TOPK_REP; it0 += NGW) { int it = it0 % (SEQ + DB);
        if (it < SEQ && (SEQ % (2 * NGW)) == 0) { const int blk = it / NGW, w = it % NGW; it = (blk & 1) ? blk * NGW + (NGW - 1 - w) : it; }
        if (it < SEQ) { const int t = NMETA + it; topk_row(SC + (size_t)t * SCLD, t + 1, SEL + (size_t)t * TOPK, hist, lane); }
        else { const int b = it - SEQ; topk_row(SCS + (size_t)b * SCSLD, LS, SEL + (size_t)(TP + b) * TOPK, hist, lane); }
    }
}

template <int CTRL> __device__ __forceinline__ float dpp_f(float v) { return __builtin_bit_cast(float, __builtin_amdgcn_update_dpp(0, __builtin_bit_cast(int, v), CTRL, 0xf, 0xf, false)); }
__device__ __forceinline__ float row16_sum(float v) {
    v += dpp_f<0xB1>(v);
    v += dpp_f<0x4E>(v);
    v += dpp_f<0x124>(v);
    v += dpp_f<0x128>(v);
    return v;
}
typedef short s16x4 __attribute__((ext_vector_type(4)));
__device__ __forceinline__ s16x4 vtr(LAS unsigned char* p) { return __builtin_bit_cast(s16x4, __builtin_amdgcn_ds_read_tr16_b64_v4i16((LAS s16x4*)p)); }
constexpr int VROW = 288;
constexpr int ATT_WAVE_LDS = 1024 + 4096 + 32 * VROW;
struct AttnPre { int sel[4]; bf16x8_t qf[4]; };
__device__ __forceinline__ void attn_prefetch(const Args& a, AttnPre& P, int t, int kvh, int lane) {
    unsigned char* ws = a.ws; const int* SEL = (const int*)(ws + WS_SEL); const bf16* QB = (const bf16*)(ws + WS_QB);
    const bool smp = t >= TP; const int b = t - TP; const int cnt = smp ? TOPK : (t + 1 < TOPK ? t + 1 : TOPK);
    const int l16 = lane & 15, c = lane >> 4;
#pragma unroll
    for (int j = 0; j < 4; ++j) { const int kidx = 64 * j + lane; int sv = SEL[(size_t)t * TOPK + kidx];
        if (smp) sv = sv < PAST ? ((const int*)a.in[6])[b * NPAGES + (sv >> 7)] * PAGE + (sv & 127) : -1;
        P.sel[j] = kidx < cnt ? sv : 0; }
#pragma unroll
    for (int ks = 0; ks < 4; ++ks) { P.qf[ks] = (bf16x8_t){0, 0, 0, 0, 0, 0, 0, 0}; if (l16 < 4) P.qf[ks] = *(const bf16x8_t*)(QB + (size_t)t * 1024 + (kvh * 4 + l16) * 128 + 32 * ks + 8 * c); }
}
template <bool SMP, int APROBE = 0> __device__ __forceinline__ void attn_unit_mfma(const Args& a, LAS unsigned char* wl, int t, int kvh, int lane, const AttnPre& P) {
    unsigned char* ws = a.ws;
    const bf16* KB = (const bf16*)(ws + WS_KB); const bf16* VB = (const bf16*)(ws + WS_VB); bf16* CAT = (bf16*)(ws + (APROBE ? WS_Z : WS_CAT));
    LAS int* lsel = (LAS int*)wl; LAS float* lsc = (LAS float*)(wl + 1024); LAS unsigned char* vst = wl + 5120;
    const int cnt = SMP ? TOPK : (t + 1 < TOPK ? t + 1 : TOPK);
    const int l16 = lane & 15, c = lane >> 4;
    const int b = t - TP;
#pragma unroll
    for (int j = 0; j < 4; ++j) lsel[64 * j + lane] = P.sel[j];
    const float* ck = a.in[2] + kvh * 128; const float* cv = a.in[3] + kvh * 128;
    const float* nk = a.out + O_KS + (size_t)b * 256 + kvh * 128; const float* nv = a.out + O_VS + (size_t)b * 256 + kvh * 128;
    const char* ckb = (const char*)ck; const char* cvb = (const char*)cv;
    const long long dnk = (long long)((uintptr_t)nk - (uintptr_t)ck), dnv = (long long)((uintptr_t)nv - (uintptr_t)cv);
    bf16x8_t qf[4];
#pragma unroll
    for (int ks = 0; ks < 4; ++ks) qf[ks] = P.qf[ks];
    LDS_WAIT();
    const bf16* kbase = KB + kvh * 128 + 8 * c;
#define ATT_LOADK(kf, gp) do { _Pragma("unroll") for (int bb = 0; bb < 4; ++bb) { const int s_ = lsel[16 * (4 * (gp) + bb) + l16]; \
        if (!SMP) { const bf16* kr_ = kbase + (size_t)s_ * 256; _Pragma("unroll") for (int ks = 0; ks < 4; ++ks) kf[bb][ks] = *(const bf16x8_t*)(kr_ + 32 * ks); } \
        else { const float* kr_ = (const float*)(ckb + (s_ >= 0 ? (long long)s_ * 1024 : dnk)) + 8 * c; \
            _Pragma("unroll") for (int ks = 0; ks < 4; ++ks) { const f32x4 x_ = *(const f32x4*)(kr_ + 32 * ks), y_ = *(const f32x4*)(kr_ + 32 * ks + 4); \
                v4u pk_; pk_.x = pk2(x_.x, x_.y); pk_.y = pk2(x_.z, x_.w); pk_.z = pk2(y_.x, y_.y); pk_.w = pk2(y_.z, y_.w); kf[bb][ks] = __builtin_bit_cast(bf16x8_t, pk_); } } } } while (0)
#define ATT_QK(kf, gp) do { _Pragma("unroll") for (int bb = 0; bb < 4; ++bb) { f32x4 acc_ = {0.f, 0.f, 0.f, 0.f}; \
        _Pragma("unroll") for (int ks = 0; ks < 4; ++ks) acc_ = __builtin_amdgcn_mfma_f32_16x16x32_bf16(kf[bb][ks], qf[ks], acc_, 0, 0, 0); \
        const int k0_ = 16 * (4 * (gp) + bb) + 4 * c; \
        acc_.x = k0_ < cnt ? acc_.x : -INFINITY; acc_.y = k0_ + 1 < cnt ? acc_.y : -INFINITY; acc_.z = k0_ + 2 < cnt ? acc_.z : -INFINITY; acc_.w = k0_ + 3 < cnt ? acc_.w : -INFINITY; \
        if (l16 < 4) *(LAS f32x4*)(lsc + l16 * 256 + k0_) = acc_; } } while (0)
    const bf16* vbase = VB + kvh * 128 + 8 * l16;
#define ATT_LOADV(vr, st_) do { _Pragma("unroll") for (int i = 0; i < 8; ++i) { const int s_ = lsel[32 * (st_) + c + 4 * i]; \
        if (!SMP) vr[i] = *(const bf16x8_t*)(vbase + (size_t)s_ * 256); \
        else { const float* vp_ = (const float*)(cvb + (s_ >= 0 ? (long long)s_ * 1024 : dnv)) + 8 * l16; const f32x4 x_ = *(const f32x4*)vp_, y_ = *(const f32x4*)(vp_ + 4); \
            v4u pk_; pk_.x = pk2(x_.x, x_.y); pk_.y = pk2(x_.z, x_.w); pk_.z = pk2(y_.x, y_.y); pk_.w = pk2(y_.z, y_.w); vr[i] = __builtin_bit_cast(bf16x8_t, pk_); } } } while (0)
    bf16x8_t vr0[8], vr1[8];
    if constexpr (!SMP && APROBE == 3) { ATT_LOADV(vr0, 0); ATT_LOADV(vr1, 1); }
    else if constexpr (!SMP) { bf16x8_t kfA[4][4], kfB[4][4];
      ATT_LOADK(kfA, 0); ATT_LOADK(kfB, 1); ATT_QK(kfA, 0); ATT_LOADK(kfA, 2); ATT_QK(kfB, 1); ATT_LOADK(kfB, 3); ATT_QK(kfA, 2); ATT_LOADV(vr0, 0); ATT_LOADV(vr1, 1); ATT_QK(kfB, 3); }
    else {
#pragma unroll 1
      for (int gp = 0; gp < 4; ++gp) { bf16x8_t kfA[4][4]; ATT_LOADK(kfA, gp); ATT_QK(kfA, gp); }
      ATT_LOADV(vr0, 0); ATT_LOADV(vr1, 1); }
#undef ATT_LOADK
#undef ATT_QK
    LDS_WAIT();
    float lsum[4];
    { const int g = lane >> 4, i16 = lane & 15; LAS f32x4* ps = (LAS f32x4*)(lsc + g * 256 + 16 * i16);
      f32x4 pv[4]; float m = -INFINITY;
#pragma unroll
      for (int j = 0; j < 4; ++j) { pv[j] = ps[j]; m = fmaxf(m, fmaxf(fmaxf(pv[j].x, pv[j].y), fmaxf(pv[j].z, pv[j].w))); }
      m = fmaxf(m, dpp_f<0xB1>(m)); m = fmaxf(m, dpp_f<0x4E>(m)); m = fmaxf(m, dpp_f<0x124>(m)); m = fmaxf(m, dpp_f<0x128>(m));
      float l = 0.f;
#pragma unroll
      for (int j = 0; j < 4; ++j) { pv[j].x = __builtin_amdgcn_exp2f(pv[j].x - m); pv[j].y = __builtin_amdgcn_exp2f(pv[j].y - m); pv[j].z = __builtin_amdgcn_exp2f(pv[j].z - m); pv[j].w = __builtin_amdgcn_exp2f(pv[j].w - m);
          l += (pv[j].x + pv[j].y) + (pv[j].z + pv[j].w); ps[j] = pv[j]; }
      l = row16_sum(l);
#pragma unroll
      for (int gg = 0; gg < 4; ++gg) lsum[gg] = __builtin_bit_cast(float, __builtin_amdgcn_readlane(__builtin_bit_cast(int, l), 16 * gg)); }
    LDS_WAIT();
    f32x4 oacc[8];
#pragma unroll
    for (int db = 0; db < 8; ++db) oacc[db] = (f32x4){0.f, 0.f, 0.f, 0.f};
    LAS unsigned char* trp = vst + (4 * c + (l16 >> 2)) * VROW + 8 * (l16 & 3);
#define ATT_PV(vr, st, vnext, DOLOAD) do { \
        _Pragma("unroll") for (int i = 0; i < 8; ++i) *(LAS bf16x8_t*)(vst + (c + 4 * i) * VROW + 16 * l16) = vr[i]; \
        if (DOLOAD) ATT_LOADV(vnext, (st) + 2); \
        bf16x8_t pf = (bf16x8_t){0, 0, 0, 0, 0, 0, 0, 0}; \
        if (l16 < 4) { const f32x4 p0 = *(const LAS f32x4*)(lsc + l16 * 256 + 32 * (st) + 4 * c), p1 = *(const LAS f32x4*)(lsc + l16 * 256 + 32 * (st) + 16 + 4 * c); \
            v4u pk; pk.x = pk2(p0.x, p0.y); pk.y = pk2(p0.z, p0.w); pk.z = pk2(p1.x, p1.y); pk.w = pk2(p1.z, p1.w); pf = __builtin_bit_cast(bf16x8_t, pk); } \
        LDS_WAIT(); \
        _Pragma("unroll") for (int db = 0; db < 8; ++db) { const s16x4 lo = vtr(trp + 32 * db), hi = vtr(trp + 16 * VROW + 32 * db); \
            const bf16x8_t vf = (bf16x8_t){lo[0], lo[1], lo[2], lo[3], hi[0], hi[1], hi[2], hi[3]}; \
            oacc[db] = __builtin_amdgcn_mfma_f32_16x16x32_bf16(pf, vf, oacc[db], 0, 0, 0); } \
        LDS_WAIT(); } while (0)
#pragma unroll 1
    for (int st = 0; st < (APROBE == 4 ? 2 : 8); st += 2) {
        ATT_PV(vr0, st, vr0, st + 2 < 8);
        ATT_PV(vr1, st + 1, vr1, st + 3 < 8);
    }
#undef ATT_PV
#undef ATT_LOADV
    LAS unsigned short* obuf = (LAS unsigned short*)lsc;
    if (c == 0) {
        const float i0 = 1.f / lsum[0], i1 = 1.f / lsum[1], i2 = 1.f / lsum[2], i3 = 1.f / lsum[3];
#pragma unroll
        for (int db = 0; db < 8; ++db) { obuf[0 * 128 + 16 * db + l16] = (unsigned short)f2bf(oacc[db].x * i0); obuf[1 * 128 + 16 * db + l16] = (unsigned short)f2bf(oacc[db].y * i1);
            obuf[2 * 128 + 16 * db + l16] = (unsigned short)f2bf(oacc[db].z * i2); obuf[3 * 128 + 16 * db + l16] = (unsigned short)f2bf(oacc[db].w * i3); } }
    LDS_WAIT();
    { const v4u o = *(const LAS v4u*)((LAS unsigned char*)obuf + c * 256 + 16 * l16);
      *(v4u*)(CAT + (size_t)t * 2048 + (kvh * 4 + c) * 128 + 8 * l16) = o; }
    LDS_WAIT();
}
template <int APROBE = 0> __device__ __forceinline__ void p5_attn(const Args& a, LAS unsigned char* lds, int bid, int G, int wave, int lane) {
    LAS unsigned char* wl = lds + wave * ATT_WAVE_LDS;
    constexpr int AW = CONV_IN_ATTN ? 7 : 8;
    int kvh, hw, nhw;
    if ((G & 7) == 0) { kvh = (bid >> 2) & 1; hw = ((bid >> 3) * 4 + (bid & 3)) * AW + wave; nhw = (G / 2) * AW; }
    else { kvh = bid & 1; hw = (bid >> 1) * AW + wave; nhw = ((G + 1 - kvh) >> 1) * AW; if (nhw == 0) { nhw = 1; } }
#ifndef DYN_ROUNDS
#define DYN_ROUNDS 1
#endif
    const int NSTAT = ((SEQ + DB) / nhw - DYN_ROUNDS) * nhw;
    unsigned* ticket = (unsigned*)(a.ws + WS_CTL) + 2048 + 64 * kvh;
#define ATT_ROW(i) (((i) >= DB && (i) < 2 * DB) ? TP + ((i) - DB) : NMETA + ((i) < DB ? (i) : (i) - DB))
    if (CONV_IN_ATTN && wave == 7) {
        LAS float* scr = (LAS float*)(lds + 8 * ATT_WAVE_LDS);
        LAS float* scr2 = scr + 64 * 33;
        for (int cit = bid; cit < CV_N; cit += 2 * G) { if (cit + G < CV_N) conv_pair(a, scr, scr2, cit, cit + G, lane); else conv_item(a, scr, cit, lane); }
    } else {
        AttnPre P;
        if (hw < NSTAT) attn_prefetch(a, P, ATT_ROW(hw), kvh, lane);
        for (int it = hw; it < NSTAT; it += nhw) {
            const int t = ATT_ROW(it);
            const AttnPre C = P; const int nx = it + nhw;
            if (nx < NSTAT) attn_prefetch(a, P, ATT_ROW(nx), kvh, lane);
            if (t >= TP) attn_unit_mfma<true, APROBE>(a, wl, t, kvh, lane, C); else attn_unit_mfma<false, APROBE>(a, wl, t, kvh, lane, C); }
    }
    {
        unsigned tk = 0u; if (lane == 0) tk = __hip_atomic_fetch_add(ticket, 1u, __ATOMIC_RELAXED, __HIP_MEMORY_SCOPE_AGENT);
        int it = NSTAT + (int)__builtin_amdgcn_readfirstlane(tk);
        AttnPre P2; if (it < SEQ + DB) attn_prefetch(a, P2, ATT_ROW(it), kvh, lane);
        while (it < SEQ + DB) {
            const int t = ATT_ROW(it); const AttnPre C = P2;
            unsigned tn = 0u; if (lane == 0) tn = __hip_atomic_fetch_add(ticket, 1u, __ATOMIC_RELAXED, __HIP_MEMORY_SCOPE_AGENT);
            const int itn = NSTAT + (int)__builtin_amdgcn_readfirstlane(tn);
            if (itn < SEQ + DB) attn_prefetch(a, P2, ATT_ROW(itn), kvh, lane);
            if (t >= TP) attn_unit_mfma<true, APROBE>(a, wl, t, kvh, lane, C); else attn_unit_mfma<false, APROBE>(a, wl, t, kvh, lane, C);
            it = itn; } }
#undef ATT_ROW
}
template <int W> __device__ __forceinline__ void dpool_block16(const float* U, bf16* DP, int r0, int c4) {
    f32x4 v[31], P[32];
#pragma unroll
    for (int i = 0; i < 31; ++i) v[i] = (i >= 16 - W) ? *((const f32x4*)(U + (size_t)(r0 - 15 + i) * 1024) + c4) : (f32x4){0.f, 0.f, 0.f, 0.f};
    P[0] = (f32x4){0.f, 0.f, 0.f, 0.f};
#pragma unroll
    for (int i = 0; i < 31; ++i) P[i + 1] = P[i] + v[i];
#pragma unroll
    for (int t = 0; t < 16; ++t) { const f32x4 d = (P[16 + t] - P[16 + t - W]) * (1.0f / W) - v[15 + t];
        *((unsigned long long*)(DP + (size_t)(r0 + t) * 1024) + c4) = (unsigned long long)pk2(d.x, d.y) | ((unsigned long long)pk2(d.z, d.w) << 32); }
}
__device__ __forceinline__ void p5_dpool(const Args& a, int bid, int G, int tid) {
    unsigned char* ws = a.ws;
    const float* U = (const float*)(ws + WS_U); bf16* DP = (bf16*)(ws + WS_DPOOL); const float* SP = a.in[5];
    for (int e = bid * 512 + tid; e < (SEQ / 16) * 256; e += G * 512) { const int rb = e >> 8, c4 = e & 255; const int grp = c4 >> 6; const int r0 = NMETA + 16 * rb;
        if (grp == 0) dpool_block16<2>(U, DP, r0, c4); else if (grp == 1) dpool_block16<4>(U, DP, r0, c4); else if (grp == 2) dpool_block16<8>(U, DP, r0, c4); else dpool_block16<16>(U, DP, r0, c4); }
    for (int e = bid * 512 + tid; e < (MP - TP) * 256; e += G * 512) { const int r = TP + (e >> 8), c4 = e & 255; const int grp = c4 >> 6; const int w = 2 << grp;
        f32x4 d = {0.f, 0.f, 0.f, 0.f};
        if (r < MR) { const int b = r - TP; const f32x4 cur = *((const f32x4*)(U + (size_t)r * 1024) + c4); f32x4 sum = cur;
            for (int j = 1; j < w; ++j) sum += *((const f32x4*)(SP + ((size_t)b * 15 + (15 - j)) * 1024) + c4);
            d = sum / (float)w - cur; }
        *((unsigned long long*)(DP + (size_t)r * 1024) + c4) = (unsigned long long)pk2(d.x, d.y) | ((unsigned long long)pk2(d.z, d.w) << 32); }
}
__device__ __forceinline__ void rms_row_to_f32(const float* xrow, const float* gain, float* orow, int lane) {
    const f32x4* xr = (const f32x4*)xrow + lane; const f32x4* gr = (const f32x4*)gain + lane;
    f32x4 v[8]; float s = 0.f;
#pragma unroll
    for (int j = 0; j < 8; ++j) { v[j] = xr[64 * j]; s += (v[j].x * v[j].x + v[j].y * v[j].y) + (v[j].z * v[j].z + v[j].w * v[j].w); }
    const float rstd = 1.f / sqrtf(wave_sum(s) * (1.f / DM) + EPS);
#pragma unroll
    for (int j = 0; j < 8; ++j) { const f32x4 g = gr[64 * j]; *((f32x4*)orow + lane + 64 * j) = v[j] * rstd * g; }
}

template <int NB, int MODE  >
__device__ __forceinline__ void small_gemm_item(const bf16* A, int lda, const bf16* Bt, int ldb, int n0, int k_lo, int k_hi, float* outF, bf16* outH, int ldo, int wave, int lane) {
    const int fr = lane & 15, fq = lane >> 4;
    const bf16* ap = A + (size_t)(16 * wave + fr) * lda + k_lo + 8 * fq;
    const bf16* bp = Bt + (size_t)(n0 + fr) * ldb + k_lo + 8 * fq;
    f32x4 acc[NB];
#pragma unroll
    for (int c = 0; c < NB; ++c) acc[c] = (f32x4){0.f, 0.f, 0.f, 0.f};
#pragma unroll 8
    for (int k = k_lo; k < k_hi; k += 32) {
        const bf16x8_t af = *(const bf16x8_t*)ap; ap += 32;
#pragma unroll
        for (int c = 0; c < NB; ++c) { const bf16x8_t bfv = *(const bf16x8_t*)(bp + (size_t)16 * c * ldb); acc[c] = __builtin_amdgcn_mfma_f32_16x16x32_bf16(bfv, af, acc[c], 0, 0, 0); }
        bp += 32;
    }
    const int row = 16 * wave + fr;
#pragma unroll
    for (int c = 0; c < NB; ++c) { const int col = n0 + 16 * c + 4 * fq;
        if (MODE == 0) *(f32x4*)(outF + (size_t)row * ldo + col) = acc[c];
        else { float v0 = fmaxf(acc[c].x, 0.f), v1 = fmaxf(acc[c].y, 0.f), v2 = fmaxf(acc[c].z, 0.f), v3 = fmaxf(acc[c].w, 0.f);
            unsigned long long o = (unsigned long long)pk2(v0 * v0, v1 * v1) | ((unsigned long long)pk2(v2 * v2, v3 * v3) << 32);
            *(unsigned long long*)(outH + (size_t)row * ldo + col) = o; } }
}
template <int KLEN, int MODE  >
__device__ __forceinline__ void small_gemm_ksplit(const bf16* A, int lda, const bf16* Bt, int ldb, int n0, int k_lo, float* outF, bf16* outH, int ldo, LAS unsigned char* lds, int tid, int wave, int lane) {
    constexpr int KW = KLEN / 8, NS = KW / 32;
    static_assert(KW % 32 == 0 && NS >= 1, "small_gemm_ksplit: KLEN must be a multiple of 256");
    const int fr = lane & 15, fq = lane >> 4;
    const bf16* ap = A + (size_t)fr * lda + k_lo + wave * KW + 8 * fq;
    const bf16* bp = Bt + (size_t)(n0 + fr) * ldb + k_lo + wave * KW + 8 * fq;
    f32x4 acc[8][2];
#pragma unroll
    for (int rb = 0; rb < 8; ++rb) { acc[rb][0] = (f32x4){0.f, 0.f, 0.f, 0.f}; acc[rb][1] = acc[rb][0]; }
    constexpr int SB = NS < 4 ? NS : 4;
#pragma unroll 1
    for (int s0 = 0; s0 < NS; s0 += SB) {
        bf16x8_t af[SB][8], bfv[SB][2];
#pragma unroll
        for (int ss = 0; ss < SB; ++ss) {
#pragma unroll
            for (int rb = 0; rb < 8; ++rb) af[ss][rb] = *(const bf16x8_t*)(ap + (size_t)(16 * rb) * lda + 32 * (s0 + ss));
            bfv[ss][0] = *(const bf16x8_t*)(bp + 32 * (s0 + ss)); bfv[ss][1] = *(const bf16x8_t*)(bp + (size_t)16 * ldb + 32 * (s0 + ss)); }
#pragma unroll
        for (int ss = 0; ss < SB; ++ss)
#pragma unroll
            for (int rb = 0; rb < 8; ++rb) { acc[rb][0] = __builtin_amdgcn_mfma_f32_16x16x32_bf16(bfv[ss][0], af[ss][rb], acc[rb][0], 0, 0, 0); acc[rb][1] = __builtin_amdgcn_mfma_f32_16x16x32_bf16(bfv[ss][1], af[ss][rb], acc[rb][1], 0, 0, 0); }
    }
    LAS float* part = (LAS float*)lds;
#pragma unroll
    for (int rb = 0; rb < 8; ++rb)
#pragma unroll
        for (int cb = 0; cb < 2; ++cb) *(LAS f32x4*)(part + ((size_t)(wave * 128 + 16 * rb + fr) * 32 + 16 * cb + 4 * fq)) = acc[rb][cb];
    __syncthreads();
    { const int row = tid >> 2, c0 = (tid & 3) * 8;
      f32x4 s0 = {0.f, 0.f, 0.f, 0.f}, s1 = s0;
#pragma unroll
      for (int w = 0; w < 8; ++w) { s0 += *(const LAS f32x4*)(part + ((size_t)(w * 128 + row) * 32 + c0)); s1 += *(const LAS f32x4*)(part + ((size_t)(w * 128 + row) * 32 + c0 + 4)); }
      if (MODE == 0) { float* o = outF + (size_t)row * ldo + n0 + c0; *(f32x4*)o = s0; *(f32x4*)(o + 4) = s1; }
      else { v4u o; float a0 = fmaxf(s0.x, 0.f), a1 = fmaxf(s0.y, 0.f), a2 = fmaxf(s0.z, 0.f), a3 = fmaxf(s0.w, 0.f), b0 = fmaxf(s1.x, 0.f), b1 = fmaxf(s1.y, 0.f), b2 = fmaxf(s1.z, 0.f), b3 = fmaxf(s1.w, 0.f);
          o.x = pk2(a0 * a0, a1 * a1); o.y = pk2(a2 * a2, a3 * a3); o.z = pk2(b0 * b0, b1 * b1); o.w = pk2(b2 * b2, b3 * b3);
          *(v4u*)(outH + (size_t)row * ldo + n0 + c0) = o; } }
    __syncthreads();
}
template <bool OUT_BF16>
__device__ __forceinline__ void rms_row_slabs(const float* base, const float* slab  , int b, const float* gain, float* xstore, bf16* obf, float* of32, int lane) {
    const f32x4* xr = (const f32x4*)base + lane; const f32x4* gr = (const f32x4*)gain + lane;
    f32x4 v[8]; float s = 0.f;
#pragma unroll
    for (int j = 0; j < 8; ++j) { v[j] = xr[64 * j];
#pragma unroll
        for (int sp = 0; sp < 4; ++sp) v[j] += *((const f32x4*)(slab + ((size_t)sp * DB + b) * DM) + lane + 64 * j);
        s += (v[j].x * v[j].x + v[j].y * v[j].y) + (v[j].z * v[j].z + v[j].w * v[j].w);
        if (xstore) *((f32x4*)xstore + lane + 64 * j) = v[j]; }
    const float rstd = 1.f / sqrtf(wave_sum(s) * (1.f / DM) + EPS);
#pragma unroll
    for (int j = 0; j < 8; ++j) { const f32x4 g = gr[64 * j];
        if (OUT_BF16) *((unsigned long long*)obf + lane + 64 * j) = (unsigned long long)pk2(v[j].x * rstd * g.x, v[j].y * rstd * g.y) | ((unsigned long long)pk2(v[j].z * rstd * g.z, v[j].w * rstd * g.w) << 32);
        else *((f32x4*)of32 + lane + 64 * j) = v[j] * rstd * g; }
}

#define GAS __attribute__((address_space(1)))
typedef GAS unsigned gu32;
#define RLX_AGENT __ATOMIC_RELAXED, __HIP_MEMORY_SCOPE_AGENT
#define XB_TMO      128
#define XB_XCNT(j)  (256  + 64 * (j))
#define XB_XSUB(j)  (1280 + 64 * (j))
#define XB_XGEN(j)  (2304 + 64 * (j))
#define XB_TOP      3328
#define XB_TOPGEN   3392
#define XCD_BAR_WORDS 3456
#define XB_SPIN_CAP (1u << 18)

__device__ __forceinline__ unsigned xb_ld(unsigned* p)              { return __hip_atomic_load(p, __ATOMIC_RELAXED, __HIP_MEMORY_SCOPE_AGENT); }
__device__ __forceinline__ unsigned xb_add(unsigned* p, unsigned v) { return __hip_atomic_fetch_add(p, v, __ATOMIC_RELAXED, __HIP_MEMORY_SCOPE_AGENT); }
__device__ __forceinline__ unsigned xb_xcc_id() { return (unsigned)__builtin_amdgcn_s_getreg((3 << 11) | 20) & 0xFu; }
#define XB_SPIN(cond, bar) do { unsigned _sp = 0; while (cond) { __builtin_amdgcn_s_sleep(1); \
    if ((++_sp & 255u) == 0u) { if (xb_ld(&(bar)[XB_TMO])) break; if (_sp > XB_SPIN_CAP) { atomicAdd(&(bar)[XB_TMO], 1u); break; } } } } while (0)

struct XcdBarrier {
    unsigned* bar; unsigned x;
    volatile LAS unsigned* st;
};

__device__ __forceinline__ XcdBarrier xcd_barrier_post(unsigned* bar, volatile LAS unsigned* st) {
    XcdBarrier b; b.bar = bar; b.x = xb_xcc_id(); b.st = st;
    if (threadIdx.x == 0) (void)xb_add(&bar[XB_XCNT(b.x)], 1u);
    return b;
}
__device__ __forceinline__ void xcd_barrier_complete(unsigned* bar, unsigned x, unsigned& nloc, unsigned& nx) {
    const unsigned G = gridDim.x * gridDim.y * gridDim.z;
    unsigned sum, cnt, mine, sp = 0u;
    for (;;) {
        sum = 0u; cnt = 0u; mine = 0u;
#pragma unroll
        for (unsigned j = 0; j < 16; ++j) { const unsigned c = xb_ld(&bar[XB_XCNT(j)]); sum += c; cnt += (c > 0u) ? 1u : 0u; mine = (j == x) ? c : mine; }
        if (sum == G) break;
        __builtin_amdgcn_s_sleep(1);
        if ((++sp & 255u) == 0u) { if (xb_ld(&bar[XB_TMO])) break; if (sp > XB_SPIN_CAP) { atomicAdd(&bar[XB_TMO], 1u); break; } }
    }
    nloc = mine > 0u ? mine : 1u; nx = cnt > 0u ? cnt : 1u;
}

__device__ __forceinline__ void xcd_barrier(const XcdBarrier& b) {
    asm volatile("s_waitcnt vmcnt(0)" ::: "memory");
    __syncthreads();
    if (threadIdx.x == 0) {
        unsigned* bar = b.bar;
        __builtin_amdgcn_s_waitcnt(0);
        unsigned nloc = b.st[0], nx = b.st[1];
        if (nloc == 0u) { xcd_barrier_complete(bar, b.x, nloc, nx); b.st[0] = nloc; b.st[1] = nx; }
        const unsigned old = xb_add(&bar[XB_XSUB(b.x)], 1u);
        const unsigned gen = old / nloc;
        if (old + 1u == (gen + 1u) * nloc) {
            __builtin_amdgcn_fence(__ATOMIC_RELEASE, "agent");
            asm volatile("s_waitcnt vmcnt(0)" ::: "memory");
            const unsigned og = xb_add(&bar[XB_TOP], 1u);
            const unsigned tg = og / nx;
            if (og + 1u == (tg + 1u) * nx) xb_add(&bar[XB_TOPGEN], 1u);
            else XB_SPIN(xb_ld(&bar[XB_TOPGEN]) == tg, bar);
            __builtin_amdgcn_fence(__ATOMIC_ACQUIRE, "agent");
            xb_add(&bar[XB_XGEN(b.x)], 1u);
            asm volatile("s_waitcnt vmcnt(0)" ::: "memory");
        } else {
            XB_SPIN(xb_ld(&bar[XB_XGEN(b.x)]) == gen, bar);
            __builtin_amdgcn_fence(__ATOMIC_ACQUIRE, "agent");
            asm volatile("s_waitcnt vmcnt(0)" ::: "memory");
        }
    }
    __syncthreads();
}


__global__ void __launch_bounds__(512, 2) mk_fwd(Args a) {
    extern __shared__ __attribute__((aligned(16))) unsigned char lds_raw[];
    LAS unsigned char* lds = (LAS unsigned char*)lds_raw;
    const int tid = threadIdx.x, lane = tid & 63, wave = __builtin_amdgcn_readfirstlane(tid >> 6);
    const int G = gridDim.x, bid = blockIdx.x;
    const int gw = bid * 8 + wave, NGW = G * 8;
    unsigned char* ws = a.ws;
    const int lo = a.ph_lo, hi = a.ph_hi;
#ifndef PHASE_MASK
#define PHASE_MASK 0xFFF
#endif
#define IN(k) ((((PHASE_MASK) >> (k)) & 1) && lo <= (k) && (k) < hi)
#if MK_ONE_LAUNCH
    for (int u = tid; u < (LDS_BYTES - LDSCTL_OFF) / 4; u += 512) ((LAS unsigned*)(lds + LDSCTL_OFF))[u] = 0u;
    __syncthreads();
    if (hi > NPH) cg::this_grid().sync();
    XcdBarrier bar = xcd_barrier_post((unsigned*)(ws + WS_CTL) + CW_BAR, (volatile LAS unsigned*)(lds + MISC_OFF) + 8);
#define SEAM(k) do { if (IN(k) && IN((k) + 1)) xcd_barrier(bar); } while (0)
#else
#define SEAM(k) do { } while (0)
#endif
#ifndef DUPMASK
#define DUPMASK 0
#endif
#ifndef GREP
#define GREP 0
#endif
#define GR(k) ((((GREP) >> (k)) & 1) ? 2 : 1)
#define REPS(k) for (int rep_ = 0; rep_ < ((((DUPMASK) >> (k)) & 1) ? 2 : 1); ++rep_)
    if (IN(0)) REPS(0) { p0_prep(a, lds, gw, NGW, wave, lane); __syncthreads(); } SEAM(0);
    if (IN(1)) REPS(1) { pg8::Gemm g{(const pg8::bf16_t*)(ws + WS_XN), (const pg8::bf16_t*)(ws + WS_WIN), MP, NZ, DM, DM, DM, 0}; pg8::StaticOrder S; S.init(MP, NZ, G, bid);
        pg8::EpiIn E{a.out, ws};
        pg8::gemm_phase<pg8::EpiIn, pg8::StaticOrder, PG8_ALIGN, PG8_SP2>(lds, g, S, E); } SEAM(2);
#ifndef SUB3
#define SUB3 7
#endif
#ifndef SUB3DUP
#define SUB3DUP 0
#endif
#ifndef PMODE2
#define PMODE2 0
#endif
    if (IN(3)) {         p3_indexer_prompt<0>(a, lds, bid, G, tid, wave, lane, true); __syncthreads();
        if (SUB3DUP & 1) { p3_indexer_prompt<PMODE2>(a, lds, bid, G, tid, wave, lane, false); __syncthreads(); }
        for (int r3 = 0; r3 < ((SUB3DUP & 2) ? 2 : 1); ++r3) { p3_indexer_sample(a, lds, gw, NGW, wave, lane); }
        for (int r3 = 0; r3 < ((SUB3DUP & 4) ? 2 : 1); ++r3) p5_dpool(a, bid, G, tid); __syncthreads(); } SEAM(3);
    if (IN(4)) REPS(4) {
        { pg8::Gemm g{(const pg8::bf16_t*)(ws + WS_DPOOL), (const pg8::bf16_t*)(ws + WS_WPOOL), MP, 1024, 256, 1024, 256, 256}; pg8::StaticOrder S; S.init(MP, 1024, G, bid, GR(6));
          pg8::EpiBf16<0> E{(pg8::bf16_t*)(ws + WS_CAT), 2048, 1024, a.in[11]};
          pg8::gemm_phase<pg8::EpiBf16<0>, pg8::StaticOrder, PG8_ALIGN, PG8_SP2>(lds, g, S, E); }
        p4_topk(a, lds, gw, NGW, wave, lane); __syncthreads(); } SEAM(4);
#ifndef APROBE2
#define APROBE2 0
#endif
    if (IN(5)) { p5_attn<0>(a, lds, bid, G, wave, lane); __syncthreads(); if (APROBE2) { p5_attn<APROBE2>(a, lds, bid, G, wave, lane); __syncthreads(); } } SEAM(6);
    constexpr int R0 = NMETA;
    if (IN(7)) REPS(7) { pg8::Gemm g{(const pg8::bf16_t*)(ws + WS_CAT) + (size_t)R0 * DM, (const pg8::bf16_t*)(ws + WS_WOUT), SEQ, DM, DM, DM, DM, 0}; pg8::StaticOrder S; S.init(SEQ, DM, G, bid, GR(7));
        pg8::EpiRes E{(float*)(ws + WS_H1) + (size_t)R0 * DM, a.in[0]};
        pg8::gemm_phase<pg8::EpiRes, pg8::StaticOrder, PG8_ALIGN, PG8_SP2>(lds, g, S, E);
        for (int it = bid; it < 256; it += G) { const int ct = it & 63, sp = it >> 6;
            small_gemm_ksplit<512, 0>((const bf16*)(ws + WS_CAT) + (size_t)TP * DM, DM, (const bf16*)(ws + WS_WOUT), DM, 32 * ct, 512 * sp, (float*)(ws + WS_PS1) + (size_t)sp * DB * DM, nullptr, DM, lds, tid, wave, lane); }
    } SEAM(7);
    if (IN(8)) REPS(8) { float* H1 = (float*)(ws + WS_H1); bf16* XN = (bf16*)(ws + WS_XN);
        for (int m = gw; m < SEQ + DB; m += NGW) { const int r = R0 + m;
            if (m < SEQ) rms_row_to_bf16(H1 + (size_t)r * DM, a.in[13], XN + (size_t)r * DM, lane);
            else rms_row_slabs<true>(a.in[1] + (size_t)(m - SEQ) * DM, (const float*)(ws + WS_PS1), m - SEQ, a.in[13], H1 + (size_t)r * DM, XN + (size_t)r * DM, nullptr, lane); } } SEAM(8);
    if (IN(9)) REPS(9) { pg8::Gemm g{(const pg8::bf16_t*)(ws + WS_XN) + (size_t)R0 * DM, (const pg8::bf16_t*)(ws + WS_WUP), SEQ, DFF, DM, DM, DM, 0}; pg8::StaticOrder S; S.init(SEQ, DFF, G, bid, GR(9));
        pg8::EpiBf16<1> E{(pg8::bf16_t*)(ws + WS_ACT) + (size_t)R0 * DFF, DFF, 0, nullptr};
        pg8::gemm_phase<pg8::EpiBf16<1>, pg8::StaticOrder, PG8_ALIGN, PG8_SP2>(lds, g, S, E);
        for (int it = bid; it < 256; it += G)
            small_gemm_ksplit<2048, 1>((const bf16*)(ws + WS_XN) + (size_t)TP * DM, DM, (const bf16*)(ws + WS_WUP), DM, 32 * it, 0, nullptr, (bf16*)(ws + WS_ACT) + (size_t)TP * DFF, DFF, lds, tid, wave, lane);
    } SEAM(9);
    if (IN(10)) REPS(10) { pg8::Gemm g{(const pg8::bf16_t*)(ws + WS_ACT) + (size_t)R0 * DFF, (const pg8::bf16_t*)(ws + WS_WDN), SEQ, DM, DFF, DFF, DFF, 0}; pg8::StaticOrder S; S.init(SEQ, DM, G, bid, GR(10));
        pg8::EpiRes E{(float*)(ws + WS_H2) + (size_t)R0 * DM, (const float*)(ws + WS_H1) + (size_t)R0 * DM};
        pg8::gemm_phase<pg8::EpiRes, pg8::StaticOrder, PG8_ALIGN, PG8_SP2>(lds, g, S, E);
        for (int it = bid; it < 256; it += G) { const int ct = it & 63, sp = it >> 6;
            small_gemm_ksplit<2048, 0>((const bf16*)(ws + WS_ACT) + (size_t)TP * DFF, DFF, (const bf16*)(ws + WS_WDN), DFF, 32 * ct, 2048 * sp, (float*)(ws + WS_PS2) + (size_t)sp * DB * DM, nullptr, DM, lds, tid, wave, lane); }
    } SEAM(10);
    if (IN(11)) REPS(11) { const float* H2 = (const float*)(ws + WS_H2); const float* H1 = (const float*)(ws + WS_H1);
        for (int m = gw; m < SEQ + DB; m += NGW) { const int r = R0 + m;
            if (m < SEQ) rms_row_to_f32(H2 + (size_t)r * DM, a.in[16], a.out + O_YP + (size_t)m * DM, lane);
            else rms_row_slabs<false>(H1 + (size_t)r * DM, (const float*)(ws + WS_PS2), m - SEQ, a.in[16], nullptr, nullptr, a.out + O_YS + (size_t)(m - SEQ) * DM, lane); } }
#undef IN
#undef SEAM
}

extern "C" void kernel_launch(void* const* d_in, const int* in_sizes, int n_in, void* d_out, int out_size, void* d_ws, size_t ws_size, hipStream_t stream) {
    static int grid = 0;
    if (grid == 0) {
        if (n_in != 17 || (size_t)out_size != O_END || ws_size < WS_END) { fprintf(stderr, "kernel_launch: unexpected shapes: n_in %d out_size %d (want %zu) ws %zu (want >= %zu)\n", n_in, out_size, (size_t)O_END, ws_size, (size_t)WS_END); grid = -1; return; }
        int dev = 0, cus = 0, per_cu = 0;
        if (hipGetDevice(&dev) != hipSuccess || hipDeviceGetAttribute(&cus, hipDeviceAttributeMultiprocessorCount, dev) != hipSuccess) { grid = -1; return; }
        if (hipFuncSetAttribute((const void*)mk_fwd, hipFuncAttributeMaxDynamicSharedMemorySize, LDS_BYTES) != hipSuccess) { fprintf(stderr, "kernel_launch: hipFuncSetAttribute failed\n"); grid = -1; return; }
        if (hipOccupancyMaxActiveBlocksPerMultiprocessor(&per_cu, (const void*)mk_fwd, 512, LDS_BYTES) != hipSuccess || per_cu < 1) { fprintf(stderr, "kernel_launch: occupancy query says %d\n", per_cu); grid = -1; return; }
        grid = cus;
        fprintf(stderr, "kernel_launch: grid %d (cus %d, per_cu %d)\n", grid, cus, per_cu);
    }
    if (grid < 0) return;
    Args a{};
    for (int i = 0; i < 17; ++i) a.in[i] = (const float*)d_in[i];
    a.out = (float*)d_out; a.ws = (unsigned char*)d_ws;
#if MK_ONE_LAUNCH
    a.ph_lo = 0; a.ph_hi = NPH;
    if (hipMemsetAsync((char*)d_ws + WS_CTL, 0, 65536, stream) != hipSuccess) { fprintf(stderr, "kernel_launch: memset failed\n"); return; }
    void* args[] = {&a};
    hipError_t e = hipLaunchCooperativeKernel((const void*)mk_fwd, dim3(grid), dim3(512), args, LDS_BYTES, stream);
    if (e != hipSuccess) fprintf(stderr, "kernel_launch: cooperative launch failed: %s (grid %d)\n", hipGetErrorString(e), grid);
#else
    for (int p = 0; p < NPH; ++p) { a.ph_lo = p; a.ph_hi = p + 1; hipLaunchKernelGGL(mk_fwd, dim3(grid), dim3(512), LDS_BYTES, stream, a); }
#endif
}
```

```cpp
#include <hip/hip_runtime.h>
#include <hip/hip_cooperative_groups.h>
#include <cstdio>
#include <cstdint>
namespace cg = cooperative_groups;

namespace pg8 {
#define PG8_LAS __attribute__((address_space(3)))
typedef unsigned short bf16_t;
typedef short bf16x8 __attribute__((ext_vector_type(8)));
typedef float f32x4 __attribute__((ext_vector_type(4)));
typedef unsigned u32x4 __attribute__((ext_vector_type(4)));
constexpr int BM = 256, BK = 64, HALF = 128, HTB = HALF * BK * 2  , STAGE_BYTES = 8 * HTB, NXCD = 8, WGM = 8;

__host__ __device__ __forceinline__ int lds_byte(int r, int c) { const int st = (r >> 4) * 2 + (c >> 5), rr = r & 15, cc = c & 31, ob = rr * 64 + cc * 2; return st * 1024 + (ob ^ (((ob >> 9) & 1) << 5)); }
__host__ __device__ __forceinline__ void stage_rc(int b, int& R, int& C) { const int st = b / 1024, sb = b % 1024, swz = sb ^ (((sb >> 9) & 1) << 5); R = (st >> 1) * 16 + swz / 64; C = (st & 1) * 32 + (swz % 64) / 2; }
__host__ __device__ __forceinline__ int perm32(int rho) { const int n = rho >> 4, i = rho & 15; return 8 * (i >> 2) + 4 * n + (i & 3); }

struct Unit { int pm, pn; };
struct Gemm { const bf16_t* A; const bf16_t* Bt; int M, N, K, lda, ldb, acs; };

struct StaticOrder {
    int nM, nN, nwg, G, c, rep;
    __host__ __device__ void init(int M, int N, int G_, int c_, int rep_ = 1) { nM = M / BM; nN = N / BM; nwg = nM * nN; G = G_; c = c_; rep = rep_; }
    __host__ __device__ bool next(int i, Unit& u) const {
        const int R = (nwg + G - 1) / G;
        if (i >= R * rep) return false;
        const long L = (long)(i % R) * G + c; if (L >= nwg) return (i + 1 < R * rep) ? next(i + 1, u) : false;
        int wgid = (int)L; { const int q = nwg / NXCD, r = nwg % NXCD, xcd = wgid % NXCD, off = wgid / NXCD; wgid = (xcd < r ? xcd * (q + 1) : r * (q + 1) + (xcd - r) * q) + off; }
        const int nig = WGM * nN, gid = wgid / nig, fm = gid * WGM, gsz = (nM - fm) < WGM ? (nM - fm) : WGM;
        u.pm = fm + ((wgid % nig) % gsz); u.pn = (wgid % nig) / gsz; return true;
    }
    __device__ __forceinline__ void a_ready(const Unit&) const {}
    __device__ __forceinline__ void done(const Unit&) const {}
};


__device__ __forceinline__ unsigned cvt_pk_bf16(float lo, float hi) { unsigned r; asm volatile("v_cvt_pk_bf16_f32 %0, %1, %2" : "=v"(r) : "v"(lo), "v"(hi)); return r; }

struct EpiF32 {
    static constexpr bool PERM = false, AFTER_DRAIN = false;
    float* C; int ldc;
    __device__ __forceinline__ void operator()(const f32x4 (&acc)[2][2][4][2], const Unit& u, int wr, int wc, int fr, int fq) const {
        const int row0 = u.pm * BM + wr * 64 + fr, col0 = u.pn * BM + wc * 32 + 4 * fq;
#pragma unroll
        for (int ai = 0; ai < 2; ++ai)
#pragma unroll
            for (int m = 0; m < 4; ++m) { float* rowp = C + (size_t)(row0 + ai * HALF + m * 16) * ldc + col0;
#pragma unroll
                for (int bj = 0; bj < 2; ++bj)
#pragma unroll
                    for (int n = 0; n < 2; ++n) *(f32x4*)(rowp + bj * HALF + n * 16) = acc[ai][bj][m][n]; }
    }
};
template <int ACT> struct EpiBf16 {
    static constexpr bool PERM = true, AFTER_DRAIN = false;
    bf16_t* O; int ldc; int col_off; const float* colscale;
    __device__ __forceinline__ void operator()(const f32x4 (&acc)[2][2][4][2], const Unit& u, int wr, int wc, int fr, int fq) const {
        const int row0 = u.pm * BM + wr * 64 + fr; const int col0 = u.pn * BM + wc * 32 + 8 * fq;
#pragma unroll
        for (int bj = 0; bj < 2; ++bj) {
            f32x4 sv0 = (f32x4){1.f, 1.f, 1.f, 1.f}, sv1 = sv0;
            if (ACT == 0) { sv0 = *(const f32x4*)(colscale + col0 + bj * HALF); sv1 = *(const f32x4*)(colscale + col0 + bj * HALF + 4); }
#pragma unroll
            for (int ai = 0; ai < 2; ++ai)
#pragma unroll
                for (int m = 0; m < 4; ++m) { bf16_t* rowp = O + (size_t)(row0 + ai * HALF + m * 16) * ldc + col_off + col0;
                    f32x4 v0 = acc[ai][bj][m][0], v1 = acc[ai][bj][m][1];
                    if (ACT == 0) { v0 = v0 * sv0; v1 = v1 * sv1; }
                    if (ACT == 1) {
#pragma unroll
                        for (int j = 0; j < 4; ++j) { const float a = fmaxf(v0[j], 0.f), b = fmaxf(v1[j], 0.f); v0[j] = a * a; v1[j] = b * b; } }
                    u32x4 w; w.x = cvt_pk_bf16(v0[0], v0[1]); w.y = cvt_pk_bf16(v0[2], v0[3]); w.z = cvt_pk_bf16(v1[0], v1[1]); w.w = cvt_pk_bf16(v1[2], v1[3]);
                    *(u32x4*)(rowp + bj * HALF) = w; }
        }
    }
};
struct EpiRes {
    static constexpr bool PERM = false, AFTER_DRAIN = false;
    float* C; const float* R;
    __device__ __forceinline__ void operator()(const f32x4 (&acc)[2][2][4][2], const Unit& u, int wr, int wc, int fr, int fq) const {
        const int row0 = u.pm * BM + wr * 64 + fr, col0 = u.pn * BM + wc * 32 + 4 * fq;
#pragma unroll
        for (int ai = 0; ai < 2; ++ai)
#pragma unroll
            for (int m = 0; m < 4; ++m) { const size_t off = (size_t)(row0 + ai * HALF + m * 16) * 2048 + col0;
#pragma unroll
                for (int bj = 0; bj < 2; ++bj)
#pragma unroll
                    for (int n = 0; n < 2; ++n) { const f32x4 rv = *(const f32x4*)(R + off + bj * HALF + n * 16);
                        *(f32x4*)(C + off + bj * HALF + n * 16) = acc[ai][bj][m][n] + rv; } }
    }
};


template <class Epi, class Sched, bool ALIGN_EPI = false, bool SP2 = false>
__device__ __forceinline__ void gemm_phase(PG8_LAS unsigned char* lds, const Gemm g, const Sched& S, const Epi& E) {
    const int tid = threadIdx.x, wid = __builtin_amdgcn_readfirstlane(tid >> 6), lane = tid & 63, wr = wid >> 2, wc = wid & 3, fr = lane & 15, fq = lane >> 4;
    const int K = g.K, nt = K / BK;
    unsigned voffA[2], voffB[2];
#pragma unroll
    for (int i = 0; i < 2; ++i) { int R, C; stage_rc(tid * 16 + i * 8192, R, C); const int Rb = Epi::PERM ? ((R & ~31) + perm32(R & 31)) : R;
        voffA[i] = (unsigned)(R * g.lda + C) * 2u; voffB[i] = (unsigned)(Rb * g.ldb + C) * 2u; }
    const size_t kstep = (size_t)(BK * 2);
    const size_t hstepA = (size_t)HALF * g.lda * 2, hstepB = (size_t)HALF * g.ldb * 2;
    const size_t tstepA = 2 * hstepA, tstepB = 2 * hstepB;
    const size_t acs2 = (size_t)g.acs * 2;
    const unsigned ldsw = (unsigned)wid * 1024u;
    const int aoff = lds_byte(wr * 64 + fr, fq * 8), boff = lds_byte(wc * 32 + fr, fq * 8);
#define PG8_SA(b, h) (((b) * 2 + (h)) * HTB)
#define PG8_SB(b, h) ((4 + (b) * 2 + (h)) * HTB)
#define PG8_STAGE(bufoff, gbase, voff) do { _Pragma("unroll") for (int _i = 0; _i < 2; ++_i) \
        __builtin_amdgcn_global_load_lds((const unsigned*)((const char*)(gbase) + (voff)[_i]), (PG8_LAS unsigned*)(lds + (bufoff) + ldsw + _i * 8192), 16, 0, 0); } while (0)
#define PG8_LDA(dst, b, h) do { _Pragma("unroll") for (int m = 0; m < 4; ++m) _Pragma("unroll") for (int k = 0; k < 2; ++k) dst[m][k] = *(const PG8_LAS bf16x8*)(lds + PG8_SA(b, h) + aoff + m * 2048 + k * 1024); } while (0)
#define PG8_LDB(dst, b, h) do { _Pragma("unroll") for (int n = 0; n < 2; ++n) _Pragma("unroll") for (int k = 0; k < 2; ++k) dst[n][k] = *(const PG8_LAS bf16x8*)(lds + PG8_SB(b, h) + boff + n * 2048 + k * 1024); } while (0)
#define PG8_MMA(ai, bj, At, Bt) do { __builtin_amdgcn_s_setprio(1); _Pragma("unroll") for (int m = 0; m < 4; ++m) _Pragma("unroll") for (int n = 0; n < 2; ++n) _Pragma("unroll") for (int k = 0; k < 2; ++k) \
        acc[ai][bj][m][n] = __builtin_amdgcn_mfma_f32_16x16x32_bf16(Bt[n][k], At[m][k], acc[ai][bj][m][n], 0, 0, 0); __builtin_amdgcn_s_setprio(0); } while (0)
#define PG8_WAIT_V(n) asm volatile("s_waitcnt vmcnt(" #n ")" ::: "memory")
#define PG8_WAIT_L(n) asm volatile("s_waitcnt lgkmcnt(" #n ")" ::: "memory")
#define PG8_BAR __builtin_amdgcn_s_barrier()
#define PG8_SCHED __builtin_amdgcn_sched_barrier(0)
    Unit cur, nxt; int ui = 0;
    if (!S.next(0, cur)) return;
    f32x4 acc[2][2][4][2];
#pragma unroll
    for (int a = 0; a < 2; ++a)
#pragma unroll
        for (int b = 0; b < 2; ++b)
#pragma unroll
            for (int m = 0; m < 4; ++m)
#pragma unroll
                for (int n = 0; n < 2; ++n) acc[a][b][m][n] = (f32x4){0.f, 0.f, 0.f, 0.f};
    bf16x8 At[4][2], B0[2][2], B1[2][2];
    const char* cA = (const char*)g.A + (size_t)cur.pm * tstepA + (size_t)cur.pn * acs2; const char* cB = (const char*)g.Bt + (size_t)cur.pn * tstepB;
    S.a_ready(cur);
    if constexpr (SP2) {
        PG8_STAGE(PG8_SB(0, 0), cB, voffB); PG8_STAGE(PG8_SB(0, 1), cB + hstepB, voffB); PG8_STAGE(PG8_SA(0, 0), cA, voffA); PG8_STAGE(PG8_SA(0, 1), cA + hstepA, voffA);
        if (wr == 1) PG8_BAR;
        PG8_WAIT_V(2); PG8_BAR;
        PG8_STAGE(PG8_SB(1, 0), cB + kstep, voffB); PG8_STAGE(PG8_SA(1, 0), cA + kstep, voffA); PG8_STAGE(PG8_SB(1, 1), cB + hstepB + kstep, voffB);
        PG8_WAIT_V(6); PG8_BAR;
    } else {
        PG8_STAGE(PG8_SB(0, 0), cB, voffB); PG8_STAGE(PG8_SA(0, 0), cA, voffA); PG8_STAGE(PG8_SB(0, 1), cB + hstepB, voffB); PG8_STAGE(PG8_SA(0, 1), cA + hstepA, voffA);
        if (wr == 1) PG8_BAR;
        PG8_WAIT_V(4); PG8_BAR;
        PG8_STAGE(PG8_SB(1, 0), cB + kstep, voffB); PG8_STAGE(PG8_SA(1, 0), cA + kstep, voffA); PG8_STAGE(PG8_SB(1, 1), cB + hstepB + kstep, voffB);
        PG8_WAIT_V(6); PG8_BAR;
    }
    for (;;) {
        const bool has_next = S.next(ui + 1, nxt);
        const char* nA = has_next ? (const char*)g.A + (size_t)nxt.pm * tstepA + (size_t)nxt.pn * acs2 : cA; const char* nB = has_next ? (const char*)g.Bt + (size_t)nxt.pn * tstepB : cB;
        for (int t = 0; t < nt; t += 2) {
            const bool last = (t == nt - 2);
            const char* a1 = cA + (size_t)(t + 1) * kstep;
            const char* a2 = last ? nA : cA + (size_t)(t + 2) * kstep; const char* b2 = last ? nB : cB + (size_t)(t + 2) * kstep;
            const char* a3 = a2 + kstep; const char* b3 = b2 + kstep;
            if (last && has_next) S.a_ready(nxt);
            if constexpr (SP2) {
            PG8_LDB(B0, 0, 0); PG8_LDB(B1, 0, 1); PG8_SCHED; PG8_LDA(At, 0, 0); PG8_STAGE(PG8_SA(1, 1), a1 + hstepA, voffA);
            PG8_WAIT_V(8); PG8_WAIT_L(0); PG8_BAR; PG8_MMA(0, 0, At, B0); PG8_MMA(0, 1, At, B1); PG8_BAR; PG8_SCHED;
            PG8_LDA(At, 0, 1); PG8_STAGE(PG8_SB(0, 0), b2, voffB); PG8_STAGE(PG8_SB(0, 1), b2 + hstepB, voffB); PG8_STAGE(PG8_SA(0, 0), a2, voffA);
            PG8_WAIT_V(8); PG8_WAIT_L(0); PG8_BAR; PG8_MMA(1, 0, At, B0); PG8_MMA(1, 1, At, B1); PG8_BAR; PG8_SCHED;
            PG8_LDB(B0, 1, 0); PG8_LDB(B1, 1, 1); PG8_SCHED; PG8_LDA(At, 1, 0); PG8_STAGE(PG8_SA(0, 1), a2 + hstepA, voffA);
            PG8_WAIT_V(8); PG8_WAIT_L(0); PG8_BAR; PG8_MMA(0, 0, At, B0); PG8_MMA(0, 1, At, B1); PG8_BAR; PG8_SCHED;
            PG8_LDA(At, 1, 1); PG8_STAGE(PG8_SB(1, 0), b3, voffB); PG8_STAGE(PG8_SB(1, 1), b3 + hstepB, voffB); PG8_STAGE(PG8_SA(1, 0), a3, voffA);
            PG8_WAIT_V(8); PG8_WAIT_L(0); PG8_BAR; PG8_MMA(1, 0, At, B0); PG8_MMA(1, 1, At, B1); PG8_BAR; PG8_SCHED;
            } else {
            PG8_LDB(B0, 0, 0); PG8_SCHED; PG8_LDA(At, 0, 0); PG8_STAGE(PG8_SA(1, 1), a1 + hstepA, voffA);
            PG8_WAIT_L(8); PG8_BAR; PG8_WAIT_L(0); PG8_MMA(0, 0, At, B0); PG8_BAR; PG8_SCHED;
            PG8_LDB(B1, 0, 1); PG8_STAGE(PG8_SB(0, 0), b2, voffB);
            PG8_BAR; PG8_WAIT_L(0); PG8_MMA(0, 1, At, B1); PG8_BAR;
            PG8_LDA(At, 0, 1); PG8_STAGE(PG8_SA(0, 0), a2, voffA);
            PG8_BAR; PG8_WAIT_L(0); PG8_MMA(1, 0, At, B0); PG8_BAR; PG8_SCHED;
            PG8_STAGE(PG8_SB(0, 1), b2 + hstepB, voffB);
            PG8_WAIT_V(6); PG8_BAR; PG8_MMA(1, 1, At, B1); PG8_BAR;
            PG8_LDB(B0, 1, 0); PG8_SCHED; PG8_LDA(At, 1, 0); PG8_STAGE(PG8_SA(0, 1), a2 + hstepA, voffA);
            PG8_WAIT_L(8); PG8_BAR; PG8_WAIT_L(0); PG8_MMA(0, 0, At, B0); PG8_BAR; PG8_SCHED;
            PG8_LDB(B1, 1, 1); PG8_STAGE(PG8_SB(1, 0), b3, voffB);
            PG8_BAR; PG8_WAIT_L(0); PG8_MMA(0, 1, At, B1); PG8_BAR;
            PG8_LDA(At, 1, 1); PG8_STAGE(PG8_SA(1, 0), a3, voffA);
            PG8_BAR; PG8_WAIT_L(0); PG8_MMA(1, 0, At, B0); PG8_BAR; PG8_SCHED;
            PG8_STAGE(PG8_SB(1, 1), b3 + hstepB, voffB);
            PG8_WAIT_V(6); PG8_BAR; PG8_MMA(1, 1, At, B1); PG8_BAR;
            }
        }
        if constexpr (ALIGN_EPI) { if (wr == 0) PG8_BAR; }
        if constexpr (!Epi::AFTER_DRAIN) { E(acc, cur, wr, wc, fr, fq); S.done(cur); }
        if (!has_next) break;
#pragma unroll
        for (int a = 0; a < 2; ++a)
#pragma unroll
            for (int b = 0; b < 2; ++b)
#pragma unroll
                for (int m = 0; m < 4; ++m)
#pragma unroll
                    for (int n = 0; n < 2; ++n) acc[a][b][m][n] = (f32x4){0.f, 0.f, 0.f, 0.f};
        cur = nxt; cA = nA; cB = nB; ++ui;
        if constexpr (ALIGN_EPI) { if (wr == 1) PG8_BAR; }
    }
    PG8_WAIT_V(0);
    if constexpr (!ALIGN_EPI) { if (wr == 0) PG8_BAR; }
    PG8_BAR;
    if constexpr (Epi::AFTER_DRAIN) { E.fused(acc, cur, wr, wc, fr, fq, lds, wid, lane); S.done(cur); }
#undef PG8_SA
#undef PG8_SB
#undef PG8_STAGE
#undef PG8_LDA
#undef PG8_LDB
#undef PG8_MMA
#undef PG8_WAIT_V
#undef PG8_WAIT_L
#undef PG8_BAR
#undef PG8_SCHED
}
}

#ifndef PG8_SP2
#define PG8_SP2 true
#endif
#ifndef PG8_ALIGN
#define PG8_ALIGN true
#endif
#ifndef MK_ONE_LAUNCH
#define MK_ONE_LAUNCH 1
#endif

constexpr int DM = 2048, SEQ = 8192, NMETA = 16, TP = SEQ + NMETA, DB = 128, MR = TP + DB, MP = 8448;
constexpr int HD = 128, NH = 8, NKV = 2, NIH = 16, IDD = 64, TOPK = 256, NZR = 3664, NZ = 3840, DFF = 8192;
constexpr int PAST = 2048, PAGE = 128, NPAGES = 16, LS = PAST + 1;
constexpr int ZQ = 0, ZK = 1024, ZV = 1280, ZQI = 1536, ZKI = 2560, ZWI = 2624, ZU = 2640;
constexpr float EPS = 1e-6f;
constexpr int SCLD = 8256, SCROWS = 8224, SCSLD = 2304;
constexpr size_t O_YP = 0, O_YS = O_YP + (size_t)SEQ * DM, O_KP = O_YS + (size_t)DB * DM, O_VP = O_KP + (size_t)TP * 256, O_KIP = O_VP + (size_t)TP * 256,
                 O_PP = O_KIP + (size_t)TP * 64, O_KS = O_PP + 15 * 1024, O_VS = O_KS + DB * 256, O_KIS = O_VS + DB * 256, O_PS = O_KIS + DB * 64, O_END = O_PS + (size_t)DB * 15 * 1024;
constexpr size_t MiB = 1u << 20;
constexpr size_t WS_CTL = 0, WS_WIN = 2 * MiB, WS_WOUT = 18 * MiB, WS_WUP = 26 * MiB, WS_WDN = 58 * MiB, WS_WPOOL = 90 * MiB, WS_XN = 92 * MiB, WS_Z = 126 * MiB,
                 WS_QF = 250 * MiB, WS_QI = 284 * MiB, WS_KI = 302 * MiB, WS_WI = 304 * MiB, WS_U = 306 * MiB, WS_QI32 = 340 * MiB, WS_SCS = 341 * MiB, WS_SEL = 344 * MiB,
                 WS_DPOOL = 356 * MiB, WS_CAT = 374 * MiB, WS_H1 = 408 * MiB, WS_ACT = 476 * MiB, WS_H2 = 608 * MiB, WS_SC = 676 * MiB, WS_PS1 = 936 * MiB, WS_PS2 = 944 * MiB, WS_QB = 952 * MiB, WS_KB = 970 * MiB, WS_VB = 975 * MiB, WS_QL = 980 * MiB, WS_CS = 984 * MiB, WS_END = 992 * MiB;
static_assert(WS_Z + (size_t)MP * NZ * 4 <= WS_QF && WS_SC + (size_t)SCROWS * SCLD * 4 <= WS_PS1 && WS_ACT + (size_t)MP * DFF * 2 <= WS_H2, "ws map");
constexpr int LDS_BYTES = 163840;
constexpr int NPH = 12;

#define LAS __attribute__((address_space(3)))
typedef unsigned short bf16;
typedef unsigned v4u __attribute__((ext_vector_type(4)));
typedef float f32x4 __attribute__((ext_vector_type(4)));
typedef float f32x16 __attribute__((ext_vector_type(16)));
typedef _Float16 f16x8 __attribute__((ext_vector_type(8)));
typedef _Float16 f16;
typedef short bf16x8_t __attribute__((ext_vector_type(8)));

__device__ const double INV_FREQ[64] = { 1.00000000000000000e+00, 8.65964323360065347e-01, 7.49894209332455874e-01, 6.49381631576211316e-01, 5.62341325190349073e-01, 4.86967525165863113e-01, 4.21696503428582226e-01, 3.65174127254837722e-01, 3.16227766016837941e-01, 2.73841963426436130e-01, 2.37137370566165517e-01, 2.05352502645714613e-01, 1.77827941003892293e-01, 1.53992652605949187e-01, 1.33352143216332403e-01, 1.15478198468945817e-01, 1.00000000000000006e-01, 8.65964323360065291e-02, 7.49894209332455791e-02, 6.49381631576211316e-02, 5.62341325190349114e-02, 4.86967525165863113e-02, 4.21696503428582239e-02, 3.65174127254837694e-02, 3.16227766016837913e-02, 2.73841963426436144e-02, 2.37137370566165538e-02, 2.05352502645714599e-02, 1.77827941003892293e-02, 1.53992652605949194e-02, 1.33352143216332406e-02, 1.15478198468945813e-02, 1.00000000000000002e-02, 8.65964323360065430e-03, 7.49894209332455791e-03, 6.49381631576211298e-03, 5.62341325190349097e-03, 4.86967525165863096e-03, 4.21696503428582292e-03, 3.65174127254837711e-03, 3.16227766016837939e-03, 2.73841963426436127e-03, 2.37137370566165538e-03, 2.05352502645714599e-03, 1.77827941003892275e-03, 1.53992652605949203e-03, 1.33352143216332406e-03, 1.15478198468945813e-03, 1.00000000000000002e-03, 8.65964323360065387e-04, 7.49894209332455856e-04, 6.49381631576211342e-04, 5.62341325190349097e-04, 4.86967525165863096e-04, 4.21696503428582237e-04, 3.65174127254837700e-04, 3.16227766016837939e-04, 2.73841963426436105e-04, 2.37137370566165538e-04, 2.05352502645714610e-04, 1.77827941003892270e-04, 1.53992652605949192e-04, 1.33352143216332395e-04, 1.15478198468945822e-04 };

struct Args { const float* in[17]; float* out; unsigned char* ws; int ph_lo, ph_hi; };
constexpr int CW_BAR = 4096;
constexpr int LDSCTL_OFF = 159744, MISC_OFF = LDSCTL_OFF + 320;

#define LDS_WAIT() asm volatile("s_waitcnt lgkmcnt(0)" ::: "memory")
__device__ __forceinline__ unsigned f2bf(float f) { unsigned u = __builtin_bit_cast(unsigned, f); return (u + 0x7fffu + ((u >> 16) & 1u)) >> 16; }
__device__ __forceinline__ unsigned pk2(float lo, float hi) { return f2bf(lo) | (f2bf(hi) << 16); }
__device__ __forceinline__ float wave_sum(float v) {
#pragma unroll
    for (int o = 1; o < 64; o <<= 1) v += __shfl_xor(v, o);
    return v;
}
__device__ __forceinline__ const float* in_row(const Args& a, int r) {
    return r < NMETA ? a.in[7] + (size_t)r * DM : r < TP ? a.in[0] + (size_t)(r - NMETA) * DM : r < MR ? a.in[1] + (size_t)(r - TP) * DM : (const float*)nullptr;
}

__device__ __forceinline__ int win_src_col(int n) {
    const int pn = n >> 8, c = n & 255, half = c >> 7, cc = c & 127;
    if (pn < 4) return ZQ + (2 * pn + (cc >> 6)) * 128 + half * 64 + (cc & 63);
    if (pn == 4) return ZK + (cc >> 6) * 128 + half * 64 + (cc & 63);
    if (pn == 5) return ZV + c;
    if (pn < 10) return ZQI + (4 * (pn - 6) + (cc >> 5)) * 64 + half * 32 + (cc & 31);
    if (pn == 10) return c < 32 ? ZKI + c : c < 48 ? ZWI + (c - 32) : (c >= 128 && c < 160) ? ZKI + 32 + (c - 128) : -1;
    return ZU + (pn - 11) * 256 + c;
}
template <bool WIN = false>
__device__ __forceinline__ void p0_transpose_item(const float* W, int K, int N, bf16* WT, LAS float* scr, int item, int nblk, int lane) {
    const int kb = item / nblk, nb = item % nblk, k0 = 64 * kb, n0 = 32 * nb;
    const int n_rd = WIN ? win_src_col(n0 + (lane & 31)) : ((n0 + (lane & 31)) < N ? n0 + (lane & 31) : -1);
    float rv[32];
#pragma unroll
    for (int i = 0; i < 32; ++i) { const int kk = 2 * i + (lane >> 5); rv[i] = n_rd >= 0 ? W[(size_t)(k0 + kk) * N + n_rd] : 0.f; }
#pragma unroll
    for (int i = 0; i < 32; ++i) { const int kk = 2 * i + (lane >> 5); scr[kk * 33 + (lane & 31)] = rv[i]; }
    LDS_WAIT();
    const int c = lane & 7;
#pragma unroll
    for (int j = 0; j < 4; ++j) { const int n = (lane >> 3) + 8 * j; const LAS float* s = scr + (8 * c) * 33 + n;
        v4u o; o.x = pk2(s[0 * 33], s[1 * 33]); o.y = pk2(s[2 * 33], s[3 * 33]); o.z = pk2(s[4 * 33], s[5 * 33]); o.w = pk2(s[6 * 33], s[7 * 33]);
        *(v4u*)(WT + (size_t)(n0 + n) * K + k0 + 8 * c) = o; }
    LDS_WAIT();
}
#ifndef CONV_IN_ATTN
#define CONV_IN_ATTN 1
#endif
constexpr int CV_OUT = 32 * 64, CV_UP = 32 * 256, CV_DN = 128 * 64, CV_N = CV_OUT + CV_UP + CV_DN;
__device__ __forceinline__ void conv_item(const Args& a, LAS float* scr, int it, int lane) {
    unsigned char* ws = a.ws;
    if (it < CV_OUT) { p0_transpose_item(a.in[12], DM, DM, (bf16*)(ws + WS_WOUT), scr, it, 64, lane); return; } it -= CV_OUT;
    if (it < CV_UP) { p0_transpose_item(a.in[14], DM, DFF, (bf16*)(ws + WS_WUP), scr, it, 256, lane); return; } it -= CV_UP;
    p0_transpose_item(a.in[15], DFF, DM, (bf16*)(ws + WS_WDN), scr, it, 64, lane);
}
__device__ __forceinline__ void p0_transpose_pair(const float* W, int K, int N, bf16* WT, LAS float* scrA, LAS float* scrB, int itemA, int itemB, int nblk, int lane) {
    const int k0a = 64 * (itemA / nblk), n0a = 32 * (itemA % nblk), k0b = 64 * (itemB / nblk), n0b = 32 * (itemB % nblk);
    const int na = n0a + (lane & 31), nb = n0b + (lane & 31);
    float ra[32], rb[32];
#pragma unroll
    for (int i = 0; i < 32; ++i) { const int kk = 2 * i + (lane >> 5); ra[i] = W[(size_t)(k0a + kk) * N + na]; rb[i] = W[(size_t)(k0b + kk) * N + nb]; }
#pragma unroll
    for (int i = 0; i < 32; ++i) { const int kk = 2 * i + (lane >> 5); scrA[kk * 33 + (lane & 31)] = ra[i]; scrB[kk * 33 + (lane & 31)] = rb[i]; }
    LDS_WAIT();
    const int c = lane & 7;
#pragma unroll
    for (int j = 0; j < 4; ++j) { const int n = (lane >> 3) + 8 * j; const LAS float* sa = scrA + (8 * c) * 33 + n; const LAS float* sb = scrB + (8 * c) * 33 + n;
        v4u o; o.x = pk2(sa[0 * 33], sa[1 * 33]); o.y = pk2(sa[2 * 33], sa[3 * 33]); o.z = pk2(sa[4 * 33], sa[5 * 33]); o.w = pk2(sa[6 * 33], sa[7 * 33]);
        *(v4u*)(WT + (size_t)(n0a + n) * K + k0a + 8 * c) = o;
        v4u q; q.x = pk2(sb[0 * 33], sb[1 * 33]); q.y = pk2(sb[2 * 33], sb[3 * 33]); q.z = pk2(sb[4 * 33], sb[5 * 33]); q.w = pk2(sb[6 * 33], sb[7 * 33]);
        *(v4u*)(WT + (size_t)(n0b + n) * K + k0b + 8 * c) = q; }
    LDS_WAIT();
}
__device__ __forceinline__ void conv_pair(const Args& a, LAS float* scrA, LAS float* scrB, int itA, int itB, int lane) {
    unsigned char* ws = a.ws;
    if (itB < CV_OUT) { p0_transpose_pair(a.in[12], DM, DM, (bf16*)(ws + WS_WOUT), scrA, scrB, itA, itB, 64, lane); return; }
    if (itA >= CV_OUT && itB < CV_OUT + CV_UP) { p0_transpose_pair(a.in[14], DM, DFF, (bf16*)(ws + WS_WUP), scrA, scrB, itA - CV_OUT, itB - CV_OUT, 256, lane); return; }
    if (itA >= CV_OUT + CV_UP) { p0_transpose_pair(a.in[15], DFF, DM, (bf16*)(ws + WS_WDN), scrA, scrB, itA - CV_OUT - CV_UP, itB - CV_OUT - CV_UP, 64, lane); return; }
    conv_item(a, scrA, itA, lane); conv_item(a, scrA, itB, lane);
}
__device__ __forceinline__ void rms_row_to_bf16(const float* xrow, const float* gain, bf16* orow, int lane) {
    const f32x4* xr = (const f32x4*)xrow + lane; const f32x4* gr = (const f32x4*)gain + lane;
    f32x4 v[8]; float s = 0.f;
#pragma unroll
    for (int j = 0; j < 8; ++j) { v[j] = xr[64 * j]; s += (v[j].x * v[j].x + v[j].y * v[j].y) + (v[j].z * v[j].z + v[j].w * v[j].w); }
    const float rstd = 1.f / sqrtf(wave_sum(s) * (1.f / DM) + EPS);
    unsigned long long* o8 = (unsigned long long*)orow + lane;
#pragma unroll
    for (int j = 0; j < 8; ++j) { const f32x4 g = gr[64 * j]; o8[64 * j] = (unsigned long long)pk2(v[j].x * rstd * g.x, v[j].y * rstd * g.y) | ((unsigned long long)pk2(v[j].z * rstd * g.z, v[j].w * rstd * g.w) << 32); }
}
__device__ __forceinline__ void rope_cs(int pos, int j, float& c, float& s) {
    const double x = (double)pos * INV_FREQ[j];
    const double n = __builtin_rint(x * 0.15915494309189535);
    const double r = __builtin_fma(-n, 6.283185307179586, x);
    const float rf = (float)r; c = cosf(rf); s = sinf(rf);
}
__device__ __forceinline__ void p0_prep(const Args& a, LAS unsigned char* lds, int gw, int NGW, int wave, int lane) {
    LAS float* scr = (LAS float*)(lds + wave * 16384);
    unsigned char* ws = a.ws;
    constexpr int I_IN = 32 * 120, I_PL = 4 * 32;
    for (int it = gw; it < I_IN + I_PL + (CONV_IN_ATTN ? 0 : CV_N); it += NGW) {
        if (it < I_IN) p0_transpose_item<true>(a.in[9], DM, NZR, (bf16*)(ws + WS_WIN), scr, it, 120, lane);
        else if (it < I_IN + I_PL) { const int r = it - I_IN, g = r >> 5; p0_transpose_item(a.in[10] + (size_t)g * 65536, 256, 256, (bf16*)(ws + WS_WPOOL) + (size_t)g * 65536, scr, r & 31, 8, lane); }
        else conv_item(a, scr, it - I_IN - I_PL, lane);
    }
    bf16* XN = (bf16*)(ws + WS_XN);
    for (int m = gw; m < MP; m += NGW) {
        const float* xr = in_row(a, m);
        if (xr) rms_row_to_bf16(xr, a.in[8], XN + (size_t)m * DM, lane);
        else { v4u z = {0u, 0u, 0u, 0u}; v4u* o = (v4u*)(XN + (size_t)m * DM) + lane;
#pragma unroll
            for (int j = 0; j < 4; ++j) o[64 * j] = z; }
    }
    float* CS = (float*)(ws + WS_CS);
    for (int pos = gw; pos < TP; pos += NGW) { float c1, s1; rope_cs(pos, lane, c1, s1); CS[(size_t)pos * 192 + lane] = c1; CS[(size_t)pos * 192 + 64 + lane] = s1;
        if (lane < 32) { float c2, s2; rope_cs(pos, 2 * lane, c2, s2); CS[(size_t)pos * 192 + 128 + lane] = c2; CS[(size_t)pos * 192 + 160 + lane] = s2; } }
    for (int i = gw * 64 + lane; i < DB * 14 * 256; i += NGW * 64) { const int b = i / (14 * 256), rem = i % (14 * 256);
        *((f32x4*)(a.out + O_PS + (size_t)b * 15 * 1024) + rem) = *((const f32x4*)(a.in[5] + ((size_t)b * 15 + 1) * 1024) + rem); }
}

namespace pg8 {
struct EpiIn {
    static constexpr bool PERM = true, AFTER_DRAIN = false;
    float* out; unsigned char* ws;
    __device__ __forceinline__ void operator()(const f32x4 (&acc)[2][2][4][2], const Unit& u, int wr, int wc, int fr, int fq) const {
        constexpr float QSCALE = 0.12751743074602957f;
        typedef _Float16 f16x8v __attribute__((ext_vector_type(8)));
        const float* CS = (const float*)(ws + WS_CS);
        const int pn = u.pn;
        const int c0 = 32 * wc + 8 * fq;
#pragma unroll
        for (int ai = 0; ai < 2; ++ai)
#pragma unroll
            for (int m = 0; m < 4; ++m) {
                const int r = u.pm * BM + ai * HALF + wr * 64 + m * 16 + fr;
                if (r >= MR) continue;
                const bool smp = r >= TP; const int b = r - TP; const float* cs = CS + (size_t)(smp ? PAST : r) * 192;
                if (pn < 5) {
                    const int hd = c0 >> 6, j0 = c0 & 63;
                    f32x4 o1[2], o2[2];
#pragma unroll
                    for (int n = 0; n < 2; ++n) { const f32x4 co = *(const f32x4*)(cs + j0 + 4 * n), si = *(const f32x4*)(cs + 64 + j0 + 4 * n), x1 = acc[ai][0][m][n], x2 = acc[ai][1][m][n];
                        o1[n] = x1 * co - x2 * si; o2[n] = x1 * si + x2 * co; }
                    if (pn < 4) { ::bf16* q = (::bf16*)(ws + WS_QB) + (size_t)r * 1024 + (2 * pn + hd) * 128 + j0;
                        v4u a_, b_; a_.x = pk2(o1[0].x * QSCALE, o1[0].y * QSCALE); a_.y = pk2(o1[0].z * QSCALE, o1[0].w * QSCALE); a_.z = pk2(o1[1].x * QSCALE, o1[1].y * QSCALE); a_.w = pk2(o1[1].z * QSCALE, o1[1].w * QSCALE);
                        b_.x = pk2(o2[0].x * QSCALE, o2[0].y * QSCALE); b_.y = pk2(o2[0].z * QSCALE, o2[0].w * QSCALE); b_.z = pk2(o2[1].x * QSCALE, o2[1].y * QSCALE); b_.w = pk2(o2[1].z * QSCALE, o2[1].w * QSCALE);
                        *(v4u*)q = a_; *(v4u*)(q + 64) = b_; }
                    else { float* ko = (smp ? out + O_KS + (size_t)b * 256 : out + O_KP + (size_t)r * 256) + hd * 128 + j0;
                        *(f32x4*)ko = o1[0]; *(f32x4*)(ko + 4) = o1[1]; *(f32x4*)(ko + 64) = o2[0]; *(f32x4*)(ko + 68) = o2[1];
                        ::bf16* kb = (::bf16*)(ws + WS_KB) + (size_t)r * 256 + hd * 128 + j0;
                        v4u a_, b_; a_.x = pk2(o1[0].x, o1[0].y); a_.y = pk2(o1[0].z, o1[0].w); a_.z = pk2(o1[1].x, o1[1].y); a_.w = pk2(o1[1].z, o1[1].w);
                        b_.x = pk2(o2[0].x, o2[0].y); b_.y = pk2(o2[0].z, o2[0].w); b_.z = pk2(o2[1].x, o2[1].y); b_.w = pk2(o2[1].z, o2[1].w);
                        *(v4u*)kb = a_; *(v4u*)(kb + 64) = b_; }
                } else if (pn == 5) {
#pragma unroll
                    for (int bj = 0; bj < 2; ++bj) { const int c = 128 * bj + c0; const f32x4 v0 = acc[ai][bj][m][0], v1 = acc[ai][bj][m][1];
                        float* vo = (smp ? out + O_VS + (size_t)b * 256 : out + O_VP + (size_t)r * 256) + c; *(f32x4*)vo = v0; *(f32x4*)(vo + 4) = v1;
                        v4u a_; a_.x = pk2(v0.x, v0.y); a_.y = pk2(v0.z, v0.w); a_.z = pk2(v1.x, v1.y); a_.w = pk2(v1.z, v1.w);
                        *(v4u*)((::bf16*)(ws + WS_VB) + (size_t)r * 256 + c) = a_; }
                } else if (pn < 10) {
                    const int hd = 4 * (pn - 6) + (c0 >> 5), j0 = c0 & 31;
                    f32x4 o1[2], o2[2];
#pragma unroll
                    for (int n = 0; n < 2; ++n) { const f32x4 co = *(const f32x4*)(cs + 128 + j0 + 4 * n), si = *(const f32x4*)(cs + 160 + j0 + 4 * n), x1 = acc[ai][0][m][n], x2 = acc[ai][1][m][n];
                        o1[n] = x1 * co - x2 * si; o2[n] = x1 * si + x2 * co; }
                    f16* qi = (f16*)(ws + WS_QI) + (size_t)r * 1024 + hd * 64 + j0;
                    *(f16x8v*)qi = (f16x8v){(f16)o1[0].x, (f16)o1[0].y, (f16)o1[0].z, (f16)o1[0].w, (f16)o1[1].x, (f16)o1[1].y, (f16)o1[1].z, (f16)o1[1].w};
                    *(f16x8v*)(qi + 32) = (f16x8v){(f16)o2[0].x, (f16)o2[0].y, (f16)o2[0].z, (f16)o2[0].w, (f16)o2[1].x, (f16)o2[1].y, (f16)o2[1].z, (f16)o2[1].w};
                    if (smp) { float* q32 = (float*)(ws + WS_QI32) + (size_t)b * 1024 + hd * 64 + j0; *(f32x4*)q32 = o1[0]; *(f32x4*)(q32 + 4) = o1[1]; *(f32x4*)(q32 + 32) = o2[0]; *(f32x4*)(q32 + 36) = o2[1]; }
                } else if (pn == 10) {
                    if (wc == 0) { const int j0 = c0;
                        f32x4 o1[2], o2[2];
#pragma unroll
                        for (int n = 0; n < 2; ++n) { const f32x4 co = *(const f32x4*)(cs + 128 + j0 + 4 * n), si = *(const f32x4*)(cs + 160 + j0 + 4 * n), x1 = acc[ai][0][m][n], x2 = acc[ai][1][m][n];
                            o1[n] = x1 * co - x2 * si; o2[n] = x1 * si + x2 * co; }
                        float* kio = (smp ? out + O_KIS + (size_t)b * 64 : out + O_KIP + (size_t)r * 64) + j0; *(f32x4*)kio = o1[0]; *(f32x4*)(kio + 4) = o1[1]; *(f32x4*)(kio + 32) = o2[0]; *(f32x4*)(kio + 36) = o2[1];
                        f16* ki = (f16*)(ws + WS_KI) + (size_t)r * 64 + j0;
                        *(f16x8v*)ki = (f16x8v){(f16)o1[0].x, (f16)o1[0].y, (f16)o1[0].z, (f16)o1[0].w, (f16)o1[1].x, (f16)o1[1].y, (f16)o1[1].z, (f16)o1[1].w};
                        *(f16x8v*)(ki + 32) = (f16x8v){(f16)o2[0].x, (f16)o2[0].y, (f16)o2[0].z, (f16)o2[0].w, (f16)o2[1].x, (f16)o2[1].y, (f16)o2[1].z, (f16)o2[1].w};
                    } else if (wc == 1 && fq < 2) { float* wo = (float*)(ws + WS_WI) + (size_t)r * 16 + 8 * fq; *(f32x4*)wo = acc[ai][0][m][0] * 0.25f; *(f32x4*)(wo + 4) = acc[ai][0][m][1] * 0.25f; }
                } else {
#pragma unroll
                    for (int bj = 0; bj < 2; ++bj) { const int c = (pn - 11) * 256 + 128 * bj + c0; const f32x4 v0 = acc[ai][bj][m][0], v1 = acc[ai][bj][m][1];
                        float* uo = (float*)(ws + WS_U) + (size_t)r * 1024 + c; *(f32x4*)uo = v0; *(f32x4*)(uo + 4) = v1;
                        if (!smp && r >= TP - 15) { float* po = out + O_PP + (size_t)(r - (TP - 15)) * 1024 + c; *(f32x4*)po = v0; *(f32x4*)(po + 4) = v1; }
                        if (smp) { float* po = out + O_PS + ((size_t)b * 15 + 14) * 1024 + c; *(f32x4*)po = v0; *(f32x4*)(po + 4) = v1; } }
                }
            }
    }
};
}

template <int PMODE = 0> __device__ __forceinline__ void p3_indexer_prompt(const Args& a, LAS unsigned char* lds, int bid, int G, int tid, int wave, int lane, bool dostore = true) {
    unsigned char* ws = a.ws;
    const f16* QI = (const f16*)(ws + WS_QI); const f16* KI = (const f16*)(ws + WS_KI); const float* WI = (const float*)(ws + WS_WI); float* SC = (float*)(ws + WS_SC);
    const int r = lane & 31, hh = lane >> 5;
    constexpr int WOFF = 18 * 4096;
    constexpr int CB = 20, T = 129 * 129 + 257 * CB;
    const int lo = (int)((long)bid * T / G), hi = (int)((long)(bid + 1) * T / G);
    int q = 0, P = 0;
    while (P + CB + (q >> 1) + 1 <= lo) { P += CB + (q >> 1) + 1; ++q; }
    for (; q <= 256 && P < hi; P += CB + (q >> 1) + 1, ++q) {
        const int t0 = q * 32; const int nkb = (q >> 1) + 1;
        const int kb_lo = lo - (P + CB) > 0 ? lo - (P + CB) : 0; const int kb_end = hi - (P + CB) < nkb ? hi - (P + CB) : nkb;
        if (kb_lo >= kb_end) continue;
        {
            __syncthreads();
            int tidv = tid; asm volatile("" : "+v"(tidv));
#pragma unroll
            for (int i = 0; i < 8; ++i) { const int rr = tidv & 31, c = 2 * (8 * i + (tidv >> 6)) + ((tidv >> 5) & 1);
                const v4u v = *(const v4u*)(QI + (size_t)(t0 + rr) * 1024 + c * 8);
                *(LAS v4u*)(lds + (c * 32 + rr) * 16) = v; }
            { const float wx = WI[(size_t)(t0 + (tidv & 31)) * 16 + (tidv >> 5)]; *(LAS float*)(lds + WOFF + ((tidv >> 5) * 32 + (tidv & 31)) * 4) = wx * 0.0625f; }
            __syncthreads();
            {
                const int rr = tidv & 31, dg = tidv >> 5; const int ks = dg >> 2, h2 = (dg >> 1) & 1, e0 = (dg & 1) * 4;
                float qa[4] = {0.f, 0.f, 0.f, 0.f};
#pragma unroll 4
                for (int h = 0; h < 16; ++h) { const float wh = *(const LAS float*)(lds + WOFF + (h * 32 + rr) * 4);
                    typedef _Float16 f16x4 __attribute__((ext_vector_type(4)));
                    const f16x4 qv = *(const LAS f16x4*)(lds + ((((h * 4 + ks) * 2 + h2) * 32) + rr) * 16 + e0 * 2);
                    qa[0] = fmaf(wh, (float)qv[0], qa[0]); qa[1] = fmaf(wh, (float)qv[1], qa[1]); qa[2] = fmaf(wh, (float)qv[2], qa[2]); qa[3] = fmaf(wh, (float)qv[3], qa[3]); }
                typedef _Float16 f16x4 __attribute__((ext_vector_type(4)));
                f16x4 hi, lo;
#pragma unroll
                for (int e = 0; e < 4; ++e) { hi[e] = (f16)qa[e]; lo[e] = (f16)(qa[e] - (float)hi[e]); }
                *(LAS f16x4*)(lds + ((((16 * 4 + ks) * 2 + h2) * 32) + rr) * 16 + e0 * 2) = hi;
                *(LAS f16x4*)(lds + ((((17 * 4 + ks) * 2 + h2) * 32) + rr) * 16 + e0 * 2) = lo;
            }
            __syncthreads();
            f16x8 afn[2][4];
            if (kb_lo + wave < kb_end) {
#pragma unroll
                for (int blk = 0; blk < 2; ++blk)
#pragma unroll
                    for (int ks = 0; ks < 4; ++ks) afn[blk][ks] = *(const f16x8*)(KI + (size_t)((kb_lo + wave) * 64 + blk * 32 + r) * 64 + ks * 16 + hh * 8); }
            for (int kb = kb_lo + wave; kb < kb_end; kb += 8) {
                const int s0 = kb * 64;
                f16x8 af[2][4];
#pragma unroll
                for (int blk = 0; blk < 2; ++blk)
#pragma unroll
                    for (int ks = 0; ks < 4; ++ks) af[blk][ks] = afn[blk][ks];
                if (kb + 8 < kb_end) {
#pragma unroll
                    for (int blk = 0; blk < 2; ++blk)
#pragma unroll
                        for (int ks = 0; ks < 4; ++ks) afn[blk][ks] = *(const f16x8*)(KI + (size_t)(s0 + 512 + blk * 32 + r) * 64 + ks * 16 + hh * 8); }
                float sa0[16], sa1[16];
#pragma unroll
                for (int i = 0; i < 16; ++i) { sa0[i] = 0.f; sa1[i] = 0.f; }
#define IDX_FRAG(h, ks) (*(const LAS f16x8*)(lds + (((((h) * 4 + (ks)) * 2 + hh) * 32) + r) * 16))
#define IDX_W(h) (*(const LAS float*)(lds + WOFF + ((h) * 32 + r) * 4))
#define IDX_STEP(m, D0, D1, Bc, P0, P1, Bn, DOVALU, DOLOAD, WCUR, WNXT) do { const float wP_ = WCUR; \
        WNXT = IDX_W(m);                                      \
        __builtin_amdgcn_sched_barrier(0); \
        if (DOLOAD && PMODE != 2) { _Pragma("unroll") for (int ks = 0; ks < 4; ++ks) Bn[ks] = IDX_FRAG((m) + 1, ks); } \
        _Pragma("unroll") for (int ks = 0; ks < 4; ++ks) { \
            if (PMODE != 4) { \
            if (ks == 0) { D0 = __builtin_amdgcn_mfma_f32_32x32x16_f16(af[0][0], Bc[0], (f32x16){}, 0, 0, 0); D1 = __builtin_amdgcn_mfma_f32_32x32x16_f16(af[1][0], Bc[0], (f32x16){}, 0, 0, 0); } \
            else { D0 = __builtin_amdgcn_mfma_f32_32x32x16_f16(af[0][ks], Bc[ks], D0, 0, 0, 0); D1 = __builtin_amdgcn_mfma_f32_32x32x16_f16(af[1][ks], Bc[ks], D1, 0, 0, 0); } } \
            else if (ks == 0) { _Pragma("unroll") for (int i_ = 0; i_ < 16; ++i_) { D0[i_] = (float)Bc[0][0] * (float)i_; D1[i_] = D0[i_]; } } \
            __builtin_amdgcn_sched_barrier(0); \
            if (DOVALU && PMODE != 1) { if (ks == 0) asm volatile("s_nop 7" : "+v"(P0), "+v"(P1)); \
                _Pragma("unroll") for (int i = 4 * ks; i < 4 * ks + 4; ++i) { if (PMODE == 3) { asm volatile("v_fma_f32 %0, %1, |%1|, %0" : "+v"(sa0[i]) : "v"(wP_)); asm volatile("v_fma_f32 %0, %1, |%1|, %0" : "+v"(sa1[i]) : "v"(wP_)); } else { \
                    asm volatile("v_fma_f32 %0, %1, |%2|, %0" : "+v"(sa0[(i + 1) & 15]) : "v"(wP_), "v"(P0[i])); asm volatile("v_fma_f32 %0, %1, |%2|, %0" : "+v"(sa1[(i + 1) & 15]) : "v"(wP_), "v"(P1[i])); } } } \
            __builtin_amdgcn_sched_barrier(0); } } while (0)
                {
                    f16x8 bA[4], bB[4]; f32x16 dA0, dA1, dB0, dB1;
#pragma unroll
                    for (int ks = 0; ks < 4; ++ks) { bA[ks] = IDX_FRAG(0, ks); if (PMODE == 2) bB[ks] = IDX_FRAG(1, ks); }
                    float wA = 0.f, wB = 0.f;
                    IDX_STEP(0, dA0, dA1, bA, dB0, dB1, bB, false, true, wB, wA);
#pragma unroll 1
                    for (int m = 1; m < 15; m += 2) {
                        IDX_STEP(m, dB0, dB1, bB, dA0, dA1, bA, true, true, wA, wB);
                        IDX_STEP(m + 1, dA0, dA1, bA, dB0, dB1, bB, true, true, wB, wA);
                    }
                    IDX_STEP(15, dB0, dB1, bB, dA0, dA1, bA, true, false, wA, wB);
                    { const float wP_ = wB; asm volatile("s_nop 15" : "+v"(dB0), "+v"(dB1));
#pragma unroll
                      for (int i = 0; i < 16; ++i) { asm volatile("v_fma_f32 %0, %1, |%2|, %0" : "+v"(sa0[(i + 1) & 15]) : "v"(wP_), "v"(dB0[i])); asm volatile("v_fma_f32 %0, %1, |%2|, %0" : "+v"(sa1[(i + 1) & 15]) : "v"(wP_), "v"(dB1[i])); } }
                }
#undef IDX_STEP
                f32x16 sc0, sc1;
#pragma unroll
                for (int i = 0; i < 16; ++i) { sc0[i] = sa0[(i + 1) & 15]; sc1[i] = sa1[(i + 1) & 15]; }
#pragma unroll
                for (int h = 16; h < 18; ++h)
#pragma unroll
                    for (int ks = 0; ks < 4; ++ks) { const f16x8 bfr = IDX_FRAG(h, ks);
                        sc0 = __builtin_amdgcn_mfma_f32_32x32x16_f16(af[0][ks], bfr, sc0, 0, 0, 0); sc1 = __builtin_amdgcn_mfma_f32_32x32x16_f16(af[1][ks], bfr, sc1, 0, 0, 0); }
#undef IDX_FRAG
#undef IDX_W
                float* row = SC + (size_t)(t0 + r) * SCLD + s0 + 4 * hh;
                if (!dostore) { if (sc0[0] + sc1[3] != 12345.678f) continue; }
                if (s0 + 63 > t0) {
                    const int tq = t0 + r;
#pragma unroll
                    for (int i = 0; i < 16; ++i) { const int sk = s0 + (i & 3) + 8 * (i >> 2) + 4 * hh; if (sk > tq) sc0[i] = -INFINITY; if (sk + 32 > tq) sc1[i] = -INFINITY; } }
#pragma unroll
                for (int q4 = 0; q4 < 4; ++q4) {
                    *(f32x4*)(row + 8 * q4) = (f32x4){sc0[4 * q4], sc0[4 * q4 + 1], sc0[4 * q4 + 2], sc0[4 * q4 + 3]};
                    *(f32x4*)(row + 32 + 8 * q4) = (f32x4){sc1[4 * q4], sc1[4 * q4 + 1], sc1[4 * q4 + 2], sc1[4 * q4 + 3]}; }
                if (kb == nkb - 1) {
                    const int pend = ((t0 + 32 + 255) >> 8) << 8; float* prow = SC + (size_t)(t0 + r) * SCLD;
                    for (int sp = 64 * nkb + 4 * hh; sp < pend; sp += 8) *(f32x4*)(prow + sp) = (f32x4){-INFINITY, -INFINITY, -INFINITY, -INFINITY}; }
            }
        }
    }
}
__device__ __forceinline__ void p3_indexer_sample(const Args& a, LAS unsigned char* lds, int gw, int NGW, int wave, int lane) {
    unsigned char* ws = a.ws;
    const float* QI32 = (const float*)(ws + WS_QI32); const float* WI = (const float*)(ws + WS_WI); float* SCS = (float*)(ws + WS_SCS);
    const float* ckidx = a.in[4]; const int* pt = (const int*)a.in[6];
    LAS float* lq = (LAS float*)(lds + wave * 4096);
    for (int it = gw; it < DB * 17; it += NGW) {
        const int b = it / 17, p = it % 17;
        const float* w = WI + (size_t)(TP + b) * 16;
        const bool newk = p == 16;
        const float* kr0 = newk ? a.out + O_KIS + (size_t)b * IDD : ckidx + ((size_t)pt[b * NPAGES + p] * PAGE + lane) * IDD;
        const float* kr1 = newk ? kr0 : kr0 + 64 * IDD;
        f32x4 k0[16], k1[16];
#pragma unroll
        for (int j = 0; j < 16; ++j) { k0[j] = *((const f32x4*)kr0 + j); k1[j] = *((const f32x4*)kr1 + j); }
#pragma unroll
        for (int j = 0; j < 4; ++j) *((LAS f32x4*)lq + lane + 64 * j) = *((const f32x4*)(QI32 + (size_t)b * 1024) + lane + 64 * j);
        LDS_WAIT();
        float s0 = 0.f, s1 = 0.f;
#pragma unroll 1
        for (int h = 0; h < 16; ++h) { float d0 = 0.f, d1 = 0.f;
#pragma unroll
            for (int j = 0; j < 16; ++j) { const f32x4 q4 = *((const LAS f32x4*)(lq + h * 64) + j);
                d0 = fmaf(q4.x, k0[j].x, d0); d0 = fmaf(q4.y, k0[j].y, d0); d0 = fmaf(q4.z, k0[j].z, d0); d0 = fmaf(q4.w, k0[j].w, d0);
                d1 = fmaf(q4.x, k1[j].x, d1); d1 = fmaf(q4.y, k1[j].y, d1); d1 = fmaf(q4.z, k1[j].z, d1); d1 = fmaf(q4.w, k1[j].w, d1); }
            const float wh = w[h]; s0 += wh * fmaxf(d0, 0.f); s1 += wh * fmaxf(d1, 0.f); }
        if (!newk) { SCS[(size_t)b * SCSLD + p * PAGE + lane] = s0 * 0.125f; SCS[(size_t)b * SCSLD + p * PAGE + 64 + lane] = s1 * 0.125f; }
        else { if (lane == 0) SCS[(size_t)b * SCSLD + PAST] = s0 * 0.125f; for (int sp = LS + lane; sp < SCSLD; sp += 64) SCS[(size_t)b * SCSLD + sp] = -INFINITY; }
        LDS_WAIT();
    }
}

__device__ __forceinline__ unsigned tokey(float x) { const unsigned u = __builtin_bit_cast(unsigned, x); return u ^ (((unsigned)((int)u >> 31)) | 0x80000000u); }
__device__ __forceinline__ void hist_find(LAS unsigned* hist, int need, int lane, unsigned& digit, unsigned& above, unsigned& inbin) {
    unsigned tot = 0u;
#pragma unroll 8
    for (int j = 0; j < 32; ++j) tot += hist[32 * lane + j];
    unsigned s = tot;
#pragma unroll
    for (int o = 1; o < 64; o <<= 1) { const unsigned t = __shfl_down(s, o); if (lane + o < 64) s += t; }
    const unsigned s_excl = s - tot;
    const bool found = (s_excl < (unsigned)need) && ((unsigned)need <= s);
    const unsigned long long bal = __ballot(found);
    const int L = bal ? (int)__builtin_ctzll(bal) : 0;
    const unsigned sxL = __shfl(s_excl, L);
    const unsigned hb = lane < 32 ? hist[32 * L + lane] : 0u;
    unsigned s2 = hb;
#pragma unroll
    for (int o = 1; o < 32; o <<= 1) { const unsigned t = __shfl_down(s2, o); if (lane + o < 32) s2 += t; }
    const unsigned tot2 = sxL + s2, ex2 = tot2 - hb;
    const bool f2 = lane < 32 && ex2 < (unsigned)need && (unsigned)need <= tot2;
    const unsigned long long b2 = __ballot(f2);
    const int L2 = b2 ? (int)__builtin_ctzll(b2) : 0;
    digit = 32u * L + L2; above = __shfl(ex2, L2); inbin = __shfl(hb, L2);
}
constexpr int KB0 = 22785;
__device__ __forceinline__ int coarse_bin(unsigned k) { const int v = (int)(k >> 17) - KB0; return v < 0 ? 0 : (v > 2047 ? 2047 : v); }
#define TOPK_LOAD(v, base) do { _Pragma("unroll") for (int j = 0; j < 8; ++j) { v[j] = (f32x4){0.f, 0.f, 0.f, 0.f}; if ((base) + 256 * j < n) v[j] = *(const f32x4*)(row + (base) + 256 * j + 4 * lane); } } while (0)
__device__ __forceinline__ void topk_row(const float* row, int n, int* sel, LAS unsigned* hist, int lane) {
    if (n <= TOPK) { for (int i = lane; i < TOPK; i += 64) sel[i] = i < n ? i : 0; return; }
    int need = TOPK; unsigned digit, above, inbin;
    for (int i = lane; i < 2048; i += 64) hist[i] = 0u;
    LDS_WAIT();
    unsigned cnt0 = 0u;
    f32x4 vn[8]; TOPK_LOAD(vn, 0);
#pragma unroll 1
    for (int base = 0; base < n; base += 2048) { f32x4 v[8];
#pragma unroll
        for (int j = 0; j < 8; ++j) v[j] = vn[j];
        if (base + 2048 < n) TOPK_LOAD(vn, base + 2048);
#pragma unroll
        for (int j = 0; j < 8; ++j) if (base + 256 * j < n) {
#pragma unroll
            for (int e = 0; e < 4; ++e) { const int cb = coarse_bin(tokey(v[j][e]));
                if (cb != 0) __hip_atomic_fetch_add(hist + cb, 1u, __ATOMIC_RELAXED, __HIP_MEMORY_SCOPE_WORKGROUP); else ++cnt0; } } }
    { unsigned c0 = cnt0;
#pragma unroll
      for (int o = 1; o < 64; o <<= 1) c0 += __shfl_xor(c0, o);
      if (lane == 0) hist[0] = c0; }
    TOPK_LOAD(vn, 0);
    LDS_WAIT();
    hist_find(hist, need, lane, digit, above, inbin); need -= (int)above;
    const int b1 = (int)digit;
    const unsigned klo = b1 == 0 ? 0u : ((unsigned)(KB0 + b1)) << 17;
    const unsigned kspan = b1 == 0 ? ((unsigned)(KB0 + 1)) << 17 : (b1 == 2047 ? 0u - klo : 1u << 17);
    const bool fast = inbin <= 64u; const int m = (int)inbin;
    LDS_WAIT();
    unsigned thr = 0u; int need_eq = 0; bool ties = false;
    if (!fast) {
        unsigned prefix = 0u; int toteq = 0;
#pragma unroll 1
        for (int pass = 0; pass < 3; ++pass) {
            const int shift = pass == 0 ? 21 : pass == 1 ? 10 : 0; const unsigned mask = pass == 2 ? 1023u : 2047u; const int pshift = pass == 1 ? 21 : 10;
            for (int i = lane; i < 2048; i += 64) hist[i] = 0u;
            LDS_WAIT();
#pragma unroll 1
            for (int base = 0; base < n; base += 2048) { f32x4 v[8];
#pragma unroll
                for (int j = 0; j < 8; ++j) v[j] = vn[j];
                TOPK_LOAD(vn, (base + 2048 < n) ? base + 2048 : 0);
#pragma unroll
                for (int j = 0; j < 8; ++j) if (base + 256 * j < n)
#pragma unroll
                    for (int e = 0; e < 4; ++e) { const unsigned k = tokey(v[j][e]);
                        if (k >= klo && (k - klo) < kspan && (pass == 0 || (k >> pshift) == prefix)) __hip_atomic_fetch_add(hist + ((k >> shift) & mask), 1u, __ATOMIC_RELAXED, __HIP_MEMORY_SCOPE_WORKGROUP); } }
            LDS_WAIT();
            hist_find(hist, need, lane, digit, above, inbin);
            need -= (int)above; toteq = (int)inbin;
            prefix = pass == 2 ? ((prefix << 10) | digit) : ((prefix << 11) | digit);
            LDS_WAIT();
        }
        thr = prefix; need_eq = need; ties = toteq != need_eq;
    }
    LAS unsigned* lkey = hist; LAS unsigned* lidx = hist + 64; LAS unsigned* lcnt = hist + 128;
    if (lane == 0) *lcnt = 0u;
    LDS_WAIT();
    const unsigned long long lt = (1ull << lane) - 1ull;
    int outbase = fast ? need : 0, eqtaken = 0;
#pragma unroll 1
    for (int base = 0; base < n; base += 2048) { f32x4 v[8];
#pragma unroll
        for (int j = 0; j < 8; ++j) v[j] = vn[j];
        if (base + 2048 < n) TOPK_LOAD(vn, base + 2048);
        unsigned mask = 0u;
#pragma unroll
        for (int j = 0; j < 8; ++j) if (base + 256 * j < n) {
            unsigned kk[4]; bool eq[4];
#pragma unroll
            for (int e = 0; e < 4; ++e) { const int idx = base + 256 * j + 4 * lane + e; const bool valid = true; kk[e] = tokey(v[j][e]); eq[e] = false; bool take;
                if (fast) { const bool inr = valid && kk[e] >= klo; const unsigned dk = kk[e] - klo; take = inr && dk >= kspan;
                    if (inr && dk < kspan) { const unsigned p_ = __hip_atomic_fetch_add(lcnt, 1u, __ATOMIC_RELAXED, __HIP_MEMORY_SCOPE_WORKGROUP); if (p_ < 64u) { lkey[p_] = kk[e]; lidx[p_] = (unsigned)idx; } } }
                else { take = valid && (kk[e] > thr || (kk[e] == thr && !ties)); eq[e] = valid && ties && kk[e] == thr; }
                mask |= take ? (1u << (4 * j + e)) : 0u; }
            if (!fast && ties) {
                int lower = 0, tot = 0, own = 0;
#pragma unroll
                for (int e = 0; e < 4; ++e) { const unsigned long long be = __ballot(eq[e]); lower += __builtin_popcountll(be & lt); tot += __builtin_popcountll(be); }
#pragma unroll
                for (int e = 0; e < 4; ++e) { if (eq[e]) { if (eqtaken + lower + own < need_eq) mask |= 1u << (4 * j + e); ++own; } }
                eqtaken += tot; }
        }
        const int cnt = __builtin_popcount(mask);
        int pre = cnt;
#pragma unroll
        for (int o = 1; o < 64; o <<= 1) { const int t = __shfl_up(pre, o); if (lane >= o) pre += t; }
        int pos = outbase + pre - cnt; outbase += __shfl(pre, 63);
        while (mask) { const int bpos = __builtin_ctz(mask); mask &= mask - 1u; if (pos < TOPK) sel[pos] = base + 256 * (bpos >> 2) + 4 * lane + (bpos & 3); ++pos; }
    }
    if (fast) {
        LDS_WAIT();
        const unsigned mykey = lane < m ? lkey[lane] : 0u; const int myidx = lane < m ? (int)lidx[lane] : 0x7fffffff;
        int rk = 0;
        for (int j = 0; j < m; ++j) { const unsigned kj = __shfl(mykey, j); const int ij = __shfl(myidx, j); rk += (kj > mykey || (kj == mykey && ij < myidx)) ? 1 : 0; }
        if (lane < m && rk < need) sel[rk] = myidx;
    }
    LDS_WAIT();
}
#undef TOPK_LOAD
__device__ __forceinline__ void p4_topk(const Args& a, LAS unsigned char* lds, int gw, int NGW, int wave, int lane) {
    unsigned char* ws = a.ws;
    const float* SC = (const float*)(ws + WS_SC); const float* SCS = (const float*)(ws + WS_SCS); int* SEL = (int*)(ws + WS_SEL);
    LAS unsigned* hist = (LAS unsigned*)(lds + wave * 16896); LAS float* scr = (LAS float*)(lds + wave * 16896 + 8192);
#ifndef TOPK_REP
#define TOPK_REP 1
#endif
    for (int it0 = gw; it0 < (SEQ + DB) * TOPK_REP; it0 += NGW) { int it = it0 % (SEQ + DB);
        if (it < SEQ && (SEQ % (2 * NGW)) == 0) { const int blk = it / NGW, w = it % NGW; it = (blk & 1) ? blk * NGW + (NGW - 1 - w) : it; }
        if (it < SEQ) { const int t = NMETA + it; topk_row(SC + (size_t)t * SCLD, t + 1, SEL + (size_t)t * TOPK, hist, lane); }
        else { const int b = it - SEQ; topk_row(SCS + (size_t)b * SCSLD, LS, SEL + (size_t)(TP + b) * TOPK, hist, lane); }
    }
}

template <int CTRL> __device__ __forceinline__ float dpp_f(float v) { return __builtin_bit_cast(float, __builtin_amdgcn_update_dpp(0, __builtin_bit_cast(int, v), CTRL, 0xf, 0xf, false)); }
__device__ __forceinline__ float row16_sum(float v) {
    v += dpp_f<0xB1>(v);
    v += dpp_f<0x4E>(v);
    v += dpp_f<0x124>(v);
    v += dpp_f<0x128>(v);
    return v;
}
typedef short s16x4 __attribute__((ext_vector_type(4)));
__device__ __forceinline__ s16x4 vtr(LAS unsigned char* p) { return __builtin_bit_cast(s16x4, __builtin_amdgcn_ds_read_tr16_b64_v4i16((LAS s16x4*)p)); }
constexpr int VROW = 288;
constexpr int ATT_WAVE_LDS = 1024 + 4096 + 32 * VROW;
struct AttnPre { int sel[4]; bf16x8_t qf[4]; };
__device__ __forceinline__ void attn_prefetch(const Args& a, AttnPre& P, int t, int kvh, int lane) {
    unsigned char* ws = a.ws; const int* SEL = (const int*)(ws + WS_SEL); const bf16* QB = (const bf16*)(ws + WS_QB);
    const bool smp = t >= TP; const int b = t - TP; const int cnt = smp ? TOPK : (t + 1 < TOPK ? t + 1 : TOPK);
    const int l16 = lane & 15, c = lane >> 4;
#pragma unroll
    for (int j = 0; j < 4; ++j) { const int kidx = 64 * j + lane; int sv = SEL[(size_t)t * TOPK + kidx];
        if (smp) sv = sv < PAST ? ((const int*)a.in[6])[b * NPAGES + (sv >> 7)] * PAGE + (sv & 127) : -1;
        P.sel[j] = kidx < cnt ? sv : 0; }
#pragma unroll
    for (int ks = 0; ks < 4; ++ks) { P.qf[ks] = (bf16x8_t){0, 0, 0, 0, 0, 0, 0, 0}; if (l16 < 4) P.qf[ks] = *(const bf16x8_t*)(QB + (size_t)t * 1024 + (kvh * 4 + l16) * 128 + 32 * ks + 8 * c); }
}
template <bool SMP, int APROBE = 0> __device__ __forceinline__ void attn_unit_mfma(const Args& a, LAS unsigned char* wl, int t, int kvh, int lane, const AttnPre& P) {
    unsigned char* ws = a.ws;
    const bf16* KB = (const bf16*)(ws + WS_KB); const bf16* VB = (const bf16*)(ws + WS_VB); bf16* CAT = (bf16*)(ws + (APROBE ? WS_Z : WS_CAT));
    LAS int* lsel = (LAS int*)wl; LAS float* lsc = (LAS float*)(wl + 1024); LAS unsigned char* vst = wl + 5120;
    const int cnt = SMP ? TOPK : (t + 1 < TOPK ? t + 1 : TOPK);
    const int l16 = lane & 15, c = lane >> 4;
    const int b = t - TP;
#pragma unroll
    for (int j = 0; j < 4; ++j) lsel[64 * j + lane] = P.sel[j];
    const float* ck = a.in[2] + kvh * 128; const float* cv = a.in[3] + kvh * 128;
    const float* nk = a.out + O_KS + (size_t)b * 256 + kvh * 128; const float* nv = a.out + O_VS + (size_t)b * 256 + kvh * 128;
    const char* ckb = (const char*)ck; const char* cvb = (const char*)cv;
    const long long dnk = (long long)((uintptr_t)nk - (uintptr_t)ck), dnv = (long long)((uintptr_t)nv - (uintptr_t)cv);
    bf16x8_t qf[4];
#pragma unroll
    for (int ks = 0; ks < 4; ++ks) qf[ks] = P.qf[ks];
    LDS_WAIT();
    const bf16* kbase = KB + kvh * 128 + 8 * c;
#define ATT_LOADK(kf, gp) do { _Pragma("unroll") for (int bb = 0; bb < 4; ++bb) { const int s_ = lsel[16 * (4 * (gp) + bb) + l16]; \
        if (!SMP) { const bf16* kr_ = kbase + (size_t)s_ * 256; _Pragma("unroll") for (int ks = 0; ks < 4; ++ks) kf[bb][ks] = *(const bf16x8_t*)(kr_ + 32 * ks); } \
        else { const float* kr_ = (const float*)(ckb + (s_ >= 0 ? (long long)s_ * 1024 : dnk)) + 8 * c; \
            _Pragma("unroll") for (int ks = 0; ks < 4; ++ks) { const f32x4 x_ = *(const f32x4*)(kr_ + 32 * ks), y_ = *(const f32x4*)(kr_ + 32 * ks + 4); \
                v4u pk_; pk_.x = pk2(x_.x, x_.y); pk_.y = pk2(x_.z, x_.w); pk_.z = pk2(y_.x, y_.y); pk_.w = pk2(y_.z, y_.w); kf[bb][ks] = __builtin_bit_cast(bf16x8_t, pk_); } } } } while (0)
#define ATT_QK(kf, gp) do { _Pragma("unroll") for (int bb = 0; bb < 4; ++bb) { f32x4 acc_ = {0.f, 0.f, 0.f, 0.f}; \
        _Pragma("unroll") for (int ks = 0; ks < 4; ++ks) acc_ = __builtin_amdgcn_mfma_f32_16x16x32_bf16(kf[bb][ks], qf[ks], acc_, 0, 0, 0); \
        const int k0_ = 16 * (4 * (gp) + bb) + 4 * c; \
        acc_.x = k0_ < cnt ? acc_.x : -INFINITY; acc_.y = k0_ + 1 < cnt ? acc_.y : -INFINITY; acc_.z = k0_ + 2 < cnt ? acc_.z : -INFINITY; acc_.w = k0_ + 3 < cnt ? acc_.w : -INFINITY; \
        if (l16 < 4) *(LAS f32x4*)(lsc + l16 * 256 + k0_) = acc_; } } while (0)
    const bf16* vbase = VB + kvh * 128 + 8 * l16;
#define ATT_LOADV(vr, st_) do { _Pragma("unroll") for (int i = 0; i < 8; ++i) { const int s_ = lsel[32 * (st_) + c + 4 * i]; \
        if (!SMP) vr[i] = *(const bf16x8_t*)(vbase + (size_t)s_ * 256); \
        else { const float* vp_ = (const float*)(cvb + (s_ >= 0 ? (long long)s_ * 1024 : dnv)) + 8 * l16; const f32x4 x_ = *(const f32x4*)vp_, y_ = *(const f32x4*)(vp_ + 4); \
            v4u pk_; pk_.x = pk2(x_.x, x_.y); pk_.y = pk2(x_.z, x_.w); pk_.z = pk2(y_.x, y_.y); pk_.w = pk2(y_.z, y_.w); vr[i] = __builtin_bit_cast(bf16x8_t, pk_); } } } while (0)
    bf16x8_t vr0[8], vr1[8];
    if constexpr (!SMP && APROBE == 3) { ATT_LOADV(vr0, 0); ATT_LOADV(vr1, 1); }
    else if constexpr (!SMP) {
      const bf16* kbase2 = KB + kvh * 128 + 8 * l16;
#define ATT_LOADKR(kr, st_) do { _Pragma("unroll") for (int i = 0; i < 8; ++i) { const int s_ = lsel[32 * (st_) + c + 4 * i]; kr[i] = *(const bf16x8_t*)(kbase2 + (size_t)s_ * 256); } } while (0)
#define ATT_QKS(kr, st_, DOLOAD) do { \
        _Pragma("unroll") for (int i = 0; i < 8; ++i) *(LAS bf16x8_t*)(vst + (c + 4 * i) * VROW + 16 * l16) = kr[i]; \
        if (DOLOAD) ATT_LOADKR(kr, (st_) + 2); \
        LDS_WAIT(); \
        _Pragma("unroll") for (int kb2 = 0; kb2 < 2; ++kb2) { f32x4 acc_ = {0.f, 0.f, 0.f, 0.f}; \
            _Pragma("unroll") for (int ks = 0; ks < 4; ++ks) { const bf16x8_t af_ = *(const LAS bf16x8_t*)(vst + (16 * kb2 + l16) * VROW + 64 * ks + 16 * c); \
                acc_ = __builtin_amdgcn_mfma_f32_16x16x32_bf16(af_, qf[ks], acc_, 0, 0, 0); } \
            const int k0_ = 32 * (st_) + 16 * kb2 + 4 * c; \
            acc_.x = k0_ < cnt ? acc_.x : -INFINITY; acc_.y = k0_ + 1 < cnt ? acc_.y : -INFINITY; acc_.z = k0_ + 2 < cnt ? acc_.z : -INFINITY; acc_.w = k0_ + 3 < cnt ? acc_.w : -INFINITY; \
            if (l16 < 4) *(LAS f32x4*)(lsc + l16 * 256 + k0_) = acc_; } \
        LDS_WAIT(); } while (0)
      bf16x8_t kr0[8], kr1[8];
      ATT_LOADKR(kr0, 0); ATT_LOADKR(kr1, 1);
#pragma unroll 1
      for (int st = 0; st < 8; st += 2) {
          if (st == 6) { ATT_LOADV(vr0, 0); ATT_LOADV(vr1, 1); }
          ATT_QKS(kr0, st, st + 2 < 8);
          ATT_QKS(kr1, st + 1, st + 3 < 8); }
#undef ATT_LOADKR
#undef ATT_QKS
    }
    else {
#pragma unroll 1
      for (int gp = 0; gp < 4; ++gp) { bf16x8_t kfA[4][4]; ATT_LOADK(kfA, gp); ATT_QK(kfA, gp); }
      ATT_LOADV(vr0, 0); ATT_LOADV(vr1, 1); }
#undef ATT_LOADK
#undef ATT_QK
    LDS_WAIT();
    float lsum[4];
    { const int g = lane >> 4, i16 = lane & 15; LAS f32x4* ps = (LAS f32x4*)(lsc + g * 256 + 16 * i16);
      f32x4 pv[4]; float m = -INFINITY;
#pragma unroll
      for (int j = 0; j < 4; ++j) { pv[j] = ps[j]; m = fmaxf(m, fmaxf(fmaxf(pv[j].x, pv[j].y), fmaxf(pv[j].z, pv[j].w))); }
      m = fmaxf(m, dpp_f<0xB1>(m)); m = fmaxf(m, dpp_f<0x4E>(m)); m = fmaxf(m, dpp_f<0x124>(m)); m = fmaxf(m, dpp_f<0x128>(m));
      float l = 0.f;
#pragma unroll
      for (int j = 0; j < 4; ++j) { pv[j].x = __builtin_amdgcn_exp2f(pv[j].x - m); pv[j].y = __builtin_amdgcn_exp2f(pv[j].y - m); pv[j].z = __builtin_amdgcn_exp2f(pv[j].z - m); pv[j].w = __builtin_amdgcn_exp2f(pv[j].w - m);
          l += (pv[j].x + pv[j].y) + (pv[j].z + pv[j].w); ps[j] = pv[j]; }
      l = row16_sum(l);
#pragma unroll
      for (int gg = 0; gg < 4; ++gg) lsum[gg] = __builtin_bit_cast(float, __builtin_amdgcn_readlane(__builtin_bit_cast(int, l), 16 * gg)); }
    LDS_WAIT();
    f32x4 oacc[8];
#pragma unroll
    for (int db = 0; db < 8; ++db) oacc[db] = (f32x4){0.f, 0.f, 0.f, 0.f};
    LAS unsigned char* trp = vst + (4 * c + (l16 >> 2)) * VROW + 8 * (l16 & 3);
#define ATT_PV(vr, st, vnext, DOLOAD) do { \
        _Pragma("unroll") for (int i = 0; i < 8; ++i) *(LAS bf16x8_t*)(vst + (c + 4 * i) * VROW + 16 * l16) = vr[i]; \
        if (DOLOAD) ATT_LOADV(vnext, (st) + 2); \
        bf16x8_t pf = (bf16x8_t){0, 0, 0, 0, 0, 0, 0, 0}; \
        if (l16 < 4) { const f32x4 p0 = *(const LAS f32x4*)(lsc + l16 * 256 + 32 * (st) + 4 * c), p1 = *(const LAS f32x4*)(lsc + l16 * 256 + 32 * (st) + 16 + 4 * c); \
            v4u pk; pk.x = pk2(p0.x, p0.y); pk.y = pk2(p0.z, p0.w); pk.z = pk2(p1.x, p1.y); pk.w = pk2(p1.z, p1.w); pf = __builtin_bit_cast(bf16x8_t, pk); } \
        LDS_WAIT(); \
        _Pragma("unroll") for (int db = 0; db < 8; ++db) { const s16x4 lo = vtr(trp + 32 * db), hi = vtr(trp + 16 * VROW + 32 * db); \
            const bf16x8_t vf = (bf16x8_t){lo[0], lo[1], lo[2], lo[3], hi[0], hi[1], hi[2], hi[3]}; \
            oacc[db] = __builtin_amdgcn_mfma_f32_16x16x32_bf16(pf, vf, oacc[db], 0, 0, 0); } \
        LDS_WAIT(); } while (0)
#pragma unroll 1
    for (int st = 0; st < (APROBE == 4 ? 2 : 8); st += 2) {
        ATT_PV(vr0, st, vr0, st + 2 < 8);
        ATT_PV(vr1, st + 1, vr1, st + 3 < 8);
    }
#undef ATT_PV
#undef ATT_LOADV
    LAS unsigned short* obuf = (LAS unsigned short*)lsc;
    if (c == 0) {
        const float i0 = 1.f / lsum[0], i1 = 1.f / lsum[1], i2 = 1.f / lsum[2], i3 = 1.f / lsum[3];
#pragma unroll
        for (int db = 0; db < 8; ++db) { obuf[0 * 128 + 16 * db + l16] = (unsigned short)f2bf(oacc[db].x * i0); obuf[1 * 128 + 16 * db + l16] = (unsigned short)f2bf(oacc[db].y * i1);
            obuf[2 * 128 + 16 * db + l16] = (unsigned short)f2bf(oacc[db].z * i2); obuf[3 * 128 + 16 * db + l16] = (unsigned short)f2bf(oacc[db].w * i3); } }
    LDS_WAIT();
    { const v4u o = *(const LAS v4u*)((LAS unsigned char*)obuf + c * 256 + 16 * l16);
      *(v4u*)(CAT + (size_t)t * 2048 + (kvh * 4 + c) * 128 + 8 * l16) = o; }
    LDS_WAIT();
}
template <int APROBE = 0> __device__ __forceinline__ void p5_attn(const Args& a, LAS unsigned char* lds, int bid, int G, int wave, int lane) {
    LAS unsigned char* wl = lds + wave * ATT_WAVE_LDS;
    constexpr int AW = CONV_IN_ATTN ? 7 : 8;
    int kvh, hw, nhw;
    if ((G & 7) == 0) { kvh = (bid >> 2) & 1; hw = ((bid >> 3) * 4 + (bid & 3)) * AW + wave; nhw = (G / 2) * AW; }
    else { kvh = bid & 1; hw = (bid >> 1) * AW + wave; nhw = ((G + 1 - kvh) >> 1) * AW; if (nhw == 0) { nhw = 1; } }
#ifndef DYN_ROUNDS
#define DYN_ROUNDS 1
#endif
    const int NSTAT = ((SEQ + DB) / nhw - DYN_ROUNDS) * nhw;
    unsigned* ticket = (unsigned*)(a.ws + WS_CTL) + 2048 + 64 * kvh;
#define ATT_ROW(i) (((i) >= DB && (i) < 2 * DB) ? TP + ((i) - DB) : NMETA + ((i) < DB ? (i) : (i) - DB))
    if (CONV_IN_ATTN && wave == 7) {
        LAS float* scr = (LAS float*)(lds + 8 * ATT_WAVE_LDS);
        LAS float* scr2 = scr + 64 * 33;
        for (int cit = bid; cit < CV_N; cit += 2 * G) { if (cit + G < CV_N) conv_pair(a, scr, scr2, cit, cit + G, lane); else conv_item(a, scr, cit, lane); }
    } else {
        AttnPre P;
        if (hw < NSTAT) attn_prefetch(a, P, ATT_ROW(hw), kvh, lane);
        for (int it = hw; it < NSTAT; it += nhw) {
            const int t = ATT_ROW(it);
            const AttnPre C = P; const int nx = it + nhw;
            if (nx < NSTAT) attn_prefetch(a, P, ATT_ROW(nx), kvh, lane);
            if (t >= TP) attn_unit_mfma<true, APROBE>(a, wl, t, kvh, lane, C); else attn_unit_mfma<false, APROBE>(a, wl, t, kvh, lane, C); }
    }
    for (;;) {
        unsigned tk = 0u; if (lane == 0) tk = __hip_atomic_fetch_add(ticket, 1u, __ATOMIC_RELAXED, __HIP_MEMORY_SCOPE_AGENT);
        const int it = NSTAT + (int)__builtin_amdgcn_readfirstlane(tk);
        if (it >= SEQ + DB) break;
        const int t = ATT_ROW(it); AttnPre C; attn_prefetch(a, C, t, kvh, lane);
        if (t >= TP) attn_unit_mfma<true, APROBE>(a, wl, t, kvh, lane, C); else attn_unit_mfma<false, APROBE>(a, wl, t, kvh, lane, C); }
#undef ATT_ROW
}
template <int W> __device__ __forceinline__ void dpool_block16(const float* U, bf16* DP, int r0, int c4) {
    f32x4 v[31], P[32];
#pragma unroll
    for (int i = 0; i < 31; ++i) v[i] = (i >= 16 - W) ? *((const f32x4*)(U + (size_t)(r0 - 15 + i) * 1024) + c4) : (f32x4){0.f, 0.f, 0.f, 0.f};
    P[0] = (f32x4){0.f, 0.f, 0.f, 0.f};
#pragma unroll
    for (int i = 0; i < 31; ++i) P[i + 1] = P[i] + v[i];
#pragma unroll
    for (int t = 0; t < 16; ++t) { const f32x4 d = (P[16 + t] - P[16 + t - W]) * (1.0f / W) - v[15 + t];
        *((unsigned long long*)(DP + (size_t)(r0 + t) * 1024) + c4) = (unsigned long long)pk2(d.x, d.y) | ((unsigned long long)pk2(d.z, d.w) << 32); }
}
__device__ __forceinline__ void p5_dpool(const Args& a, int bid, int G, int tid) {
    unsigned char* ws = a.ws;
    const float* U = (const float*)(ws + WS_U); bf16* DP = (bf16*)(ws + WS_DPOOL); const float* SP = a.in[5];
    for (int e = bid * 512 + tid; e < (SEQ / 16) * 256; e += G * 512) { const int rb = e >> 8, c4 = e & 255; const int grp = c4 >> 6; const int r0 = NMETA + 16 * rb;
        if (grp == 0) dpool_block16<2>(U, DP, r0, c4); else if (grp == 1) dpool_block16<4>(U, DP, r0, c4); else if (grp == 2) dpool_block16<8>(U, DP, r0, c4); else dpool_block16<16>(U, DP, r0, c4); }
    for (int e = bid * 512 + tid; e < (MP - TP) * 256; e += G * 512) { const int r = TP + (e >> 8), c4 = e & 255; const int grp = c4 >> 6; const int w = 2 << grp;
        f32x4 d = {0.f, 0.f, 0.f, 0.f};
        if (r < MR) { const int b = r - TP; const f32x4 cur = *((const f32x4*)(U + (size_t)r * 1024) + c4); f32x4 sum = cur;
            for (int j = 1; j < w; ++j) sum += *((const f32x4*)(SP + ((size_t)b * 15 + (15 - j)) * 1024) + c4);
            d = sum / (float)w - cur; }
        *((unsigned long long*)(DP + (size_t)r * 1024) + c4) = (unsigned long long)pk2(d.x, d.y) | ((unsigned long long)pk2(d.z, d.w) << 32); }
}
__device__ __forceinline__ void rms_row_to_f32(const float* xrow, const float* gain, float* orow, int lane) {
    const f32x4* xr = (const f32x4*)xrow + lane; const f32x4* gr = (const f32x4*)gain + lane;
    f32x4 v[8]; float s = 0.f;
#pragma unroll
    for (int j = 0; j < 8; ++j) { v[j] = xr[64 * j]; s += (v[j].x * v[j].x + v[j].y * v[j].y) + (v[j].z * v[j].z + v[j].w * v[j].w); }
    const float rstd = 1.f / sqrtf(wave_sum(s) * (1.f / DM) + EPS);
#pragma unroll
    for (int j = 0; j < 8; ++j) { const f32x4 g = gr[64 * j]; *((f32x4*)orow + lane + 64 * j) = v[j] * rstd * g; }
}

template <int NB, int MODE  >
__device__ __forceinline__ void small_gemm_item(const bf16* A, int lda, const bf16* Bt, int ldb, int n0, int k_lo, int k_hi, float* outF, bf16* outH, int ldo, int wave, int lane) {
    const int fr = lane & 15, fq = lane >> 4;
    const bf16* ap = A + (size_t)(16 * wave + fr) * lda + k_lo + 8 * fq;
    const bf16* bp = Bt + (size_t)(n0 + fr) * ldb + k_lo + 8 * fq;
    f32x4 acc[NB];
#pragma unroll
    for (int c = 0; c < NB; ++c) acc[c] = (f32x4){0.f, 0.f, 0.f, 0.f};
#pragma unroll 8
    for (int k = k_lo; k < k_hi; k += 32) {
        const bf16x8_t af = *(const bf16x8_t*)ap; ap += 32;
#pragma unroll
        for (int c = 0; c < NB; ++c) { const bf16x8_t bfv = *(const bf16x8_t*)(bp + (size_t)16 * c * ldb); acc[c] = __builtin_amdgcn_mfma_f32_16x16x32_bf16(bfv, af, acc[c], 0, 0, 0); }
        bp += 32;
    }
    const int row = 16 * wave + fr;
#pragma unroll
    for (int c = 0; c < NB; ++c) { const int col = n0 + 16 * c + 4 * fq;
        if (MODE == 0) *(f32x4*)(outF + (size_t)row * ldo + col) = acc[c];
        else { float v0 = fmaxf(acc[c].x, 0.f), v1 = fmaxf(acc[c].y, 0.f), v2 = fmaxf(acc[c].z, 0.f), v3 = fmaxf(acc[c].w, 0.f);
            unsigned long long o = (unsigned long long)pk2(v0 * v0, v1 * v1) | ((unsigned long long)pk2(v2 * v2, v3 * v3) << 32);
            *(unsigned long long*)(outH + (size_t)row * ldo + col) = o; } }
}
template <int KLEN, int MODE  >
__device__ __forceinline__ void small_gemm_ksplit(const bf16* A, int lda, const bf16* Bt, int ldb, int n0, int k_lo, float* outF, bf16* outH, int ldo, LAS unsigned char* lds, int tid, int wave, int lane) {
    constexpr int KW = KLEN / 8, NS = KW / 32;
    static_assert(KW % 32 == 0 && NS >= 1, "small_gemm_ksplit: KLEN must be a multiple of 256");
    const int fr = lane & 15, fq = lane >> 4;
    const bf16* ap = A + (size_t)fr * lda + k_lo + wave * KW + 8 * fq;
    const bf16* bp = Bt + (size_t)(n0 + fr) * ldb + k_lo + wave * KW + 8 * fq;
    f32x4 acc[8][2];
#pragma unroll
    for (int rb = 0; rb < 8; ++rb) { acc[rb][0] = (f32x4){0.f, 0.f, 0.f, 0.f}; acc[rb][1] = acc[rb][0]; }
    constexpr int SB = NS < 4 ? NS : 4;
#pragma unroll 1
    for (int s0 = 0; s0 < NS; s0 += SB) {
        bf16x8_t af[SB][8], bfv[SB][2];
#pragma unroll
        for (int ss = 0; ss < SB; ++ss) {
#pragma unroll
            for (int rb = 0; rb < 8; ++rb) af[ss][rb] = *(const bf16x8_t*)(ap + (size_t)(16 * rb) * lda + 32 * (s0 + ss));
            bfv[ss][0] = *(const bf16x8_t*)(bp + 32 * (s0 + ss)); bfv[ss][1] = *(const bf16x8_t*)(bp + (size_t)16 * ldb + 32 * (s0 + ss)); }
#pragma unroll
        for (int ss = 0; ss < SB; ++ss)
#pragma unroll
            for (int rb = 0; rb < 8; ++rb) { acc[rb][0] = __builtin_amdgcn_mfma_f32_16x16x32_bf16(bfv[ss][0], af[ss][rb], acc[rb][0], 0, 0, 0); acc[rb][1] = __builtin_amdgcn_mfma_f32_16x16x32_bf16(bfv[ss][1], af[ss][rb], acc[rb][1], 0, 0, 0); }
    }
    LAS float* part = (LAS float*)lds;
#pragma unroll
    for (int rb = 0; rb < 8; ++rb)
#pragma unroll
        for (int cb = 0; cb < 2; ++cb) *(LAS f32x4*)(part + ((size_t)(wave * 128 + 16 * rb + fr) * 32 + 16 * cb + 4 * fq)) = acc[rb][cb];
    __syncthreads();
    { const int row = tid >> 2, c0 = (tid & 3) * 8;
      f32x4 s0 = {0.f, 0.f, 0.f, 0.f}, s1 = s0;
#pragma unroll
      for (int w = 0; w < 8; ++w) { s0 += *(const LAS f32x4*)(part + ((size_t)(w * 128 + row) * 32 + c0)); s1 += *(const LAS f32x4*)(part + ((size_t)(w * 128 + row) * 32 + c0 + 4)); }
      if (MODE == 0) { float* o = outF + (size_t)row * ldo + n0 + c0; *(f32x4*)o = s0; *(f32x4*)(o + 4) = s1; }
      else { v4u o; float a0 = fmaxf(s0.x, 0.f), a1 = fmaxf(s0.y, 0.f), a2 = fmaxf(s0.z, 0.f), a3 = fmaxf(s0.w, 0.f), b0 = fmaxf(s1.x, 0.f), b1 = fmaxf(s1.y, 0.f), b2 = fmaxf(s1.z, 0.f), b3 = fmaxf(s1.w, 0.f);
          o.x = pk2(a0 * a0, a1 * a1); o.y = pk2(a2 * a2, a3 * a3); o.z = pk2(b0 * b0, b1 * b1); o.w = pk2(b2 * b2, b3 * b3);
          *(v4u*)(outH + (size_t)row * ldo + n0 + c0) = o; } }
    __syncthreads();
}
template <bool OUT_BF16>
__device__ __forceinline__ void rms_row_slabs(const float* base, const float* slab  , int b, const float* gain, float* xstore, bf16* obf, float* of32, int lane) {
    const f32x4* xr = (const f32x4*)base + lane; const f32x4* gr = (const f32x4*)gain + lane;
    f32x4 v[8]; float s = 0.f;
#pragma unroll
    for (int j = 0; j < 8; ++j) { v[j] = xr[64 * j];
#pragma unroll
        for (int sp = 0; sp < 4; ++sp) v[j] += *((const f32x4*)(slab + ((size_t)sp * DB + b) * DM) + lane + 64 * j);
        s += (v[j].x * v[j].x + v[j].y * v[j].y) + (v[j].z * v[j].z + v[j].w * v[j].w);
        if (xstore) *((f32x4*)xstore + lane + 64 * j) = v[j]; }
    const float rstd = 1.f / sqrtf(wave_sum(s) * (1.f / DM) + EPS);
#pragma unroll
    for (int j = 0; j < 8; ++j) { const f32x4 g = gr[64 * j];
        if (OUT_BF16) *((unsigned long long*)obf + lane + 64 * j) = (unsigned long long)pk2(v[j].x * rstd * g.x, v[j].y * rstd * g.y) | ((unsigned long long)pk2(v[j].z * rstd * g.z, v[j].w * rstd * g.w) << 32);
        else *((f32x4*)of32 + lane + 64 * j) = v[j] * rstd * g; }
}

#define GAS __attribute__((address_space(1)))
typedef GAS unsigned gu32;
#define RLX_AGENT __ATOMIC_RELAXED, __HIP_MEMORY_SCOPE_AGENT
#define XB_TMO      128
#define XB_XCNT(j)  (256  + 64 * (j))
#define XB_XSUB(j)  (1280 + 64 * (j))
#define XB_XGEN(j)  (2304 + 64 * (j))
#define XB_TOP      3328
#define XB_TOPGEN   3392
#define XCD_BAR_WORDS 3456
#define XB_SPIN_CAP (1u << 18)

__device__ __forceinline__ unsigned xb_ld(unsigned* p)              { return __hip_atomic_load(p, __ATOMIC_RELAXED, __HIP_MEMORY_SCOPE_AGENT); }
__device__ __forceinline__ unsigned xb_add(unsigned* p, unsigned v) { return __hip_atomic_fetch_add(p, v, __ATOMIC_RELAXED, __HIP_MEMORY_SCOPE_AGENT); }
__device__ __forceinline__ unsigned xb_xcc_id() { return (unsigned)__builtin_amdgcn_s_getreg((3 << 11) | 20) & 0xFu; }
#define XB_SPIN(cond, bar) do { unsigned _sp = 0; while (cond) { __builtin_amdgcn_s_sleep(1); \
    if ((++_sp & 255u) == 0u) { if (xb_ld(&(bar)[XB_TMO])) break; if (_sp > XB_SPIN_CAP) { atomicAdd(&(bar)[XB_TMO], 1u); break; } } } } while (0)

struct XcdBarrier {
    unsigned* bar; unsigned x;
    volatile LAS unsigned* st;
};

__device__ __forceinline__ XcdBarrier xcd_barrier_post(unsigned* bar, volatile LAS unsigned* st) {
    XcdBarrier b; b.bar = bar; b.x = xb_xcc_id(); b.st = st;
    if (threadIdx.x == 0) (void)xb_add(&bar[XB_XCNT(b.x)], 1u);
    return b;
}
__device__ __forceinline__ void xcd_barrier_complete(unsigned* bar, unsigned x, unsigned& nloc, unsigned& nx) {
    const unsigned G = gridDim.x * gridDim.y * gridDim.z;
    unsigned sum, cnt, mine, sp = 0u;
    for (;;) {
        sum = 0u; cnt = 0u; mine = 0u;
#pragma unroll
        for (unsigned j = 0; j < 16; ++j) { const unsigned c = xb_ld(&bar[XB_XCNT(j)]); sum += c; cnt += (c > 0u) ? 1u : 0u; mine = (j == x) ? c : mine; }
        if (sum == G) break;
        __builtin_amdgcn_s_sleep(1);
        if ((++sp & 255u) == 0u) { if (xb_ld(&bar[XB_TMO])) break; if (sp > XB_SPIN_CAP) { atomicAdd(&bar[XB_TMO], 1u); break; } }
    }
    nloc = mine > 0u ? mine : 1u; nx = cnt > 0u ? cnt : 1u;
}

__device__ __forceinline__ void xcd_barrier(const XcdBarrier& b) {
    asm volatile("s_waitcnt vmcnt(0)" ::: "memory");
    __syncthreads();
    if (threadIdx.x == 0) {
        unsigned* bar = b.bar;
        __builtin_amdgcn_s_waitcnt(0);
        unsigned nloc = b.st[0], nx = b.st[1];
        if (nloc == 0u) { xcd_barrier_complete(bar, b.x, nloc, nx); b.st[0] = nloc; b.st[1] = nx; }
        const unsigned old = xb_add(&bar[XB_XSUB(b.x)], 1u);
        const unsigned gen = old / nloc;
        if (old + 1u == (gen + 1u) * nloc) {
            __builtin_amdgcn_fence(__ATOMIC_RELEASE, "agent");
            asm volatile("s_waitcnt vmcnt(0)" ::: "memory");
            const unsigned og = xb_add(&bar[XB_TOP], 1u);
            const unsigned tg = og / nx;
            if (og + 1u == (tg + 1u) * nx) xb_add(&bar[XB_TOPGEN], 1u);
            else XB_SPIN(xb_ld(&bar[XB_TOPGEN]) == tg, bar);
            __builtin_amdgcn_fence(__ATOMIC_ACQUIRE, "agent");
            xb_add(&bar[XB_XGEN(b.x)], 1u);
            asm volatile("s_waitcnt vmcnt(0)" ::: "memory");
        } else {
            XB_SPIN(xb_ld(&bar[XB_XGEN(b.x)]) == gen, bar);
            __builtin_amdgcn_fence(__ATOMIC_ACQUIRE, "agent");
            asm volatile("s_waitcnt vmcnt(0)" ::: "memory");
        }
    }
    __syncthreads();
}


__global__ void __launch_bounds__(512, 2) mk_fwd(Args a) {
    extern __shared__ __attribute__((aligned(16))) unsigned char lds_raw[];
    LAS unsigned char* lds = (LAS unsigned char*)lds_raw;
    const int tid = threadIdx.x, lane = tid & 63, wave = __builtin_amdgcn_readfirstlane(tid >> 6);
    const int G = gridDim.x, bid = blockIdx.x;
    const int gw = bid * 8 + wave, NGW = G * 8;
    unsigned char* ws = a.ws;
    const int lo = a.ph_lo, hi = a.ph_hi;
#ifndef PHASE_MASK
#define PHASE_MASK 0xFFF
#endif
#define IN(k) ((((PHASE_MASK) >> (k)) & 1) && lo <= (k) && (k) < hi)
#if MK_ONE_LAUNCH
    for (int u = tid; u < (LDS_BYTES - LDSCTL_OFF) / 4; u += 512) ((LAS unsigned*)(lds + LDSCTL_OFF))[u] = 0u;
    __syncthreads();
    if (hi > NPH) cg::this_grid().sync();
    XcdBarrier bar = xcd_barrier_post((unsigned*)(ws + WS_CTL) + CW_BAR, (volatile LAS unsigned*)(lds + MISC_OFF) + 8);
#define SEAM(k) do { if (IN(k) && IN((k) + 1)) xcd_barrier(bar); } while (0)
#else
#define SEAM(k) do { } while (0)
#endif
#ifndef DUPMASK
#define DUPMASK 0
#endif
#ifndef GREP
#define GREP 0
#endif
#define GR(k) ((((GREP) >> (k)) & 1) ? 2 : 1)
#define REPS(k) for (int rep_ = 0; rep_ < ((((DUPMASK) >> (k)) & 1) ? 2 : 1); ++rep_)
    if (IN(0)) REPS(0) { p0_prep(a, lds, gw, NGW, wave, lane); __syncthreads(); } SEAM(0);
    if (IN(1)) REPS(1) { pg8::Gemm g{(const pg8::bf16_t*)(ws + WS_XN), (const pg8::bf16_t*)(ws + WS_WIN), MP, NZ, DM, DM, DM, 0}; pg8::StaticOrder S; S.init(MP, NZ, G, bid);
        pg8::EpiIn E{a.out, ws};
        pg8::gemm_phase<pg8::EpiIn, pg8::StaticOrder, PG8_ALIGN, PG8_SP2>(lds, g, S, E); } SEAM(2);
#ifndef SUB3
#define SUB3 7
#endif
#ifndef SUB3DUP
#define SUB3DUP 0
#endif
#ifndef PMODE2
#define PMODE2 0
#endif
    if (IN(3)) {         p3_indexer_prompt<0>(a, lds, bid, G, tid, wave, lane, true); __syncthreads();
        if (SUB3DUP & 1) { p3_indexer_prompt<PMODE2>(a, lds, bid, G, tid, wave, lane, false); __syncthreads(); }
        for (int r3 = 0; r3 < ((SUB3DUP & 2) ? 2 : 1); ++r3) { p3_indexer_sample(a, lds, gw, NGW, wave, lane); }
        for (int r3 = 0; r3 < ((SUB3DUP & 4) ? 2 : 1); ++r3) p5_dpool(a, bid, G, tid); __syncthreads(); } SEAM(3);
    if (IN(4)) REPS(4) {
        { pg8::Gemm g{(const pg8::bf16_t*)(ws + WS_DPOOL), (const pg8::bf16_t*)(ws + WS_WPOOL), MP, 1024, 256, 1024, 256, 256}; pg8::StaticOrder S; S.init(MP, 1024, G, bid, GR(6));
          pg8::EpiBf16<0> E{(pg8::bf16_t*)(ws + WS_CAT), 2048, 1024, a.in[11]};
          pg8::gemm_phase<pg8::EpiBf16<0>, pg8::StaticOrder, PG8_ALIGN, PG8_SP2>(lds, g, S, E); }
        p4_topk(a, lds, gw, NGW, wave, lane); __syncthreads(); } SEAM(4);
#ifndef APROBE2
#define APROBE2 0
#endif
    if (IN(5)) { p5_attn<0>(a, lds, bid, G, wave, lane); __syncthreads(); if (APROBE2) { p5_attn<APROBE2>(a, lds, bid, G, wave, lane); __syncthreads(); } } SEAM(6);
    constexpr int R0 = NMETA;
    if (IN(7)) REPS(7) { pg8::Gemm g{(const pg8::bf16_t*)(ws + WS_CAT) + (size_t)R0 * DM, (const pg8::bf16_t*)(ws + WS_WOUT), SEQ, DM, DM, DM, DM, 0}; pg8::StaticOrder S; S.init(SEQ, DM, G, bid, GR(7));
        pg8::EpiRes E{(float*)(ws + WS_H1) + (size_t)R0 * DM, a.in[0]};
        pg8::gemm_phase<pg8::EpiRes, pg8::StaticOrder, PG8_ALIGN, PG8_SP2>(lds, g, S, E);
        for (int it = bid; it < 256; it += G) { const int ct = it & 63, sp = it >> 6;
            small_gemm_ksplit<512, 0>((const bf16*)(ws + WS_CAT) + (size_t)TP * DM, DM, (const bf16*)(ws + WS_WOUT), DM, 32 * ct, 512 * sp, (float*)(ws + WS_PS1) + (size_t)sp * DB * DM, nullptr, DM, lds, tid, wave, lane); }
    } SEAM(7);
    if (IN(8)) REPS(8) { float* H1 = (float*)(ws + WS_H1); bf16* XN = (bf16*)(ws + WS_XN);
        for (int m = gw; m < SEQ + DB; m += NGW) { const int r = R0 + m;
            if (m < SEQ) rms_row_to_bf16(H1 + (size_t)r * DM, a.in[13], XN + (size_t)r * DM, lane);
            else rms_row_slabs<true>(a.in[1] + (size_t)(m - SEQ) * DM, (const float*)(ws + WS_PS1), m - SEQ, a.in[13], H1 + (size_t)r * DM, XN + (size_t)r * DM, nullptr, lane); } } SEAM(8);
    if (IN(9)) REPS(9) { pg8::Gemm g{(const pg8::bf16_t*)(ws + WS_XN) + (size_t)R0 * DM, (const pg8::bf16_t*)(ws + WS_WUP), SEQ, DFF, DM, DM, DM, 0}; pg8::StaticOrder S; S.init(SEQ, DFF, G, bid, GR(9));
        pg8::EpiBf16<1> E{(pg8::bf16_t*)(ws + WS_ACT) + (size_t)R0 * DFF, DFF, 0, nullptr};
        pg8::gemm_phase<pg8::EpiBf16<1>, pg8::StaticOrder, PG8_ALIGN, PG8_SP2>(lds, g, S, E);
        for (int it = bid; it < 256; it += G)
            small_gemm_ksplit<2048, 1>((const bf16*)(ws + WS_XN) + (size_t)TP * DM, DM, (const bf16*)(ws + WS_WUP), DM, 32 * it, 0, nullptr, (bf16*)(ws + WS_ACT) + (size_t)TP * DFF, DFF, lds, tid, wave, lane);
    } SEAM(9);
    if (IN(10)) REPS(10) { pg8::Gemm g{(const pg8::bf16_t*)(ws + WS_ACT) + (size_t)R0 * DFF, (const pg8::bf16_t*)(ws + WS_WDN), SEQ, DM, DFF, DFF, DFF, 0}; pg8::StaticOrder S; S.init(SEQ, DM, G, bid, GR(10));
        pg8::EpiRes E{(float*)(ws + WS_H2) + (size_t)R0 * DM, (const float*)(ws + WS_H1) + (size_t)R0 * DM};
        pg8::gemm_phase<pg8::EpiRes, pg8::StaticOrder, PG8_ALIGN, PG8_SP2>(lds, g, S, E);
        for (int it = bid; it < 256; it += G) { const int ct = it & 63, sp = it >> 6;
            small_gemm_ksplit<2048, 0>((const bf16*)(ws + WS_ACT) + (size_t)TP * DFF, DFF, (const bf16*)(ws + WS_WDN), DFF, 32 * ct, 2048 * sp, (float*)(ws + WS_PS2) + (size_t)sp * DB * DM, nullptr, DM, lds, tid, wave, lane); }
    } SEAM(10);
    if (IN(11)) REPS(11) { const float* H2 = (const float*)(ws + WS_H2); const float* H1 = (const float*)(ws + WS_H1);
        for (int m = gw; m < SEQ + DB; m += NGW) { const int r = R0 + m;
            if (m < SEQ) rms_row_to_f32(H2 + (size_t)r * DM, a.in[16], a.out + O_YP + (size_t)m * DM, lane);
            else rms_row_slabs<false>(H1 + (size_t)r * DM, (const float*)(ws + WS_PS2), m - SEQ, a.in[16], nullptr, nullptr, a.out + O_YS + (size_t)(m - SEQ) * DM, lane); } }
#undef IN
#undef SEAM
}

extern "C" void kernel_launch(void* const* d_in, const int* in_sizes, int n_in, void* d_out, int out_size, void* d_ws, size_t ws_size, hipStream_t stream) {
    static int grid = 0;
    if (grid == 0) {
        if (n_in != 17 || (size_t)out_size != O_END || ws_size < WS_END) { fprintf(stderr, "kernel_launch: unexpected shapes: n_in %d out_size %d (want %zu) ws %zu (want >= %zu)\n", n_in, out_size, (size_t)O_END, ws_size, (size_t)WS_END); grid = -1; return; }
        int dev = 0, cus = 0, per_cu = 0;
        if (hipGetDevice(&dev) != hipSuccess || hipDeviceGetAttribute(&cus, hipDeviceAttributeMultiprocessorCount, dev) != hipSuccess) { grid = -1; return; }
        if (hipFuncSetAttribute((const void*)mk_fwd, hipFuncAttributeMaxDynamicSharedMemorySize, LDS_BYTES) != hipSuccess) { fprintf(stderr, "kernel_launch: hipFuncSetAttribute failed\n"); grid = -1; return; }
        if (hipOccupancyMaxActiveBlocksPerMultiprocessor(&per_cu, (const void*)mk_fwd, 512, LDS_BYTES) != hipSuccess || per_cu < 1) { fprintf(stderr, "kernel_launch: occupancy query says %d\n", per_cu); grid = -1; return; }
        grid = cus;
        fprintf(stderr, "kernel_launch: grid %d (cus %d, per_cu %d)\n", grid, cus, per_cu);
    }
    if (grid < 0) return;
    Args a{};
    for (int i = 0; i < 17; ++i) a.in[i] = (const float*)d_in[i];
    a.out = (float*)d_out; a.ws = (unsigned char*)d_ws;
#if MK_ONE_LAUNCH
    a.ph_lo = 0; a.ph_hi = NPH;
    if (hipMemsetAsync((char*)d_ws + WS_CTL, 0, 65536, stream) != hipSuccess) { fprintf(stderr, "kernel_launch: memset failed\n"); return; }
    void* args[] = {&a};
    hipError_t e = hipLaunchCooperativeKernel((const void*)mk_fwd, dim3(grid), dim3(512), args, LDS_BYTES, stream);
    if (e != hipSuccess) fprintf(stderr, "kernel_launch: cooperative launch failed: %s (grid %d)\n", hipGetErrorString(e), grid);
#else
    for (int p = 0; p < NPH; ++p) { a.ph_lo = p; a.ph_hi = p + 1; hipLaunchKernelGGL(mk_fwd, dim3(grid), dim3(512), LDS_BYTES, stream, a); }
#endif
}
```

```cpp
#include <hip/hip_runtime.h>
#include <hip/hip_cooperative_groups.h>
#include <cstdio>
#include <cstdint>
namespace cg = cooperative_groups;

namespace pg8 {
#define PG8_LAS __attribute__((address_space(3)))
typedef unsigned short bf16_t;
typedef short bf16x8 __attribute__((ext_vector_type(8)));
typedef float f32x4 __attribute__((ext_vector_type(4)));
typedef unsigned u32x4 __attribute__((ext_vector_type(4)));
constexpr int BM = 256, BK = 64, HALF = 128, HTB = HALF * BK * 2  , STAGE_BYTES = 8 * HTB, NXCD = 8, WGM = 8;

__host__ __device__ __forceinline__ int lds_byte(int r, int c) { const int st = (r >> 4) * 2 + (c >> 5), rr = r & 15, cc = c & 31, ob = rr * 64 + cc * 2; return st * 1024 + (ob ^ (((ob >> 9) & 1) << 5)); }
__host__ __device__ __forceinline__ void stage_rc(int b, int& R, int& C) { const int st = b / 1024, sb = b % 1024, swz = sb ^ (((sb >> 9) & 1) << 5); R = (st >> 1) * 16 + swz / 64; C = (st & 1) * 32 + (swz % 64) / 2; }
__host__ __device__ __forceinline__ int perm32(int rho) { const int n = rho >> 4, i = rho & 15; return 8 * (i >> 2) + 4 * n + (i & 3); }

struct Unit { int pm, pn; };
struct Gemm { const bf16_t* A; const bf16_t* Bt; int M, N, K, lda, ldb, acs; };

struct StaticOrder {
    int nM, nN, nwg, G, c, rep;
    __host__ __device__ void init(int M, int N, int G_, int c_, int rep_ = 1) { nM = M / BM; nN = N / BM; nwg = nM * nN; G = G_; c = c_; rep = rep_; }
    __host__ __device__ bool next(int i, Unit& u) const {
        const int R = (nwg + G - 1) / G;
        if (i >= R * rep) return false;
        const long L = (long)(i % R) * G + c; if (L >= nwg) return (i + 1 < R * rep) ? next(i + 1, u) : false;
        int wgid = (int)L; { const int q = nwg / NXCD, r = nwg % NXCD, xcd = wgid % NXCD, off = wgid / NXCD; wgid = (xcd < r ? xcd * (q + 1) : r * (q + 1) + (xcd - r) * q) + off; }
        const int nig = WGM * nN, gid = wgid / nig, fm = gid * WGM, gsz = (nM - fm) < WGM ? (nM - fm) : WGM;
        u.pm = fm + ((wgid % nig) % gsz); u.pn = (wgid % nig) / gsz; return true;
    }
    __device__ __forceinline__ void a_ready(const Unit&) const {}
    __device__ __forceinline__ void done(const Unit&) const {}
};


__device__ __forceinline__ unsigned cvt_pk_bf16(float lo, float hi) { unsigned r; asm volatile("v_cvt_pk_bf16_f32 %0, %1, %2" : "=v"(r) : "v"(lo), "v"(hi)); return r; }

struct EpiF32 {
    static constexpr bool PERM = false, AFTER_DRAIN = false;
    float* C; int ldc;
    __device__ __forceinline__ void operator()(const f32x4 (&acc)[2][2][4][2], const Unit& u, int wr, int wc, int fr, int fq) const {
        const int row0 = u.pm * BM + wr * 64 + fr, col0 = u.pn * BM + wc * 32 + 4 * fq;
#pragma unroll
        for (int ai = 0; ai < 2; ++ai)
#pragma unroll
            for (int m = 0; m < 4; ++m) { float* rowp = C + (size_t)(row0 + ai * HALF + m * 16) * ldc + col0;
#pragma unroll
                for (int bj = 0; bj < 2; ++bj)
#pragma unroll
                    for (int n = 0; n < 2; ++n) *(f32x4*)(rowp + bj * HALF + n * 16) = acc[ai][bj][m][n]; }
    }
};
template <int ACT> struct EpiBf16 {
    static constexpr bool PERM = true, AFTER_DRAIN = false;
    bf16_t* O; int ldc; int col_off; const float* colscale;
    __device__ __forceinline__ void operator()(const f32x4 (&acc)[2][2][4][2], const Unit& u, int wr, int wc, int fr, int fq) const {
        const int row0 = u.pm * BM + wr * 64 + fr; const int col0 = u.pn * BM + wc * 32 + 8 * fq;
#pragma unroll
        for (int bj = 0; bj < 2; ++bj) {
            f32x4 sv0 = (f32x4){1.f, 1.f, 1.f, 1.f}, sv1 = sv0;
            if (ACT == 0) { sv0 = *(const f32x4*)(colscale + col0 + bj * HALF); sv1 = *(const f32x4*)(colscale + col0 + bj * HALF + 4); }
#pragma unroll
            for (int ai = 0; ai < 2; ++ai)
#pragma unroll
                for (int m = 0; m < 4; ++m) { bf16_t* rowp = O + (size_t)(row0 + ai * HALF + m * 16) * ldc + col_off + col0;
                    f32x4 v0 = acc[ai][bj][m][0], v1 = acc[ai][bj][m][1];
                    if (ACT == 0) { v0 = v0 * sv0; v1 = v1 * sv1; }
                    if (ACT == 1) {
#pragma unroll
                        for (int j = 0; j < 4; ++j) { const float a = fmaxf(v0[j], 0.f), b = fmaxf(v1[j], 0.f); v0[j] = a * a; v1[j] = b * b; } }
                    u32x4 w; w.x = cvt_pk_bf16(v0[0], v0[1]); w.y = cvt_pk_bf16(v0[2], v0[3]); w.z = cvt_pk_bf16(v1[0], v1[1]); w.w = cvt_pk_bf16(v1[2], v1[3]);
                    *(u32x4*)(rowp + bj * HALF) = w; }
        }
    }
};
struct EpiRes {
    static constexpr bool PERM = false, AFTER_DRAIN = false;
    float* C; const float* R;
    __device__ __forceinline__ void operator()(const f32x4 (&acc)[2][2][4][2], const Unit& u, int wr, int wc, int fr, int fq) const {
        const int row0 = u.pm * BM + wr * 64 + fr, col0 = u.pn * BM + wc * 32 + 4 * fq;
#pragma unroll
        for (int ai = 0; ai < 2; ++ai)
#pragma unroll
            for (int m = 0; m < 4; ++m) { const size_t off = (size_t)(row0 + ai * HALF + m * 16) * 2048 + col0;
#pragma unroll
                for (int bj = 0; bj < 2; ++bj)
#pragma unroll
                    for (int n = 0; n < 2; ++n) { const f32x4 rv = *(const f32x4*)(R + off + bj * HALF + n * 16);
                        *(f32x4*)(C + off + bj * HALF + n * 16) = acc[ai][bj][m][n] + rv; } }
    }
};


template <class Epi, class Sched, bool ALIGN_EPI = false, bool SP2 = false>
__device__ __forceinline__ void gemm_phase(PG8_LAS unsigned char* lds, const Gemm g, const Sched& S, const Epi& E) {
    const int tid = threadIdx.x, wid = __builtin_amdgcn_readfirstlane(tid >> 6), lane = tid & 63, wr = wid >> 2, wc = wid & 3, fr = lane & 15, fq = lane >> 4;
    const int K = g.K, nt = K / BK;
    unsigned voffA[2], voffB[2];
#pragma unroll
    for (int i = 0; i < 2; ++i) { int R, C; stage_rc(tid * 16 + i * 8192, R, C); const int Rb = Epi::PERM ? ((R & ~31) + perm32(R & 31)) : R;
        voffA[i] = (unsigned)(R * g.lda + C) * 2u; voffB[i] = (unsigned)(Rb * g.ldb + C) * 2u; }
    const size_t kstep = (size_t)(BK * 2);
    const size_t hstepA = (size_t)HALF * g.lda * 2, hstepB = (size_t)HALF * g.ldb * 2;
    const size_t tstepA = 2 * hstepA, tstepB = 2 * hstepB;
    const size_t acs2 = (size_t)g.acs * 2;
    const unsigned ldsw = (unsigned)wid * 1024u;
    const int aoff = lds_byte(wr * 64 + fr, fq * 8), boff = lds_byte(wc * 32 + fr, fq * 8);
#define PG8_SA(b, h) (((b) * 2 + (h)) * HTB)
#define PG8_SB(b, h) ((4 + (b) * 2 + (h)) * HTB)
#define PG8_STAGE(bufoff, gbase, voff) do { _Pragma("unroll") for (int _i = 0; _i < 2; ++_i) \
        __builtin_amdgcn_global_load_lds((const unsigned*)((const char*)(gbase) + (voff)[_i]), (PG8_LAS unsigned*)(lds + (bufoff) + ldsw + _i * 8192), 16, 0, 0); } while (0)
#define PG8_LDA(dst, b, h) do { _Pragma("unroll") for (int m = 0; m < 4; ++m) _Pragma("unroll") for (int k = 0; k < 2; ++k) dst[m][k] = *(const PG8_LAS bf16x8*)(lds + PG8_SA(b, h) + aoff + m * 2048 + k * 1024); } while (0)
#define PG8_LDB(dst, b, h) do { _Pragma("unroll") for (int n = 0; n < 2; ++n) _Pragma("unroll") for (int k = 0; k < 2; ++k) dst[n][k] = *(const PG8_LAS bf16x8*)(lds + PG8_SB(b, h) + boff + n * 2048 + k * 1024); } while (0)
#define PG8_MMA(ai, bj, At, Bt) do { __builtin_amdgcn_s_setprio(1); _Pragma("unroll") for (int m = 0; m < 4; ++m) _Pragma("unroll") for (int n = 0; n < 2; ++n) _Pragma("unroll") for (int k = 0; k < 2; ++k) \
        acc[ai][bj][m][n] = __builtin_amdgcn_mfma_f32_16x16x32_bf16(Bt[n][k], At[m][k], acc[ai][bj][m][n], 0, 0, 0); __builtin_amdgcn_s_setprio(0); } while (0)
#define PG8_WAIT_V(n) asm volatile("s_waitcnt vmcnt(" #n ")" ::: "memory")
#define PG8_WAIT_L(n) asm volatile("s_waitcnt lgkmcnt(" #n ")" ::: "memory")
#define PG8_BAR __builtin_amdgcn_s_barrier()
#define PG8_SCHED __builtin_amdgcn_sched_barrier(0)
    Unit cur, nxt; int ui = 0;
    if (!S.next(0, cur)) return;
    f32x4 acc[2][2][4][2];
#pragma unroll
    for (int a = 0; a < 2; ++a)
#pragma unroll
        for (int b = 0; b < 2; ++b)
#pragma unroll
            for (int m = 0; m < 4; ++m)
#pragma unroll
                for (int n = 0; n < 2; ++n) acc[a][b][m][n] = (f32x4){0.f, 0.f, 0.f, 0.f};
    bf16x8 At[4][2], B0[2][2], B1[2][2];
    const char* cA = (const char*)g.A + (size_t)cur.pm * tstepA + (size_t)cur.pn * acs2; const char* cB = (const char*)g.Bt + (size_t)cur.pn * tstepB;
    S.a_ready(cur);
    if constexpr (SP2) {
        PG8_STAGE(PG8_SB(0, 0), cB, voffB); PG8_STAGE(PG8_SB(0, 1), cB + hstepB, voffB); PG8_STAGE(PG8_SA(0, 0), cA, voffA); PG8_STAGE(PG8_SA(0, 1), cA + hstepA, voffA);
        if (wr == 1) PG8_BAR;
        PG8_WAIT_V(2); PG8_BAR;
        PG8_STAGE(PG8_SB(1, 0), cB + kstep, voffB); PG8_STAGE(PG8_SA(1, 0), cA + kstep, voffA); PG8_STAGE(PG8_SB(1, 1), cB + hstepB + kstep, voffB);
        PG8_WAIT_V(6); PG8_BAR;
    } else {
        PG8_STAGE(PG8_SB(0, 0), cB, voffB); PG8_STAGE(PG8_SA(0, 0), cA, voffA); PG8_STAGE(PG8_SB(0, 1), cB + hstepB, voffB); PG8_STAGE(PG8_SA(0, 1), cA + hstepA, voffA);
        if (wr == 1) PG8_BAR;
        PG8_WAIT_V(4); PG8_BAR;
        PG8_STAGE(PG8_SB(1, 0), cB + kstep, voffB); PG8_STAGE(PG8_SA(1, 0), cA + kstep, voffA); PG8_STAGE(PG8_SB(1, 1), cB + hstepB + kstep, voffB);
        PG8_WAIT_V(6); PG8_BAR;
    }
    for (;;) {
        const bool has_next = S.next(ui + 1, nxt);
        const char* nA = has_next ? (const char*)g.A + (size_t)nxt.pm * tstepA + (size_t)nxt.pn * acs2 : cA; const char* nB = has_next ? (const char*)g.Bt + (size_t)nxt.pn * tstepB : cB;
        for (int t = 0; t < nt; t += 2) {
            const bool last = (t == nt - 2);
            const char* a1 = cA + (size_t)(t + 1) * kstep;
            const char* a2 = last ? nA : cA + (size_t)(t + 2) * kstep; const char* b2 = last ? nB : cB + (size_t)(t + 2) * kstep;
            const char* a3 = a2 + kstep; const char* b3 = b2 + kstep;
            if (last && has_next) S.a_ready(nxt);
            if constexpr (SP2) {
            PG8_LDB(B0, 0, 0); PG8_LDB(B1, 0, 1); PG8_SCHED; PG8_LDA(At, 0, 0); PG8_STAGE(PG8_SA(1, 1), a1 + hstepA, voffA);
            PG8_WAIT_V(8); PG8_WAIT_L(0); PG8_BAR; PG8_MMA(0, 0, At, B0); PG8_MMA(0, 1, At, B1); PG8_BAR; PG8_SCHED;
            PG8_LDA(At, 0, 1); PG8_STAGE(PG8_SB(0, 0), b2, voffB); PG8_STAGE(PG8_SB(0, 1), b2 + hstepB, voffB); PG8_STAGE(PG8_SA(0, 0), a2, voffA);
            PG8_WAIT_V(8); PG8_WAIT_L(0); PG8_BAR; PG8_MMA(1, 0, At, B0); PG8_MMA(1, 1, At, B1); PG8_BAR; PG8_SCHED;
            PG8_LDB(B0, 1, 0); PG8_LDB(B1, 1, 1); PG8_SCHED; PG8_LDA(At, 1, 0); PG8_STAGE(PG8_SA(0, 1), a2 + hstepA, voffA);
            PG8_WAIT_V(8); PG8_WAIT_L(0); PG8_BAR; PG8_MMA(0, 0, At, B0); PG8_MMA(0, 1, At, B1); PG8_BAR; PG8_SCHED;
            PG8_LDA(At, 1, 1); PG8_STAGE(PG8_SB(1, 0), b3, voffB); PG8_STAGE(PG8_SB(1, 1), b3 + hstepB, voffB); PG8_STAGE(PG8_SA(1, 0), a3, voffA);
            PG8_WAIT_V(8); PG8_WAIT_L(0); PG8_BAR; PG8_MMA(1, 0, At, B0); PG8_MMA(1, 1, At, B1); PG8_BAR; PG8_SCHED;
            } else {
            PG8_LDB(B0, 0, 0); PG8_SCHED; PG8_LDA(At, 0, 0); PG8_STAGE(PG8_SA(1, 1), a1 + hstepA, voffA);
            PG8_WAIT_L(8); PG8_BAR; PG8_WAIT_L(0); PG8_MMA(0, 0, At, B0); PG8_BAR; PG8_SCHED;
            PG8_LDB(B1, 0, 1); PG8_STAGE(PG8_SB(0, 0), b2, voffB);
            PG8_BAR; PG8_WAIT_L(0); PG8_MMA(0, 1, At, B1); PG8_BAR;
            PG8_LDA(At, 0, 1); PG8_STAGE(PG8_SA(0, 0), a2, voffA);
            PG8_BAR; PG8_WAIT_L(0); PG8_MMA(1, 0, At, B0); PG8_BAR; PG8_SCHED;
            PG8_STAGE(PG8_SB(0, 1), b2 + hstepB, voffB);
            PG8_WAIT_V(6); PG8_BAR; PG8_MMA(1, 1, At, B1); PG8_BAR;
            PG8_LDB(B0, 1, 0); PG8_SCHED; PG8_LDA(At, 1, 0); PG8_STAGE(PG8_SA(0, 1), a2 + hstepA, voffA);
            PG8_WAIT_L(8); PG8_BAR; PG8_WAIT_L(0); PG8_MMA(0, 0, At, B0); PG8_BAR; PG8_SCHED;
            PG8_LDB(B1, 1, 1); PG8_STAGE(PG8_SB(1, 0), b3, voffB);
            PG8_BAR; PG8_WAIT_L(0); PG8_MMA(0, 1, At, B1); PG8_BAR;
            PG8_LDA(At, 1, 1); PG8_STAGE(PG8_SA(1, 0), a3, voffA);
            PG8_BAR; PG8_WAIT_L(0); PG8_MMA(1, 0, At, B0); PG8_BAR; PG8_SCHED;
            PG8_STAGE(PG8_SB(1, 1), b3 + hstepB, voffB);
            PG8_WAIT_V(6); PG8_BAR; PG8_MMA(1, 1, At, B1); PG8_BAR;
            }
        }
        if constexpr (ALIGN_EPI) { if (wr == 0) PG8_BAR; }
        if constexpr (!Epi::AFTER_DRAIN) { E(acc, cur, wr, wc, fr, fq); S.done(cur); }
        if (!has_next) break;
#pragma unroll
        for (int a = 0; a < 2; ++a)
#pragma unroll
            for (int b = 0; b < 2; ++b)
#pragma unroll
                for (int m = 0; m < 4; ++m)
#pragma unroll
                    for (int n = 0; n < 2; ++n) acc[a][b][m][n] = (f32x4){0.f, 0.f, 0.f, 0.f};
        cur = nxt; cA = nA; cB = nB; ++ui;
        if constexpr (ALIGN_EPI) { if (wr == 1) PG8_BAR; }
    }
    PG8_WAIT_V(0);
    if constexpr (!ALIGN_EPI) { if (wr == 0) PG8_BAR; }
    PG8_BAR;
    if constexpr (Epi::AFTER_DRAIN) { E.fused(acc, cur, wr, wc, fr, fq, lds, wid, lane); S.done(cur); }
#undef PG8_SA
#undef PG8_SB
#undef PG8_STAGE
#undef PG8_LDA
#undef PG8_LDB
#undef PG8_MMA
#undef PG8_WAIT_V
#undef PG8_WAIT_L
#undef PG8_BAR
#undef PG8_SCHED
}
}

#ifndef PG8_SP2
#define PG8_SP2 true
#endif
#ifndef PG8_ALIGN
#define PG8_ALIGN true
#endif
#ifndef MK_ONE_LAUNCH
#define MK_ONE_LAUNCH 1
#endif

constexpr int DM = 2048, SEQ = 8192, NMETA = 16, TP = SEQ + NMETA, DB = 128, MR = TP + DB, MP = 8448;
constexpr int HD = 128, NH = 8, NKV = 2, NIH = 16, IDD = 64, TOPK = 256, NZR = 3664, NZ = 3840, DFF = 8192;
constexpr int PAST = 2048, PAGE = 128, NPAGES = 16, LS = PAST + 1;
constexpr int ZQ = 0, ZK = 1024, ZV = 1280, ZQI = 1536, ZKI = 2560, ZWI = 2624, ZU = 2640;
constexpr float EPS = 1e-6f;
constexpr int SCLD = 8256, SCROWS = 8224, SCSLD = 2304;
constexpr size_t O_YP = 0, O_YS = O_YP + (size_t)SEQ * DM, O_KP = O_YS + (size_t)DB * DM, O_VP = O_KP + (size_t)TP * 256, O_KIP = O_VP + (size_t)TP * 256,
                 O_PP = O_KIP + (size_t)TP * 64, O_KS = O_PP + 15 * 1024, O_VS = O_KS + DB * 256, O_KIS = O_VS + DB * 256, O_PS = O_KIS + DB * 64, O_END = O_PS + (size_t)DB * 15 * 1024;
constexpr size_t MiB = 1u << 20;
constexpr size_t WS_CTL = 0, WS_WIN = 2 * MiB, WS_WOUT = 18 * MiB, WS_WUP = 26 * MiB, WS_WDN = 58 * MiB, WS_WPOOL = 90 * MiB, WS_XN = 92 * MiB, WS_Z = 126 * MiB,
                 WS_QF = 250 * MiB, WS_QI = 284 * MiB, WS_KI = 302 * MiB, WS_WI = 304 * MiB, WS_U = 306 * MiB, WS_QI32 = 340 * MiB, WS_SCS = 341 * MiB, WS_SEL = 344 * MiB,
                 WS_DPOOL = 356 * MiB, WS_CAT = 374 * MiB, WS_H1 = 408 * MiB, WS_ACT = 476 * MiB, WS_H2 = 608 * MiB, WS_SC = 676 * MiB, WS_PS1 = 936 * MiB, WS_PS2 = 944 * MiB, WS_QB = 952 * MiB, WS_KB = 970 * MiB, WS_VB = 975 * MiB, WS_QL = 980 * MiB, WS_CS = 984 * MiB, WS_END = 992 * MiB;
static_assert(WS_Z + (size_t)MP * NZ * 4 <= WS_QF && WS_SC + (size_t)SCROWS * SCLD * 4 <= WS_PS1 && WS_ACT + (size_t)MP * DFF * 2 <= WS_H2, "ws map");
constexpr int LDS_BYTES = 163840;
constexpr int NPH = 12;

#define LAS __attribute__((address_space(3)))
typedef unsigned short bf16;
typedef unsigned v4u __attribute__((ext_vector_type(4)));
typedef float f32x4 __attribute__((ext_vector_type(4)));
typedef float f32x16 __attribute__((ext_vector_type(16)));
typedef _Float16 f16x8 __attribute__((ext_vector_type(8)));
typedef _Float16 f16;
typedef short bf16x8_t __attribute__((ext_vector_type(8)));

__device__ const double INV_FREQ[64] = { 1.00000000000000000e+00, 8.65964323360065347e-01, 7.49894209332455874e-01, 6.49381631576211316e-01, 5.62341325190349073e-01, 4.86967525165863113e-01, 4.21696503428582226e-01, 3.65174127254837722e-01, 3.16227766016837941e-01, 2.73841963426436130e-01, 2.37137370566165517e-01, 2.05352502645714613e-01, 1.77827941003892293e-01, 1.53992652605949187e-01, 1.33352143216332403e-01, 1.15478198468945817e-01, 1.00000000000000006e-01, 8.65964323360065291e-02, 7.49894209332455791e-02, 6.49381631576211316e-02, 5.62341325190349114e-02, 4.86967525165863113e-02, 4.21696503428582239e-02, 3.65174127254837694e-02, 3.16227766016837913e-02, 2.73841963426436144e-02, 2.37137370566165538e-02, 2.05352502645714599e-02, 1.77827941003892293e-02, 1.53992652605949194e-02, 1.33352143216332406e-02, 1.15478198468945813e-02, 1.00000000000000002e-02, 8.65964323360065430e-03, 7.49894209332455791e-03, 6.49381631576211298e-03, 5.62341325190349097e-03, 4.86967525165863096e-03, 4.21696503428582292e-03, 3.65174127254837711e-03, 3.16227766016837939e-03, 2.73841963426436127e-03, 2.37137370566165538e-03, 2.05352502645714599e-03, 1.77827941003892275e-03, 1.53992652605949203e-03, 1.33352143216332406e-03, 1.15478198468945813e-03, 1.00000000000000002e-03, 8.65964323360065387e-04, 7.49894209332455856e-04, 6.49381631576211342e-04, 5.62341325190349097e-04, 4.86967525165863096e-04, 4.21696503428582237e-04, 3.65174127254837700e-04, 3.16227766016837939e-04, 2.73841963426436105e-04, 2.37137370566165538e-04, 2.05352502645714610e-04, 1.77827941003892270e-04, 1.53992652605949192e-04, 1.33352143216332395e-04, 1.15478198468945822e-04 };

struct Args { const float* in[17]; float* out; unsigned char* ws; int ph_lo, ph_hi; };
constexpr int CW_BAR = 4096;
constexpr int LDSCTL_OFF = 159744, MISC_OFF = LDSCTL_OFF + 320;

#define LDS_WAIT() asm volatile("s_waitcnt lgkmcnt(0)" ::: "memory")
__device__ __forceinline__ unsigned f2bf(float f) { unsigned u = __builtin_bit_cast(unsigned, f); return (u + 0x7fffu + ((u >> 16) & 1u)) >> 16; }
__device__ __forceinline__ unsigned pk2(float lo, float hi) { return f2bf(lo) | (f2bf(hi) << 16); }
__device__ __forceinline__ float wave_sum(float v) {
#pragma unroll
    for (int o = 1; o < 64; o <<= 1) v += __shfl_xor(v, o);
    return v;
}
__device__ __forceinline__ const float* in_row(const Args& a, int r) {
    return r < NMETA ? a.in[7] + (size_t)r * DM : r < TP ? a.in[0] + (size_t)(r - NMETA) * DM : r < MR ? a.in[1] + (size_t)(r - TP) * DM : (const float*)nullptr;
}

__device__ __forceinline__ int win_src_col(int n) {
    const int pn = n >> 8, c = n & 255, half = c >> 7, cc = c & 127;
    if (pn < 4) return ZQ + (2 * pn + (cc >> 6)) * 128 + half * 64 + (cc & 63);
    if (pn == 4) return ZK + (cc >> 6) * 128 + half * 64 + (cc & 63);
    if (pn == 5) return ZV + c;
    if (pn < 10) return ZQI + (4 * (pn - 6) + (cc >> 5)) * 64 + half * 32 + (cc & 31);
    if (pn == 10) return c < 32 ? ZKI + c : c < 48 ? ZWI + (c - 32) : (c >= 128 && c < 160) ? ZKI + 32 + (c - 128) : -1;
    return ZU + (pn - 11) * 256 + c;
}
template <bool WIN = false>
__device__ __forceinline__ void p0_transpose_item(const float* W, int K, int N, bf16* WT, LAS float* scr, int item, int nblk, int lane) {
    const int kb = item / nblk, nb = item % nblk, k0 = 64 * kb, n0 = 32 * nb;
    const int n_rd = WIN ? win_src_col(n0 + (lane & 31)) : ((n0 + (lane & 31)) < N ? n0 + (lane & 31) : -1);
    float rv[32];
#pragma unroll
    for (int i = 0; i < 32; ++i) { const int kk = 2 * i + (lane >> 5); rv[i] = n_rd >= 0 ? W[(size_t)(k0 + kk) * N + n_rd] : 0.f; }
#pragma unroll
    for (int i = 0; i < 32; ++i) { const int kk = 2 * i + (lane >> 5); scr[kk * 33 + (lane & 31)] = rv[i]; }
    LDS_WAIT();
    const int c = lane & 7;
#pragma unroll
    for (int j = 0; j < 4; ++j) { const int n = (lane >> 3) + 8 * j; const LAS float* s = scr + (8 * c) * 33 + n;
        v4u o; o.x = pk2(s[0 * 33], s[1 * 33]); o.y = pk2(s[2 * 33], s[3 * 33]); o.z = pk2(s[4 * 33], s[5 * 33]); o.w = pk2(s[6 * 33], s[7 * 33]);
        *(v4u*)(WT + (size_t)(n0 + n) * K + k0 + 8 * c) = o; }
    LDS_WAIT();
}
#ifndef CONV_IN_ATTN
#define CONV_IN_ATTN 1
#endif
constexpr int CV_OUT = 32 * 64, CV_UP = 32 * 256, CV_DN = 128 * 64, CV_N = CV_OUT + CV_UP + CV_DN;
__device__ __forceinline__ void conv_item(const Args& a, LAS float* scr, int it, int lane) {
    unsigned char* ws = a.ws;
    if (it < CV_OUT) { p0_transpose_item(a.in[12], DM, DM, (bf16*)(ws + WS_WOUT), scr, it, 64, lane); return; } it -= CV_OUT;
    if (it < CV_UP) { p0_transpose_item(a.in[14], DM, DFF, (bf16*)(ws + WS_WUP), scr, it, 256, lane); return; } it -= CV_UP;
    p0_transpose_item(a.in[15], DFF, DM, (bf16*)(ws + WS_WDN), scr, it, 64, lane);
}
__device__ __forceinline__ void p0_transpose_pair(const float* W, int K, int N, bf16* WT, LAS float* scrA, LAS float* scrB, int itemA, int itemB, int nblk, int lane) {
    const int k0a = 64 * (itemA / nblk), n0a = 32 * (itemA % nblk), k0b = 64 * (itemB / nblk), n0b = 32 * (itemB % nblk);
    const int na = n0a + (lane & 31), nb = n0b + (lane & 31);
    float ra[32], rb[32];
#pragma unroll
    for (int i = 0; i < 32; ++i) { const int kk = 2 * i + (lane >> 5); ra[i] = W[(size_t)(k0a + kk) * N + na]; rb[i] = W[(size_t)(k0b + kk) * N + nb]; }
#pragma unroll
    for (int i = 0; i < 32; ++i) { const int kk = 2 * i + (lane >> 5); scrA[kk * 33 + (lane & 31)] = ra[i]; scrB[kk * 33 + (lane & 31)] = rb[i]; }
    LDS_WAIT();
    const int c = lane & 7;
#pragma unroll
    for (int j = 0; j < 4; ++j) { const int n = (lane >> 3) + 8 * j; const LAS float* sa = scrA + (8 * c) * 33 + n; const LAS float* sb = scrB + (8 * c) * 33 + n;
        v4u o; o.x = pk2(sa[0 * 33], sa[1 * 33]); o.y = pk2(sa[2 * 33], sa[3 * 33]); o.z = pk2(sa[4 * 33], sa[5 * 33]); o.w = pk2(sa[6 * 33], sa[7 * 33]);
        *(v4u*)(WT + (size_t)(n0a + n) * K + k0a + 8 * c) = o;
        v4u q; q.x = pk2(sb[0 * 33], sb[1 * 33]); q.y = pk2(sb[2 * 33], sb[3 * 33]); q.z = pk2(sb[4 * 33], sb[5 * 33]); q.w = pk2(sb[6 * 33], sb[7 * 33]);
        *(v4u*)(WT + (size_t)(n0b + n) * K + k0b + 8 * c) = q; }
    LDS_WAIT();
}
__device__ __forceinline__ void conv_pair(const Args& a, LAS float* scrA, LAS float* scrB, int itA, int itB, int lane) {
    unsigned char* ws = a.ws;
    if (itB < CV_OUT) { p0_transpose_pair(a.in[12], DM, DM, (bf16*)(ws + WS_WOUT), scrA, scrB, itA, itB, 64, lane); return; }
    if (itA >= CV_OUT && itB < CV_OUT + CV_UP) { p0_transpose_pair(a.in[14], DM, DFF, (bf16*)(ws + WS_WUP), scrA, scrB, itA - CV_OUT, itB - CV_OUT, 256, lane); return; }
    if (itA >= CV_OUT + CV_UP) { p0_transpose_pair(a.in[15], DFF, DM, (bf16*)(ws + WS_WDN), scrA, scrB, itA - CV_OUT - CV_UP, itB - CV_OUT - CV_UP, 64, lane); return; }
    conv_item(a, scrA, itA, lane); conv_item(a, scrA, itB, lane);
}
__device__ __forceinline__ void rms_row_to_bf16(const float* xrow, const float* gain, bf16* orow, int lane) {
    const f32x4* xr = (const f32x4*)xrow + lane; const f32x4* gr = (const f32x4*)gain + lane;
    f32x4 v[8]; float s = 0.f;
#pragma unroll
    for (int j = 0; j < 8; ++j) { v[j] = xr[64 * j]; s += (v[j].x * v[j].x + v[j].y * v[j].y) + (v[j].z * v[j].z + v[j].w * v[j].w); }
    const float rstd = 1.f / sqrtf(wave_sum(s) * (1.f / DM) + EPS);
    unsigned long long* o8 = (unsigned long long*)orow + lane;
#pragma unroll
    for (int j = 0; j < 8; ++j) { const f32x4 g = gr[64 * j]; o8[64 * j] = (unsigned long long)pk2(v[j].x * rstd * g.x, v[j].y * rstd * g.y) | ((unsigned long long)pk2(v[j].z * rstd * g.z, v[j].w * rstd * g.w) << 32); }
}
__device__ __forceinline__ void rope_cs(int pos, int j, float& c, float& s) {
    const double x = (double)pos * INV_FREQ[j];
    const double n = __builtin_rint(x * 0.15915494309189535);
    const double r = __builtin_fma(-n, 6.283185307179586, x);
    const float rf = (float)r; c = cosf(rf); s = sinf(rf);
}
__device__ __forceinline__ void p0_prep(const Args& a, LAS unsigned char* lds, int gw, int NGW, int wave, int lane) {
    LAS float* scr = (LAS float*)(lds + wave * 16384);
    unsigned char* ws = a.ws;
    constexpr int I_IN = 32 * 120, I_PL = 4 * 32;
    for (int it = gw; it < I_IN + I_PL + (CONV_IN_ATTN ? 0 : CV_N); it += NGW) {
        if (it < I_IN) p0_transpose_item<true>(a.in[9], DM, NZR, (bf16*)(ws + WS_WIN), scr, it, 120, lane);
        else if (it < I_IN + I_PL) { const int r = it - I_IN, g = r >> 5; p0_transpose_item(a.in[10] + (size_t)g * 65536, 256, 256, (bf16*)(ws + WS_WPOOL) + (size_t)g * 65536, scr, r & 31, 8, lane); }
        else conv_item(a, scr, it - I_IN - I_PL, lane);
    }
    bf16* XN = (bf16*)(ws + WS_XN);
    for (int m = gw; m < MP; m += NGW) {
        const float* xr = in_row(a, m);
        if (xr) rms_row_to_bf16(xr, a.in[8], XN + (size_t)m * DM, lane);
        else { v4u z = {0u, 0u, 0u, 0u}; v4u* o = (v4u*)(XN + (size_t)m * DM) + lane;
#pragma unroll
            for (int j = 0; j < 4; ++j) o[64 * j] = z; }
    }
    float* CS = (float*)(ws + WS_CS);
    for (int pos = gw; pos < TP; pos += NGW) { float c1, s1; rope_cs(pos, lane, c1, s1); CS[(size_t)pos * 192 + lane] = c1; CS[(size_t)pos * 192 + 64 + lane] = s1;
        if (lane < 32) { float c2, s2; rope_cs(pos, 2 * lane, c2, s2); CS[(size_t)pos * 192 + 128 + lane] = c2; CS[(size_t)pos * 192 + 160 + lane] = s2; } }
    for (int i = gw * 64 + lane; i < DB * 14 * 256; i += NGW * 64) { const int b = i / (14 * 256), rem = i % (14 * 256);
        *((f32x4*)(a.out + O_PS + (size_t)b * 15 * 1024) + rem) = *((const f32x4*)(a.in[5] + ((size_t)b * 15 + 1) * 1024) + rem); }
}

namespace pg8 {
struct EpiIn {
    static constexpr bool PERM = true, AFTER_DRAIN = false;
    float* out; unsigned char* ws;
    __device__ __forceinline__ void operator()(const f32x4 (&acc)[2][2][4][2], const Unit& u, int wr, int wc, int fr, int fq) const {
        constexpr float QSCALE = 0.12751743074602957f;
        typedef _Float16 f16x8v __attribute__((ext_vector_type(8)));
        const float* CS = (const float*)(ws + WS_CS);
        const int pn = u.pn;
        const int c0 = 32 * wc + 8 * fq;
#pragma unroll
        for (int ai = 0; ai < 2; ++ai)
#pragma unroll
            for (int m = 0; m < 4; ++m) {
                const int r = u.pm * BM + ai * HALF + wr * 64 + m * 16 + fr;
                if (r >= MR) continue;
                const bool smp = r >= TP; const int b = r - TP; const float* cs = CS + (size_t)(smp ? PAST : r) * 192;
                if (pn < 5) {
                    const int hd = c0 >> 6, j0 = c0 & 63;
                    f32x4 o1[2], o2[2];
#pragma unroll
                    for (int n = 0; n < 2; ++n) { const f32x4 co = *(const f32x4*)(cs + j0 + 4 * n), si = *(const f32x4*)(cs + 64 + j0 + 4 * n), x1 = acc[ai][0][m][n], x2 = acc[ai][1][m][n];
                        o1[n] = x1 * co - x2 * si; o2[n] = x1 * si + x2 * co; }
                    if (pn < 4) { ::bf16* q = (::bf16*)(ws + WS_QB) + (size_t)r * 1024 + (2 * pn + hd) * 128 + j0;
                        v4u a_, b_; a_.x = pk2(o1[0].x * QSCALE, o1[0].y * QSCALE); a_.y = pk2(o1[0].z * QSCALE, o1[0].w * QSCALE); a_.z = pk2(o1[1].x * QSCALE, o1[1].y * QSCALE); a_.w = pk2(o1[1].z * QSCALE, o1[1].w * QSCALE);
                        b_.x = pk2(o2[0].x * QSCALE, o2[0].y * QSCALE); b_.y = pk2(o2[0].z * QSCALE, o2[0].w * QSCALE); b_.z = pk2(o2[1].x * QSCALE, o2[1].y * QSCALE); b_.w = pk2(o2[1].z * QSCALE, o2[1].w * QSCALE);
                        *(v4u*)q = a_; *(v4u*)(q + 64) = b_; }
                    else { float* ko = (smp ? out + O_KS + (size_t)b * 256 : out + O_KP + (size_t)r * 256) + hd * 128 + j0;
                        *(f32x4*)ko = o1[0]; *(f32x4*)(ko + 4) = o1[1]; *(f32x4*)(ko + 64) = o2[0]; *(f32x4*)(ko + 68) = o2[1];
                        ::bf16* kb = (::bf16*)(ws + WS_KB) + (size_t)r * 256 + hd * 128 + j0;
                        v4u a_, b_; a_.x = pk2(o1[0].x, o1[0].y); a_.y = pk2(o1[0].z, o1[0].w); a_.z = pk2(o1[1].x, o1[1].y); a_.w = pk2(o1[1].z, o1[1].w);
                        b_.x = pk2(o2[0].x, o2[0].y); b_.y = pk2(o2[0].z, o2[0].w); b_.z = pk2(o2[1].x, o2[1].y); b_.w = pk2(o2[1].z, o2[1].w);
                        *(v4u*)kb = a_; *(v4u*)(kb + 64) = b_; }
                } else if (pn == 5) {
#pragma unroll
                    for (int bj = 0; bj < 2; ++bj) { const int c = 128 * bj + c0; const f32x4 v0 = acc[ai][bj][m][0], v1 = acc[ai][bj][m][1];
                        float* vo = (smp ? out + O_VS + (size_t)b * 256 : out + O_VP + (size_t)r * 256) + c; *(f32x4*)vo = v0; *(f32x4*)(vo + 4) = v1;
                        v4u a_; a_.x = pk2(v0.x, v0.y); a_.y = pk2(v0.z, v0.w); a_.z = pk2(v1.x, v1.y); a_.w = pk2(v1.z, v1.w);
                        *(v4u*)((::bf16*)(ws + WS_VB) + (size_t)r * 256 + c) = a_; }
                } else if (pn < 10) {
                    const int hd = 4 * (pn - 6) + (c0 >> 5), j0 = c0 & 31;
                    f32x4 o1[2], o2[2];
#pragma unroll
                    for (int n = 0; n < 2; ++n) { const f32x4 co = *(const f32x4*)(cs + 128 + j0 + 4 * n), si = *(const f32x4*)(cs + 160 + j0 + 4 * n), x1 = acc[ai][0][m][n], x2 = acc[ai][1][m][n];
                        o1[n] = x1 * co - x2 * si; o2[n] = x1 * si + x2 * co; }
                    f16* qi = (f16*)(ws + WS_QI) + (size_t)r * 1024 + hd * 64 + j0;
                    *(f16x8v*)qi = (f16x8v){(f16)o1[0].x, (f16)o1[0].y, (f16)o1[0].z, (f16)o1[0].w, (f16)o1[1].x, (f16)o1[1].y, (f16)o1[1].z, (f16)o1[1].w};
                    *(f16x8v*)(qi + 32) = (f16x8v){(f16)o2[0].x, (f16)o2[0].y, (f16)o2[0].z, (f16)o2[0].w, (f16)o2[1].x, (f16)o2[1].y, (f16)o2[1].z, (f16)o2[1].w};
                    if (smp) { float* q32 = (float*)(ws + WS_QI32) + (size_t)b * 1024 + hd * 64 + j0; *(f32x4*)q32 = o1[0]; *(f32x4*)(q32 + 4) = o1[1]; *(f32x4*)(q32 + 32) = o2[0]; *(f32x4*)(q32 + 36) = o2[1]; }
                } else if (pn == 10) {
                    if (wc == 0) { const int j0 = c0;
                        f32x4 o1[2], o2[2];
#pragma unroll
                        for (int n = 0; n < 2; ++n) { const f32x4 co = *(const f32x4*)(cs + 128 + j0 + 4 * n), si = *(const f32x4*)(cs + 160 + j0 + 4 * n), x1 = acc[ai][0][m][n], x2 = acc[ai][1][m][n];
                            o1[n] = x1 * co - x2 * si; o2[n] = x1 * si + x2 * co; }
                        float* kio = (smp ? out + O_KIS + (size_t)b * 64 : out + O_KIP + (size_t)r * 64) + j0; *(f32x4*)kio = o1[0]; *(f32x4*)(kio + 4) = o1[1]; *(f32x4*)(kio + 32) = o2[0]; *(f32x4*)(kio + 36) = o2[1];
                        f16* ki = (f16*)(ws + WS_KI) + (size_t)r * 64 + j0;
                        *(f16x8v*)ki = (f16x8v){(f16)o1[0].x, (f16)o1[0].y, (f16)o1[0].z, (f16)o1[0].w, (f16)o1[1].x, (f16)o1[1].y, (f16)o1[1].z, (f16)o1[1].w};
                        *(f16x8v*)(ki + 32) = (f16x8v){(f16)o2[0].x, (f16)o2[0].y, (f16)o2[0].z, (f16)o2[0].w, (f16)o2[1].x, (f16)o2[1].y, (f16)o2[1].z, (f16)o2[1].w};
                    } else if (wc == 1 && fq < 2) { float* wo = (float*)(ws + WS_WI) + (size_t)r * 16 + 8 * fq; *(f32x4*)wo = acc[ai][0][m][0] * 0.25f; *(f32x4*)(wo + 4) = acc[ai][0][m][1] * 0.25f; }
                } else {
#pragma unroll
                    for (int bj = 0; bj < 2; ++bj) { const int c = (pn - 11) * 256 + 128 * bj + c0; const f32x4 v0 = acc[ai][bj][m][0], v1 = acc[ai][bj][m][1];
                        float* uo = (float*)(ws + WS_U) + (size_t)r * 1024 + c; *(f32x4*)uo = v0; *(f32x4*)(uo + 4) = v1;
                        if (!smp && r >= TP - 15) { float* po = out + O_PP + (size_t)(r - (TP - 15)) * 1024 + c; *(f32x4*)po = v0; *(f32x4*)(po + 4) = v1; }
                        if (smp) { float* po = out + O_PS + ((size_t)b * 15 + 14) * 1024 + c; *(f32x4*)po = v0; *(f32x4*)(po + 4) = v1; } }
                }
            }
    }
};
template <bool RBF> struct EpiResB {
    static constexpr bool PERM = true, AFTER_DRAIN = false;
    bf16_t* C; const void* R;
    __device__ __forceinline__ void operator()(const f32x4 (&acc)[2][2][4][2], const Unit& u, int wr, int wc, int fr, int fq) const {
        const int row0 = u.pm * BM + wr * 64 + fr, col0 = u.pn * BM + wc * 32 + 8 * fq;
#pragma unroll
        for (int ai = 0; ai < 2; ++ai)
#pragma unroll
            for (int m = 0; m < 4; ++m) { const size_t off = (size_t)(row0 + ai * HALF + m * 16) * 2048 + col0;
#pragma unroll
                for (int bj = 0; bj < 2; ++bj) { f32x4 r0, r1;
                    if (RBF) { const u32x4 rb = *(const u32x4*)((const bf16_t*)R + off + bj * HALF);
                        r0 = (f32x4){__builtin_bit_cast(float, rb.x << 16), __builtin_bit_cast(float, rb.x & 0xffff0000u), __builtin_bit_cast(float, rb.y << 16), __builtin_bit_cast(float, rb.y & 0xffff0000u)};
                        r1 = (f32x4){__builtin_bit_cast(float, rb.z << 16), __builtin_bit_cast(float, rb.z & 0xffff0000u), __builtin_bit_cast(float, rb.w << 16), __builtin_bit_cast(float, rb.w & 0xffff0000u)}; }
                    else { r0 = *(const f32x4*)((const float*)R + off + bj * HALF); r1 = *(const f32x4*)((const float*)R + off + bj * HALF + 4); }
                    const f32x4 h0 = acc[ai][bj][m][0] + r0, h1 = acc[ai][bj][m][1] + r1;
                    u32x4 w; w.x = cvt_pk_bf16(h0[0], h0[1]); w.y = cvt_pk_bf16(h0[2], h0[3]); w.z = cvt_pk_bf16(h1[0], h1[1]); w.w = cvt_pk_bf16(h1[2], h1[3]);
                    *(u32x4*)(C + off + bj * HALF) = w; } }
    }
};
}

template <int PMODE = 0> __device__ __forceinline__ void p3_indexer_prompt(const Args& a, LAS unsigned char* lds, int bid, int G, int tid, int wave, int lane, bool dostore = true) {
    unsigned char* ws = a.ws;
    const f16* QI = (const f16*)(ws + WS_QI); const f16* KI = (const f16*)(ws + WS_KI); const float* WI = (const float*)(ws + WS_WI); float* SC = (float*)(ws + WS_SC);
    const int r = lane & 31, hh = lane >> 5;
    constexpr int WOFF = 18 * 4096;
    constexpr int CB = 20, T = 129 * 129 + 257 * CB;
    const int lo = (int)((long)bid * T / G), hi = (int)((long)(bid + 1) * T / G);
    int q = 0, P = 0;
    while (P + CB + (q >> 1) + 1 <= lo) { P += CB + (q >> 1) + 1; ++q; }
    for (; q <= 256 && P < hi; P += CB + (q >> 1) + 1, ++q) {
        const int t0 = q * 32; const int nkb = (q >> 1) + 1;
        const int kb_lo = lo - (P + CB) > 0 ? lo - (P + CB) : 0; const int kb_end = hi - (P + CB) < nkb ? hi - (P + CB) : nkb;
        if (kb_lo >= kb_end) continue;
        {
            __syncthreads();
            int tidv = tid; asm volatile("" : "+v"(tidv));
#pragma unroll
            for (int i = 0; i < 8; ++i) { const int rr = tidv & 31, c = 2 * (8 * i + (tidv >> 6)) + ((tidv >> 5) & 1);
                const v4u v = *(const v4u*)(QI + (size_t)(t0 + rr) * 1024 + c * 8);
                *(LAS v4u*)(lds + (c * 32 + rr) * 16) = v; }
            { const float wx = WI[(size_t)(t0 + (tidv & 31)) * 16 + (tidv >> 5)]; *(LAS float*)(lds + WOFF + ((tidv >> 5) * 32 + (tidv & 31)) * 4) = wx * 0.0625f; }
            __syncthreads();
            {
                const int rr = tidv & 31, dg = tidv >> 5; const int ks = dg >> 2, h2 = (dg >> 1) & 1, e0 = (dg & 1) * 4;
                float qa[4] = {0.f, 0.f, 0.f, 0.f};
#pragma unroll 4
                for (int h = 0; h < 16; ++h) { const float wh = *(const LAS float*)(lds + WOFF + (h * 32 + rr) * 4);
                    typedef _Float16 f16x4 __attribute__((ext_vector_type(4)));
                    const f16x4 qv = *(const LAS f16x4*)(lds + ((((h * 4 + ks) * 2 + h2) * 32) + rr) * 16 + e0 * 2);
                    qa[0] = fmaf(wh, (float)qv[0], qa[0]); qa[1] = fmaf(wh, (float)qv[1], qa[1]); qa[2] = fmaf(wh, (float)qv[2], qa[2]); qa[3] = fmaf(wh, (float)qv[3], qa[3]); }
                typedef _Float16 f16x4 __attribute__((ext_vector_type(4)));
                f16x4 hi, lo;
#pragma unroll
                for (int e = 0; e < 4; ++e) { hi[e] = (f16)qa[e]; lo[e] = (f16)(qa[e] - (float)hi[e]); }
                *(LAS f16x4*)(lds + ((((16 * 4 + ks) * 2 + h2) * 32) + rr) * 16 + e0 * 2) = hi;
                *(LAS f16x4*)(lds + ((((17 * 4 + ks) * 2 + h2) * 32) + rr) * 16 + e0 * 2) = lo;
            }
            __syncthreads();
            f16x8 afn[2][4];
            if (kb_lo + wave < kb_end) {
#pragma unroll
                for (int blk = 0; blk < 2; ++blk)
#pragma unroll
                    for (int ks = 0; ks < 4; ++ks) afn[blk][ks] = *(const f16x8*)(KI + (size_t)((kb_lo + wave) * 64 + blk * 32 + r) * 64 + ks * 16 + hh * 8); }
            for (int kb = kb_lo + wave; kb < kb_end; kb += 8) {
                const int s0 = kb * 64;
                f16x8 af[2][4];
#pragma unroll
                for (int blk = 0; blk < 2; ++blk)
#pragma unroll
                    for (int ks = 0; ks < 4; ++ks) af[blk][ks] = afn[blk][ks];
                if (kb + 8 < kb_end) {
#pragma unroll
                    for (int blk = 0; blk < 2; ++blk)
#pragma unroll
                        for (int ks = 0; ks < 4; ++ks) afn[blk][ks] = *(const f16x8*)(KI + (size_t)(s0 + 512 + blk * 32 + r) * 64 + ks * 16 + hh * 8); }
                float sa0[16], sa1[16];
#pragma unroll
                for (int i = 0; i < 16; ++i) { sa0[i] = 0.f; sa1[i] = 0.f; }
#define IDX_FRAG(h, ks) (*(const LAS f16x8*)(lds + (((((h) * 4 + (ks)) * 2 + hh) * 32) + r) * 16))
#define IDX_W(h) (*(const LAS float*)(lds + WOFF + ((h) * 32 + r) * 4))
#define IDX_STEP(m, D0, D1, Bc, P0, P1, Bn, DOVALU, DOLOAD, WCUR, WNXT) do { const float wP_ = WCUR; \
        WNXT = IDX_W(m);                                      \
        __builtin_amdgcn_sched_barrier(0); \
        if (DOLOAD && PMODE != 2) { _Pragma("unroll") for (int ks = 0; ks < 4; ++ks) Bn[ks] = IDX_FRAG((m) + 1, ks); } \
        _Pragma("unroll") for (int ks = 0; ks < 4; ++ks) { \
            if (PMODE != 4) { \
            if (ks == 0) { D0 = __builtin_amdgcn_mfma_f32_32x32x16_f16(af[0][0], Bc[0], (f32x16){}, 0, 0, 0); D1 = __builtin_amdgcn_mfma_f32_32x32x16_f16(af[1][0], Bc[0], (f32x16){}, 0, 0, 0); } \
            else { D0 = __builtin_amdgcn_mfma_f32_32x32x16_f16(af[0][ks], Bc[ks], D0, 0, 0, 0); D1 = __builtin_amdgcn_mfma_f32_32x32x16_f16(af[1][ks], Bc[ks], D1, 0, 0, 0); } } \
            else if (ks == 0) { _Pragma("unroll") for (int i_ = 0; i_ < 16; ++i_) { D0[i_] = (float)Bc[0][0] * (float)i_; D1[i_] = D0[i_]; } } \
            __builtin_amdgcn_sched_barrier(0); \
            if (DOVALU && PMODE != 1) { if (ks == 0) asm volatile("s_nop 7" : "+v"(P0), "+v"(P1)); \
                _Pragma("unroll") for (int i = 4 * ks; i < 4 * ks + 4; ++i) { if (PMODE == 3) { asm volatile("v_fma_f32 %0, %1, |%1|, %0" : "+v"(sa0[i]) : "v"(wP_)); asm volatile("v_fma_f32 %0, %1, |%1|, %0" : "+v"(sa1[i]) : "v"(wP_)); } else { \
                    asm volatile("v_fma_f32 %0, %1, |%2|, %0" : "+v"(sa0[(i + 1) & 15]) : "v"(wP_), "v"(P0[i])); asm volatile("v_fma_f32 %0, %1, |%2|, %0" : "+v"(sa1[(i + 1) & 15]) : "v"(wP_), "v"(P1[i])); } } } \
            __builtin_amdgcn_sched_barrier(0); } } while (0)
                {
                    f16x8 bA[4], bB[4]; f32x16 dA0, dA1, dB0, dB1;
#pragma unroll
                    for (int ks = 0; ks < 4; ++ks) { bA[ks] = IDX_FRAG(0, ks); if (PMODE == 2) bB[ks] = IDX_FRAG(1, ks); }
                    float wA = 0.f, wB = 0.f;
                    IDX_STEP(0, dA0, dA1, bA, dB0, dB1, bB, false, true, wB, wA);
#pragma unroll 1
                    for (int m = 1; m < 15; m += 2) {
                        IDX_STEP(m, dB0, dB1, bB, dA0, dA1, bA, true, true, wA, wB);
                        IDX_STEP(m + 1, dA0, dA1, bA, dB0, dB1, bB, true, true, wB, wA);
                    }
                    IDX_STEP(15, dB0, dB1, bB, dA0, dA1, bA, true, false, wA, wB);
                    { const float wP_ = wB; asm volatile("s_nop 15" : "+v"(dB0), "+v"(dB1));
#pragma unroll
                      for (int i = 0; i < 16; ++i) { asm volatile("v_fma_f32 %0, %1, |%2|, %0" : "+v"(sa0[(i + 1) & 15]) : "v"(wP_), "v"(dB0[i])); asm volatile("v_fma_f32 %0, %1, |%2|, %0" : "+v"(sa1[(i + 1) & 15]) : "v"(wP_), "v"(dB1[i])); } }
                }
#undef IDX_STEP
                f32x16 sc0, sc1;
#pragma unroll
                for (int i = 0; i < 16; ++i) { sc0[i] = sa0[(i + 1) & 15]; sc1[i] = sa1[(i + 1) & 15]; }
#pragma unroll
                for (int h = 16; h < 18; ++h)
#pragma unroll
                    for (int ks = 0; ks < 4; ++ks) { const f16x8 bfr = IDX_FRAG(h, ks);
                        sc0 = __builtin_amdgcn_mfma_f32_32x32x16_f16(af[0][ks], bfr, sc0, 0, 0, 0); sc1 = __builtin_amdgcn_mfma_f32_32x32x16_f16(af[1][ks], bfr, sc1, 0, 0, 0); }
#undef IDX_FRAG
#undef IDX_W
                float* row = SC + (size_t)(t0 + r) * SCLD + s0 + 4 * hh;
                if (!dostore) { if (sc0[0] + sc1[3] != 12345.678f) continue; }
                if (s0 + 63 > t0) {
                    const int tq = t0 + r;
#pragma unroll
                    for (int i = 0; i < 16; ++i) { const int sk = s0 + (i & 3) + 8 * (i >> 2) + 4 * hh; if (sk > tq) sc0[i] = -INFINITY; if (sk + 32 > tq) sc1[i] = -INFINITY; } }
#pragma unroll
                for (int q4 = 0; q4 < 4; ++q4) {
                    *(f32x4*)(row + 8 * q4) = (f32x4){sc0[4 * q4], sc0[4 * q4 + 1], sc0[4 * q4 + 2], sc0[4 * q4 + 3]};
                    *(f32x4*)(row + 32 + 8 * q4) = (f32x4){sc1[4 * q4], sc1[4 * q4 + 1], sc1[4 * q4 + 2], sc1[4 * q4 + 3]}; }
                if (kb == nkb - 1) {
                    const int pend = ((t0 + 32 + 255) >> 8) << 8; float* prow = SC + (size_t)(t0 + r) * SCLD;
                    for (int sp = 64 * nkb + 4 * hh; sp < pend; sp += 8) *(f32x4*)(prow + sp) = (f32x4){-INFINITY, -INFINITY, -INFINITY, -INFINITY}; }
            }
        }
    }
}
__device__ __forceinline__ void p3_indexer_sample(const Args& a, LAS unsigned char* lds, int gw, int NGW, int wave, int lane) {
    unsigned char* ws = a.ws;
    const float* QI32 = (const float*)(ws + WS_QI32); const float* WI = (const float*)(ws + WS_WI); float* SCS = (float*)(ws + WS_SCS);
    const float* ckidx = a.in[4]; const int* pt = (const int*)a.in[6];
    LAS float* lq = (LAS float*)(lds + wave * 4096);
    for (int it = gw; it < DB * 17; it += NGW) {
        const int b = it / 17, p = it % 17;
        const float* w = WI + (size_t)(TP + b) * 16;
        const bool newk = p == 16;
        const float* kr0 = newk ? a.out + O_KIS + (size_t)b * IDD : ckidx + ((size_t)pt[b * NPAGES + p] * PAGE + lane) * IDD;
        const float* kr1 = newk ? kr0 : kr0 + 64 * IDD;
        f32x4 k0[16], k1[16];
#pragma unroll
        for (int j = 0; j < 16; ++j) { k0[j] = *((const f32x4*)kr0 + j); k1[j] = *((const f32x4*)kr1 + j); }
#pragma unroll
        for (int j = 0; j < 4; ++j) *((LAS f32x4*)lq + lane + 64 * j) = *((const f32x4*)(QI32 + (size_t)b * 1024) + lane + 64 * j);
        LDS_WAIT();
        float s0 = 0.f, s1 = 0.f;
#pragma unroll 1
        for (int h = 0; h < 16; ++h) { float d0 = 0.f, d1 = 0.f;
#pragma unroll
            for (int j = 0; j < 16; ++j) { const f32x4 q4 = *((const LAS f32x4*)(lq + h * 64) + j);
                d0 = fmaf(q4.x, k0[j].x, d0); d0 = fmaf(q4.y, k0[j].y, d0); d0 = fmaf(q4.z, k0[j].z, d0); d0 = fmaf(q4.w, k0[j].w, d0);
                d1 = fmaf(q4.x, k1[j].x, d1); d1 = fmaf(q4.y, k1[j].y, d1); d1 = fmaf(q4.z, k1[j].z, d1); d1 = fmaf(q4.w, k1[j].w, d1); }
            const float wh = w[h]; s0 += wh * fmaxf(d0, 0.f); s1 += wh * fmaxf(d1, 0.f); }
        if (!newk) { SCS[(size_t)b * SCSLD + p * PAGE + lane] = s0 * 0.125f; SCS[(size_t)b * SCSLD + p * PAGE + 64 + lane] = s1 * 0.125f; }
        else { if (lane == 0) SCS[(size_t)b * SCSLD + PAST] = s0 * 0.125f; for (int sp = LS + lane; sp < SCSLD; sp += 64) SCS[(size_t)b * SCSLD + sp] = -INFINITY; }
        LDS_WAIT();
    }
}

__device__ __forceinline__ unsigned tokey(float x) { const unsigned u = __builtin_bit_cast(unsigned, x); return u ^ (((unsigned)((int)u >> 31)) | 0x80000000u); }
__device__ __forceinline__ void hist_find(LAS unsigned* hist, int need, int lane, unsigned& digit, unsigned& above, unsigned& inbin) {
    unsigned tot = 0u;
#pragma unroll 8
    for (int j = 0; j < 32; ++j) tot += hist[32 * lane + j];
    unsigned s = tot;
#pragma unroll
    for (int o = 1; o < 64; o <<= 1) { const unsigned t = __shfl_down(s, o); if (lane + o < 64) s += t; }
    const unsigned s_excl = s - tot;
    const bool found = (s_excl < (unsigned)need) && ((unsigned)need <= s);
    const unsigned long long bal = __ballot(found);
    const int L = bal ? (int)__builtin_ctzll(bal) : 0;
    const unsigned sxL = __shfl(s_excl, L);
    const unsigned hb = lane < 32 ? hist[32 * L + lane] : 0u;
    unsigned s2 = hb;
#pragma unroll
    for (int o = 1; o < 32; o <<= 1) { const unsigned t = __shfl_down(s2, o); if (lane + o < 32) s2 += t; }
    const unsigned tot2 = sxL + s2, ex2 = tot2 - hb;
    const bool f2 = lane < 32 && ex2 < (unsigned)need && (unsigned)need <= tot2;
    const unsigned long long b2 = __ballot(f2);
    const int L2 = b2 ? (int)__builtin_ctzll(b2) : 0;
    digit = 32u * L + L2; above = __shfl(ex2, L2); inbin = __shfl(hb, L2);
}
constexpr int KB0 = 22785;
__device__ __forceinline__ int coarse_bin(unsigned k) { const int v = (int)(k >> 17) - KB0; return v < 0 ? 0 : (v > 2047 ? 2047 : v); }
#define TOPK_LOAD(v, base) do { _Pragma("unroll") for (int j = 0; j < 8; ++j) { v[j] = (f32x4){0.f, 0.f, 0.f, 0.f}; if ((base) + 256 * j < n) v[j] = *(const f32x4*)(row + (base) + 256 * j + 4 * lane); } } while (0)
__device__ __forceinline__ void topk_row(const float* row, int n, int* sel, LAS unsigned* hist, int lane) {
    if (n <= TOPK) { for (int i = lane; i < TOPK; i += 64) sel[i] = i < n ? i : 0; return; }
    int need = TOPK; unsigned digit, above, inbin;
    for (int i = lane; i < 2048; i += 64) hist[i] = 0u;
    LDS_WAIT();
    unsigned cnt0 = 0u;
    f32x4 vn[8]; TOPK_LOAD(vn, 0);
#pragma unroll 1
    for (int base = 0; base < n; base += 2048) { f32x4 v[8];
#pragma unroll
        for (int j = 0; j < 8; ++j) v[j] = vn[j];
        if (base + 2048 < n) TOPK_LOAD(vn, base + 2048);
#pragma unroll
        for (int j = 0; j < 8; ++j) if (base + 256 * j < n) {
#pragma unroll
            for (int e = 0; e < 4; ++e) { const int cb = coarse_bin(tokey(v[j][e]));
                if (cb != 0) __hip_atomic_fetch_add(hist + cb, 1u, __ATOMIC_RELAXED, __HIP_MEMORY_SCOPE_WORKGROUP); else ++cnt0; } } }
    { unsigned c0 = cnt0;
#pragma unroll
      for (int o = 1; o < 64; o <<= 1) c0 += __shfl_xor(c0, o);
      if (lane == 0) hist[0] = c0; }
    TOPK_LOAD(vn, 0);
    LDS_WAIT();
    hist_find(hist, need, lane, digit, above, inbin); need -= (int)above;
    const int b1 = (int)digit;
    const unsigned klo = b1 == 0 ? 0u : ((unsigned)(KB0 + b1)) << 17;
    const unsigned kspan = b1 == 0 ? ((unsigned)(KB0 + 1)) << 17 : (b1 == 2047 ? 0u - klo : 1u << 17);
    const bool fast = inbin <= 64u; const int m = (int)inbin;
    LDS_WAIT();
    unsigned thr = 0u; int need_eq = 0; bool ties = false;
    if (!fast) {
        unsigned prefix = 0u; int toteq = 0;
#pragma unroll 1
        for (int pass = 0; pass < 3; ++pass) {
            const int shift = pass == 0 ? 21 : pass == 1 ? 10 : 0; const unsigned mask = pass == 2 ? 1023u : 2047u; const int pshift = pass == 1 ? 21 : 10;
            for (int i = lane; i < 2048; i += 64) hist[i] = 0u;
            LDS_WAIT();
#pragma unroll 1
            for (int base = 0; base < n; base += 2048) { f32x4 v[8];
#pragma unroll
                for (int j = 0; j < 8; ++j) v[j] = vn[j];
                TOPK_LOAD(vn, (base + 2048 < n) ? base + 2048 : 0);
#pragma unroll
                for (int j = 0; j < 8; ++j) if (base + 256 * j < n)
#pragma unroll
                    for (int e = 0; e < 4; ++e) { const unsigned k = tokey(v[j][e]);
                        if (k >= klo && (k - klo) < kspan && (pass == 0 || (k >> pshift) == prefix)) __hip_atomic_fetch_add(hist + ((k >> shift) & mask), 1u, __ATOMIC_RELAXED, __HIP_MEMORY_SCOPE_WORKGROUP); } }
            LDS_WAIT();
            hist_find(hist, need, lane, digit, above, inbin);
            need -= (int)above; toteq = (int)inbin;
            prefix = pass == 2 ? ((prefix << 10) | digit) : ((prefix << 11) | digit);
            LDS_WAIT();
        }
        thr = prefix; need_eq = need; ties = toteq != need_eq;
    }
    LAS unsigned* lkey = hist; LAS unsigned* lidx = hist + 64; LAS unsigned* lcnt = hist + 128;
    if (lane == 0) *lcnt = 0u;
    LDS_WAIT();
    const unsigned long long lt = (1ull << lane) - 1ull;
    int outbase = fast ? need : 0, eqtaken = 0;
#pragma unroll 1
    for (int base = 0; base < n; base += 2048) { f32x4 v[8];
#pragma unroll
        for (int j = 0; j < 8; ++j) v[j] = vn[j];
        if (base + 2048 < n) TOPK_LOAD(vn, base + 2048);
        unsigned mask = 0u;
#pragma unroll
        for (int j = 0; j < 8; ++j) if (base + 256 * j < n) {
            unsigned kk[4]; bool eq[4];
#pragma unroll
            for (int e = 0; e < 4; ++e) { const int idx = base + 256 * j + 4 * lane + e; const bool valid = true; kk[e] = tokey(v[j][e]); eq[e] = false; bool take;
                if (fast) { const bool inr = valid && kk[e] >= klo; const unsigned dk = kk[e] - klo; take = inr && dk >= kspan;
                    if (inr && dk < kspan) { const unsigned p_ = __hip_atomic_fetch_add(lcnt, 1u, __ATOMIC_RELAXED, __HIP_MEMORY_SCOPE_WORKGROUP); if (p_ < 64u) { lkey[p_] = kk[e]; lidx[p_] = (unsigned)idx; } } }
                else { take = valid && (kk[e] > thr || (kk[e] == thr && !ties)); eq[e] = valid && ties && kk[e] == thr; }
                mask |= take ? (1u << (4 * j + e)) : 0u; }
            if (!fast && ties) {
                int lower = 0, tot = 0, own = 0;
#pragma unroll
                for (int e = 0; e < 4; ++e) { const unsigned long long be = __ballot(eq[e]); lower += __builtin_popcountll(be & lt); tot += __builtin_popcountll(be); }
#pragma unroll
                for (int e = 0; e < 4; ++e) { if (eq[e]) { if (eqtaken + lower + own < need_eq) mask |= 1u << (4 * j + e); ++own; } }
                eqtaken += tot; }
        }
        const int cnt = __builtin_popcount(mask);
        int pre = cnt;
#pragma unroll
        for (int o = 1; o < 64; o <<= 1) { const int t = __shfl_up(pre, o); if (lane >= o) pre += t; }
        int pos = outbase + pre - cnt; outbase += __shfl(pre, 63);
        while (mask) { const int bpos = __builtin_ctz(mask); mask &= mask - 1u; if (pos < TOPK) sel[pos] = base + 256 * (bpos >> 2) + 4 * lane + (bpos & 3); ++pos; }
    }
    if (fast) {
        LDS_WAIT();
        const unsigned mykey = lane < m ? lkey[lane] : 0u; const int myidx = lane < m ? (int)lidx[lane] : 0x7fffffff;
        int rk = 0;
        for (int j = 0; j < m; ++j) { const unsigned kj = __shfl(mykey, j); const int ij = __shfl(myidx, j); rk += (kj > mykey || (kj == mykey && ij < myidx)) ? 1 : 0; }
        if (lane < m && rk < need) sel[rk] = myidx;
    }
    LDS_WAIT();
}
#undef TOPK_LOAD
__device__ __forceinline__ void p4_topk(const Args& a, LAS unsigned char* lds, int gw, int NGW, int wave, int lane) {
    unsigned char* ws = a.ws;
    const float* SC = (const float*)(ws + WS_SC); const float* SCS = (const float*)(ws + WS_SCS); int* SEL = (int*)(ws + WS_SEL);
    LAS unsigned* hist = (LAS unsigned*)(lds + wave * 16896); LAS float* scr = (LAS float*)(lds + wave * 16896 + 8192);
#ifndef TOPK_REP
#define TOPK_REP 1
#endif
    for (int it0 = gw; it0 < (SEQ + DB) * TOPK_REP; it0 += NGW) { int it = it0 % (SEQ + DB);
        if (it < SEQ && (SEQ % (2 * NGW)) == 0) { const int blk = it / NGW, w = it % NGW; it = (blk & 1) ? blk * NGW + (NGW - 1 - w) : it; }
        if (it < SEQ) { const int t = NMETA + it; topk_row(SC + (size_t)t * SCLD, t + 1, SEL + (size_t)t * TOPK, hist, lane); }
        else { const int b = it - SEQ; topk_row(SCS + (size_t)b * SCSLD, LS, SEL + (size_t)(TP + b) * TOPK, hist, lane); }
    }
}

template <int CTRL> __device__ __forceinline__ float dpp_f(float v) { return __builtin_bit_cast(float, __builtin_amdgcn_update_dpp(0, __builtin_bit_cast(int, v), CTRL, 0xf, 0xf, false)); }
__device__ __forceinline__ float row16_sum(float v) {
    v += dpp_f<0xB1>(v);
    v += dpp_f<0x4E>(v);
    v += dpp_f<0x124>(v);
    v += dpp_f<0x128>(v);
    return v;
}
typedef short s16x4 __attribute__((ext_vector_type(4)));
__device__ __forceinline__ s16x4 vtr(LAS unsigned char* p) { return __builtin_bit_cast(s16x4, __builtin_amdgcn_ds_read_tr16_b64_v4i16((LAS s16x4*)p)); }
constexpr int VROW = 288;
constexpr int ATT_WAVE_LDS = 1024 + 4096 + 32 * VROW;
struct AttnPre { int sel[4]; bf16x8_t qf[4]; };
__device__ __forceinline__ void attn_prefetch(const Args& a, AttnPre& P, int t, int kvh, int lane) {
    unsigned char* ws = a.ws; const int* SEL = (const int*)(ws + WS_SEL); const bf16* QB = (const bf16*)(ws + WS_QB);
    const bool smp = t >= TP; const int b = t - TP; const int cnt = smp ? TOPK : (t + 1 < TOPK ? t + 1 : TOPK);
    const int l16 = lane & 15, c = lane >> 4;
#pragma unroll
    for (int j = 0; j < 4; ++j) { const int kidx = 64 * j + lane; int sv = SEL[(size_t)t * TOPK + kidx];
        if (smp) sv = sv < PAST ? ((const int*)a.in[6])[b * NPAGES + (sv >> 7)] * PAGE + (sv & 127) : -1;
        P.sel[j] = kidx < cnt ? sv : 0; }
#pragma unroll
    for (int ks = 0; ks < 4; ++ks) { P.qf[ks] = (bf16x8_t){0, 0, 0, 0, 0, 0, 0, 0}; if (l16 < 4) P.qf[ks] = *(const bf16x8_t*)(QB + (size_t)t * 1024 + (kvh * 4 + l16) * 128 + 32 * ks + 8 * c); }
}
template <bool SMP, int APROBE = 0> __device__ __forceinline__ void attn_unit_mfma(const Args& a, LAS unsigned char* wl, int t, int kvh, int lane, const AttnPre& P) {
    unsigned char* ws = a.ws;
    const bf16* KB = (const bf16*)(ws + WS_KB); const bf16* VB = (const bf16*)(ws + WS_VB); bf16* CAT = (bf16*)(ws + (APROBE ? WS_Z : WS_CAT));
    LAS int* lsel = (LAS int*)wl; LAS float* lsc = (LAS float*)(wl + 1024); LAS unsigned char* vst = wl + 5120;
    const int cnt = SMP ? TOPK : (t + 1 < TOPK ? t + 1 : TOPK);
    const int l16 = lane & 15, c = lane >> 4;
    const int b = t - TP;
#pragma unroll
    for (int j = 0; j < 4; ++j) { const int kidx_ = 64 * j + lane, w_ = kidx_ & 31; lsel[(kidx_ & ~31) + 8 * (w_ & 3) + (w_ >> 2)] = P.sel[j]; }
    const float* ck = a.in[2] + kvh * 128; const float* cv = a.in[3] + kvh * 128;
    const float* nk = a.out + O_KS + (size_t)b * 256 + kvh * 128; const float* nv = a.out + O_VS + (size_t)b * 256 + kvh * 128;
    const char* ckb = (const char*)ck; const char* cvb = (const char*)cv;
    const long long dnk = (long long)((uintptr_t)nk - (uintptr_t)ck), dnv = (long long)((uintptr_t)nv - (uintptr_t)cv);
    bf16x8_t qf[4];
#pragma unroll
    for (int ks = 0; ks < 4; ++ks) qf[ks] = P.qf[ks];
    LDS_WAIT();
    const bf16* kbase = KB + kvh * 128 + 8 * c;
#define ATT_LOADK(kf, gp) do { _Pragma("unroll") for (int bb = 0; bb < 4; ++bb) { const int k_ = 16 * (4 * (gp) + bb) + l16, w_ = k_ & 31; const int s_ = lsel[(k_ & ~31) + 8 * (w_ & 3) + (w_ >> 2)]; \
        if (!SMP) { const bf16* kr_ = kbase + (size_t)s_ * 256; _Pragma("unroll") for (int ks = 0; ks < 4; ++ks) kf[bb][ks] = *(const bf16x8_t*)(kr_ + 32 * ks); } \
        else { const float* kr_ = (const float*)(ckb + (s_ >= 0 ? (long long)s_ * 1024 : dnk)) + 8 * c; \
            _Pragma("unroll") for (int ks = 0; ks < 4; ++ks) { const f32x4 x_ = *(const f32x4*)(kr_ + 32 * ks), y_ = *(const f32x4*)(kr_ + 32 * ks + 4); \
                v4u pk_; pk_.x = pk2(x_.x, x_.y); pk_.y = pk2(x_.z, x_.w); pk_.z = pk2(y_.x, y_.y); pk_.w = pk2(y_.z, y_.w); kf[bb][ks] = __builtin_bit_cast(bf16x8_t, pk_); } } } } while (0)
#define ATT_QK(kf, gp) do { _Pragma("unroll") for (int bb = 0; bb < 4; ++bb) { f32x4 acc_ = {0.f, 0.f, 0.f, 0.f}; \
        _Pragma("unroll") for (int ks = 0; ks < 4; ++ks) acc_ = __builtin_amdgcn_mfma_f32_16x16x32_bf16(kf[bb][ks], qf[ks], acc_, 0, 0, 0); \
        const int k0_ = 16 * (4 * (gp) + bb) + 4 * c; \
        acc_.x = k0_ < cnt ? acc_.x : -INFINITY; acc_.y = k0_ + 1 < cnt ? acc_.y : -INFINITY; acc_.z = k0_ + 2 < cnt ? acc_.z : -INFINITY; acc_.w = k0_ + 3 < cnt ? acc_.w : -INFINITY; \
        if (l16 < 4) *(LAS f32x4*)(lsc + l16 * 256 + k0_) = acc_; } } while (0)
    const bf16* vbase = VB + kvh * 128 + 8 * l16;
#define ATT_LOADV(vr, st_) do { _Pragma("unroll") for (int i = 0; i < 8; ++i) { const int s_ = lsel[32 * (st_) + 8 * c + i]; \
        if (!SMP) vr[i] = *(const bf16x8_t*)(vbase + (size_t)s_ * 256); \
        else { const float* vp_ = (const float*)(cvb + (s_ >= 0 ? (long long)s_ * 1024 : dnv)) + 8 * l16; const f32x4 x_ = *(const f32x4*)vp_, y_ = *(const f32x4*)(vp_ + 4); \
            v4u pk_; pk_.x = pk2(x_.x, x_.y); pk_.y = pk2(x_.z, x_.w); pk_.z = pk2(y_.x, y_.y); pk_.w = pk2(y_.z, y_.w); vr[i] = __builtin_bit_cast(bf16x8_t, pk_); } } } while (0)
    bf16x8_t vr0[8], vr1[8];
    if constexpr (!SMP && APROBE == 3) { ATT_LOADV(vr0, 0); ATT_LOADV(vr1, 1); }
    else if constexpr (!SMP) {
      const bf16* kbase2 = KB + kvh * 128 + 8 * l16;
#define ATT_LOADKR(kr, st_) do { _Pragma("unroll") for (int i = 0; i < 8; ++i) { const int s_ = lsel[32 * (st_) + 8 * c + i]; kr[i] = *(const bf16x8_t*)(kbase2 + (size_t)s_ * 256); } } while (0)
#define ATT_QKS(kr, st_, DOLOAD) do { \
        _Pragma("unroll") for (int i = 0; i < 8; ++i) *(LAS bf16x8_t*)(vst + (c + 4 * i) * VROW + 16 * l16) = kr[i]; \
        if (DOLOAD) ATT_LOADKR(kr, (st_) + 2); \
        LDS_WAIT(); \
        _Pragma("unroll") for (int kb2 = 0; kb2 < 2; ++kb2) { f32x4 acc_ = {0.f, 0.f, 0.f, 0.f}; \
            _Pragma("unroll") for (int ks = 0; ks < 4; ++ks) { const bf16x8_t af_ = *(const LAS bf16x8_t*)(vst + (16 * kb2 + l16) * VROW + 64 * ks + 16 * c); \
                acc_ = __builtin_amdgcn_mfma_f32_16x16x32_bf16(af_, qf[ks], acc_, 0, 0, 0); } \
            const int k0_ = 32 * (st_) + 16 * kb2 + 4 * c; \
            acc_.x = k0_ < cnt ? acc_.x : -INFINITY; acc_.y = k0_ + 1 < cnt ? acc_.y : -INFINITY; acc_.z = k0_ + 2 < cnt ? acc_.z : -INFINITY; acc_.w = k0_ + 3 < cnt ? acc_.w : -INFINITY; \
            if (l16 < 4) *(LAS f32x4*)(lsc + l16 * 256 + k0_) = acc_; } \
        LDS_WAIT(); } while (0)
      bf16x8_t kr0[8], kr1[8];
      ATT_LOADKR(kr0, 0); ATT_LOADKR(kr1, 1);
#pragma unroll 1
      for (int st = 0; st < 8; st += 2) {
          if (st == 6) { ATT_LOADV(vr0, 0); ATT_LOADV(vr1, 1); }
          ATT_QKS(kr0, st, st + 2 < 8);
          ATT_QKS(kr1, st + 1, st + 3 < 8); }
#undef ATT_LOADKR
#undef ATT_QKS
    }
    else {
#pragma unroll 1
      for (int gp = 0; gp < 4; ++gp) { bf16x8_t kfA[4][4]; ATT_LOADK(kfA, gp); ATT_QK(kfA, gp); }
      ATT_LOADV(vr0, 0); ATT_LOADV(vr1, 1); }
#undef ATT_LOADK
#undef ATT_QK
    LDS_WAIT();
    float lsum[4];
    { const int g = lane >> 4, i16 = lane & 15; LAS f32x4* ps = (LAS f32x4*)(lsc + g * 256 + 16 * i16);
      f32x4 pv[4]; float m = -INFINITY;
#pragma unroll
      for (int j = 0; j < 4; ++j) { pv[j] = ps[j]; m = fmaxf(m, fmaxf(fmaxf(pv[j].x, pv[j].y), fmaxf(pv[j].z, pv[j].w))); }
      m = fmaxf(m, dpp_f<0xB1>(m)); m = fmaxf(m, dpp_f<0x4E>(m)); m = fmaxf(m, dpp_f<0x124>(m)); m = fmaxf(m, dpp_f<0x128>(m));
      float l = 0.f;
#pragma unroll
      for (int j = 0; j < 4; ++j) { pv[j].x = __builtin_amdgcn_exp2f(pv[j].x - m); pv[j].y = __builtin_amdgcn_exp2f(pv[j].y - m); pv[j].z = __builtin_amdgcn_exp2f(pv[j].z - m); pv[j].w = __builtin_amdgcn_exp2f(pv[j].w - m);
          l += (pv[j].x + pv[j].y) + (pv[j].z + pv[j].w); ps[j] = pv[j]; }
      l = row16_sum(l);
#pragma unroll
      for (int gg = 0; gg < 4; ++gg) lsum[gg] = __builtin_bit_cast(float, __builtin_amdgcn_readlane(__builtin_bit_cast(int, l), 16 * gg)); }
    LDS_WAIT();
    f32x4 oacc[8];
#pragma unroll
    for (int db = 0; db < 8; ++db) oacc[db] = (f32x4){0.f, 0.f, 0.f, 0.f};
    LAS unsigned char* trp = vst + (4 * c + (l16 >> 2)) * VROW + 8 * (l16 & 3);
#define ATT_PV(vr, st, vnext, DOLOAD) do { \
        _Pragma("unroll") for (int i = 0; i < 8; ++i) *(LAS bf16x8_t*)(vst + (c + 4 * i) * VROW + 16 * l16) = vr[i]; \
        if (DOLOAD) ATT_LOADV(vnext, (st) + 2); \
        bf16x8_t pf = (bf16x8_t){0, 0, 0, 0, 0, 0, 0, 0}; \
        if (l16 < 4) { const f32x4 p0 = *(const LAS f32x4*)(lsc + l16 * 256 + 32 * (st) + 4 * c), p1 = *(const LAS f32x4*)(lsc + l16 * 256 + 32 * (st) + 16 + 4 * c); \
            v4u pk; pk.x = pk2(p0.x, p0.y); pk.y = pk2(p0.z, p0.w); pk.z = pk2(p1.x, p1.y); pk.w = pk2(p1.z, p1.w); pf = __builtin_bit_cast(bf16x8_t, pk); } \
        LDS_WAIT(); \
        _Pragma("unroll") for (int db = 0; db < 8; ++db) { const s16x4 lo = vtr(trp + 32 * db), hi = vtr(trp + 16 * VROW + 32 * db); \
            const bf16x8_t vf = (bf16x8_t){lo[0], lo[1], lo[2], lo[3], hi[0], hi[1], hi[2], hi[3]}; \
            oacc[db] = __builtin_amdgcn_mfma_f32_16x16x32_bf16(pf, vf, oacc[db], 0, 0, 0); } \
        LDS_WAIT(); } while (0)
#pragma unroll 1
    for (int st = 0; st < (APROBE == 4 ? 2 : 8); st += 2) {
        ATT_PV(vr0, st, vr0, st + 2 < 8);
        ATT_PV(vr1, st + 1, vr1, st + 3 < 8);
    }
#undef ATT_PV
#undef ATT_LOADV
    LAS unsigned short* obuf = (LAS unsigned short*)lsc;
    if (c == 0) {
        const float i0 = 1.f / lsum[0], i1 = 1.f / lsum[1], i2 = 1.f / lsum[2], i3 = 1.f / lsum[3];
#pragma unroll
        for (int db = 0; db < 8; ++db) { obuf[0 * 128 + 16 * db + l16] = (unsigned short)f2bf(oacc[db].x * i0); obuf[1 * 128 + 16 * db + l16] = (unsigned short)f2bf(oacc[db].y * i1);
            obuf[2 * 128 + 16 * db + l16] = (unsigned short)f2bf(oacc[db].z * i2); obuf[3 * 128 + 16 * db + l16] = (unsigned short)f2bf(oacc[db].w * i3); } }
    LDS_WAIT();
    { const v4u o = *(const LAS v4u*)((LAS unsigned char*)obuf + c * 256 + 16 * l16);
      *(v4u*)(CAT + (size_t)t * 2048 + (kvh * 4 + c) * 128 + 8 * l16) = o; }
    LDS_WAIT();
}
template <int APROBE = 0> __device__ __forceinline__ void p5_attn(const Args& a, LAS unsigned char* lds, int bid, int G, int wave, int lane) {
    LAS unsigned char* wl = lds + wave * ATT_WAVE_LDS;
#ifndef CONVW_
#define CONVW_ 2
#endif
    constexpr int CONVW = CONV_IN_ATTN ? CONVW_ : 0, AW = 8 - CONVW;
    int kvh, hw, nhw;
    if ((G & 7) == 0) { kvh = (bid >> 2) & 1; hw = ((bid >> 3) * 4 + (bid & 3)) * AW + wave; nhw = (G / 2) * AW; }
    else { kvh = bid & 1; hw = (bid >> 1) * AW + wave; nhw = ((G + 1 - kvh) >> 1) * AW; if (nhw == 0) { nhw = 1; } }
#ifndef DYN_ROUNDS
#define DYN_ROUNDS 2
#endif
    const int NSTAT = ((SEQ + DB) / nhw - DYN_ROUNDS) * nhw;
    unsigned* ticket = (unsigned*)(a.ws + WS_CTL) + 2048 + 64 * kvh;
#define ATT_ROW(i) (((i) >= DB && (i) < 2 * DB) ? TP + ((i) - DB) : NMETA + ((i) < DB ? (i) : (i) - DB))
    if (wave >= AW) {
        const int cw = wave - AW;
        LAS float* scr = (LAS float*)(lds + 8 * ATT_WAVE_LDS + cw * 2 * 8448); LAS float* scr2 = scr + 64 * 33;
        for (int cit = bid + 2 * G * cw; cit < CV_N; cit += 2 * G * CONVW) { if (cit + G < CV_N) conv_pair(a, scr, scr2, cit, cit + G, lane); else conv_item(a, scr, cit, lane); }
    } else {
        AttnPre P;
        if (hw < NSTAT) attn_prefetch(a, P, ATT_ROW(hw), kvh, lane);
        for (int it = hw; it < NSTAT; it += nhw) {
            const int t = ATT_ROW(it);
            const AttnPre C = P; const int nx = it + nhw;
            if (nx < NSTAT) attn_prefetch(a, P, ATT_ROW(nx), kvh, lane);
            if (t >= TP) attn_unit_mfma<true, APROBE>(a, wl, t, kvh, lane, C); else attn_unit_mfma<false, APROBE>(a, wl, t, kvh, lane, C); }
    }
    for (;;) {
        unsigned tk = 0u; if (lane == 0) tk = __hip_atomic_fetch_add(ticket, 1u, __ATOMIC_RELAXED, __HIP_MEMORY_SCOPE_AGENT);
        const int it = NSTAT + (int)__builtin_amdgcn_readfirstlane(tk);
        if (it >= SEQ + DB) break;
        const int t = ATT_ROW(it); AttnPre C; attn_prefetch(a, C, t, kvh, lane);
        if (t >= TP) attn_unit_mfma<true, APROBE>(a, wl, t, kvh, lane, C); else attn_unit_mfma<false, APROBE>(a, wl, t, kvh, lane, C); }
#undef ATT_ROW
}
template <int W> __device__ __forceinline__ void dpool_block16(const float* U, bf16* DP, int r0, int c4) {
    f32x4 v[31], P[32];
#pragma unroll
    for (int i = 0; i < 31; ++i) v[i] = (i >= 16 - W) ? *((const f32x4*)(U + (size_t)(r0 - 15 + i) * 1024) + c4) : (f32x4){0.f, 0.f, 0.f, 0.f};
    P[0] = (f32x4){0.f, 0.f, 0.f, 0.f};
#pragma unroll
    for (int i = 0; i < 31; ++i) P[i + 1] = P[i] + v[i];
#pragma unroll
    for (int t = 0; t < 16; ++t) { const f32x4 d = (P[16 + t] - P[16 + t - W]) * (1.0f / W) - v[15 + t];
        *((unsigned long long*)(DP + (size_t)(r0 + t) * 1024) + c4) = (unsigned long long)pk2(d.x, d.y) | ((unsigned long long)pk2(d.z, d.w) << 32); }
}
__device__ __forceinline__ void p5_dpool(const Args& a, int bid, int G, int tid) {
    unsigned char* ws = a.ws;
    const float* U = (const float*)(ws + WS_U); bf16* DP = (bf16*)(ws + WS_DPOOL); const float* SP = a.in[5];
    for (int e = bid * 512 + tid; e < (SEQ / 16) * 256; e += G * 512) { const int rb = e >> 8, c4 = e & 255; const int grp = c4 >> 6; const int r0 = NMETA + 16 * rb;
        if (grp == 0) dpool_block16<2>(U, DP, r0, c4); else if (grp == 1) dpool_block16<4>(U, DP, r0, c4); else if (grp == 2) dpool_block16<8>(U, DP, r0, c4); else dpool_block16<16>(U, DP, r0, c4); }
    for (int e = bid * 512 + tid; e < (MP - TP) * 256; e += G * 512) { const int r = TP + (e >> 8), c4 = e & 255; const int grp = c4 >> 6; const int w = 2 << grp;
        f32x4 d = {0.f, 0.f, 0.f, 0.f};
        if (r < MR) { const int b = r - TP; const f32x4 cur = *((const f32x4*)(U + (size_t)r * 1024) + c4); f32x4 sum = cur;
            for (int j = 1; j < w; ++j) sum += *((const f32x4*)(SP + ((size_t)b * 15 + (15 - j)) * 1024) + c4);
            d = sum / (float)w - cur; }
        *((unsigned long long*)(DP + (size_t)r * 1024) + c4) = (unsigned long long)pk2(d.x, d.y) | ((unsigned long long)pk2(d.z, d.w) << 32); }
}
template <bool OUT_BF16>
__device__ __forceinline__ void rms_rowbf(const bf16* xrow, const float* gain, bf16* obf, float* of32, int lane) {
    float v[4][8]; float s = 0.f;
#pragma unroll
    for (int j = 0; j < 4; ++j) { const v4u rb = *((const v4u*)xrow + lane + 64 * j);
        v[j][0] = __builtin_bit_cast(float, rb.x << 16); v[j][1] = __builtin_bit_cast(float, rb.x & 0xffff0000u); v[j][2] = __builtin_bit_cast(float, rb.y << 16); v[j][3] = __builtin_bit_cast(float, rb.y & 0xffff0000u);
        v[j][4] = __builtin_bit_cast(float, rb.z << 16); v[j][5] = __builtin_bit_cast(float, rb.z & 0xffff0000u); v[j][6] = __builtin_bit_cast(float, rb.w << 16); v[j][7] = __builtin_bit_cast(float, rb.w & 0xffff0000u);
#pragma unroll
        for (int e = 0; e < 8; ++e) s += v[j][e] * v[j][e]; }
    const float rstd = 1.f / sqrtf(wave_sum(s) * (1.f / DM) + EPS);
#pragma unroll
    for (int j = 0; j < 4; ++j) { const f32x4 g0 = *((const f32x4*)gain + 2 * (lane + 64 * j)), g1 = *((const f32x4*)gain + 2 * (lane + 64 * j) + 1);
        const float o0 = v[j][0] * rstd * g0.x, o1 = v[j][1] * rstd * g0.y, o2 = v[j][2] * rstd * g0.z, o3 = v[j][3] * rstd * g0.w, o4 = v[j][4] * rstd * g1.x, o5 = v[j][5] * rstd * g1.y, o6 = v[j][6] * rstd * g1.z, o7 = v[j][7] * rstd * g1.w;
        if (OUT_BF16) { v4u o; o.x = pk2(o0, o1); o.y = pk2(o2, o3); o.z = pk2(o4, o5); o.w = pk2(o6, o7); *((v4u*)obf + lane + 64 * j) = o; }
        else { *((f32x4*)of32 + 2 * (lane + 64 * j)) = (f32x4){o0, o1, o2, o3}; *((f32x4*)of32 + 2 * (lane + 64 * j) + 1) = (f32x4){o4, o5, o6, o7}; } }
}
__device__ __forceinline__ void rms_row_to_f32(const float* xrow, const float* gain, float* orow, int lane) {
    const f32x4* xr = (const f32x4*)xrow + lane; const f32x4* gr = (const f32x4*)gain + lane;
    f32x4 v[8]; float s = 0.f;
#pragma unroll
    for (int j = 0; j < 8; ++j) { v[j] = xr[64 * j]; s += (v[j].x * v[j].x + v[j].y * v[j].y) + (v[j].z * v[j].z + v[j].w * v[j].w); }
    const float rstd = 1.f / sqrtf(wave_sum(s) * (1.f / DM) + EPS);
#pragma unroll
    for (int j = 0; j < 8; ++j) { const f32x4 g = gr[64 * j]; *((f32x4*)orow + lane + 64 * j) = v[j] * rstd * g; }
}

template <int NB, int MODE  >
__device__ __forceinline__ void small_gemm_item(const bf16* A, int lda, const bf16* Bt, int ldb, int n0, int k_lo, int k_hi, float* outF, bf16* outH, int ldo, int wave, int lane) {
    const int fr = lane & 15, fq = lane >> 4;
    const bf16* ap = A + (size_t)(16 * wave + fr) * lda + k_lo + 8 * fq;
    const bf16* bp = Bt + (size_t)(n0 + fr) * ldb + k_lo + 8 * fq;
    f32x4 acc[NB];
#pragma unroll
    for (int c = 0; c < NB; ++c) acc[c] = (f32x4){0.f, 0.f, 0.f, 0.f};
#pragma unroll 8
    for (int k = k_lo; k < k_hi; k += 32) {
        const bf16x8_t af = *(const bf16x8_t*)ap; ap += 32;
#pragma unroll
        for (int c = 0; c < NB; ++c) { const bf16x8_t bfv = *(const bf16x8_t*)(bp + (size_t)16 * c * ldb); acc[c] = __builtin_amdgcn_mfma_f32_16x16x32_bf16(bfv, af, acc[c], 0, 0, 0); }
        bp += 32;
    }
    const int row = 16 * wave + fr;
#pragma unroll
    for (int c = 0; c < NB; ++c) { const int col = n0 + 16 * c + 4 * fq;
        if (MODE == 0) *(f32x4*)(outF + (size_t)row * ldo + col) = acc[c];
        else { float v0 = fmaxf(acc[c].x, 0.f), v1 = fmaxf(acc[c].y, 0.f), v2 = fmaxf(acc[c].z, 0.f), v3 = fmaxf(acc[c].w, 0.f);
            unsigned long long o = (unsigned long long)pk2(v0 * v0, v1 * v1) | ((unsigned long long)pk2(v2 * v2, v3 * v3) << 32);
            *(unsigned long long*)(outH + (size_t)row * ldo + col) = o; } }
}
template <int KLEN, int MODE  >
__device__ __forceinline__ void small_gemm_ksplit(const bf16* A, int lda, const bf16* Bt, int ldb, int n0, int k_lo, float* outF, bf16* outH, int ldo, LAS unsigned char* lds, int tid, int wave, int lane) {
    constexpr int KW = KLEN / 8, NS = KW / 32;
    static_assert(KW % 32 == 0 && NS >= 1, "small_gemm_ksplit: KLEN must be a multiple of 256");
    const int fr = lane & 15, fq = lane >> 4;
    const bf16* ap = A + (size_t)fr * lda + k_lo + wave * KW + 8 * fq;
    const bf16* bp = Bt + (size_t)(n0 + fr) * ldb + k_lo + wave * KW + 8 * fq;
    f32x4 acc[8][2];
#pragma unroll
    for (int rb = 0; rb < 8; ++rb) { acc[rb][0] = (f32x4){0.f, 0.f, 0.f, 0.f}; acc[rb][1] = acc[rb][0]; }
    constexpr int SB = NS < 4 ? NS : 4;
#pragma unroll 1
    for (int s0 = 0; s0 < NS; s0 += SB) {
        bf16x8_t af[SB][8], bfv[SB][2];
#pragma unroll
        for (int ss = 0; ss < SB; ++ss) {
#pragma unroll
            for (int rb = 0; rb < 8; ++rb) af[ss][rb] = *(const bf16x8_t*)(ap + (size_t)(16 * rb) * lda + 32 * (s0 + ss));
            bfv[ss][0] = *(const bf16x8_t*)(bp + 32 * (s0 + ss)); bfv[ss][1] = *(const bf16x8_t*)(bp + (size_t)16 * ldb + 32 * (s0 + ss)); }
#pragma unroll
        for (int ss = 0; ss < SB; ++ss)
#pragma unroll
            for (int rb = 0; rb < 8; ++rb) { acc[rb][0] = __builtin_amdgcn_mfma_f32_16x16x32_bf16(bfv[ss][0], af[ss][rb], acc[rb][0], 0, 0, 0); acc[rb][1] = __builtin_amdgcn_mfma_f32_16x16x32_bf16(bfv[ss][1], af[ss][rb], acc[rb][1], 0, 0, 0); }
    }
    LAS float* part = (LAS float*)lds;
#pragma unroll
    for (int rb = 0; rb < 8; ++rb)
#pragma unroll
        for (int cb = 0; cb < 2; ++cb) *(LAS f32x4*)(part + ((size_t)(wave * 128 + 16 * rb + fr) * 32 + 16 * cb + 4 * fq)) = acc[rb][cb];
    __syncthreads();
    { const int row = tid >> 2, c0 = (tid & 3) * 8;
      f32x4 s0 = {0.f, 0.f, 0.f, 0.f}, s1 = s0;
#pragma unroll
      for (int w = 0; w < 8; ++w) { s0 += *(const LAS f32x4*)(part + ((size_t)(w * 128 + row) * 32 + c0)); s1 += *(const LAS f32x4*)(part + ((size_t)(w * 128 + row) * 32 + c0 + 4)); }
      if (MODE == 0) { float* o = outF + (size_t)row * ldo + n0 + c0; *(f32x4*)o = s0; *(f32x4*)(o + 4) = s1; }
      else { v4u o; float a0 = fmaxf(s0.x, 0.f), a1 = fmaxf(s0.y, 0.f), a2 = fmaxf(s0.z, 0.f), a3 = fmaxf(s0.w, 0.f), b0 = fmaxf(s1.x, 0.f), b1 = fmaxf(s1.y, 0.f), b2 = fmaxf(s1.z, 0.f), b3 = fmaxf(s1.w, 0.f);
          o.x = pk2(a0 * a0, a1 * a1); o.y = pk2(a2 * a2, a3 * a3); o.z = pk2(b0 * b0, b1 * b1); o.w = pk2(b2 * b2, b3 * b3);
          *(v4u*)(outH + (size_t)row * ldo + n0 + c0) = o; } }
    __syncthreads();
}
template <bool OUT_BF16>
__device__ __forceinline__ void rms_row_slabs(const float* base, const float* slab  , int b, const float* gain, float* xstore, bf16* obf, float* of32, int lane) {
    const f32x4* xr = (const f32x4*)base + lane; const f32x4* gr = (const f32x4*)gain + lane;
    f32x4 v[8]; float s = 0.f;
#pragma unroll
    for (int j = 0; j < 8; ++j) { v[j] = xr[64 * j];
#pragma unroll
        for (int sp = 0; sp < 4; ++sp) v[j] += *((const f32x4*)(slab + ((size_t)sp * DB + b) * DM) + lane + 64 * j);
        s += (v[j].x * v[j].x + v[j].y * v[j].y) + (v[j].z * v[j].z + v[j].w * v[j].w);
        if (xstore) *((f32x4*)xstore + lane + 64 * j) = v[j]; }
    const float rstd = 1.f / sqrtf(wave_sum(s) * (1.f / DM) + EPS);
#pragma unroll
    for (int j = 0; j < 8; ++j) { const f32x4 g = gr[64 * j];
        if (OUT_BF16) *((unsigned long long*)obf + lane + 64 * j) = (unsigned long long)pk2(v[j].x * rstd * g.x, v[j].y * rstd * g.y) | ((unsigned long long)pk2(v[j].z * rstd * g.z, v[j].w * rstd * g.w) << 32);
        else *((f32x4*)of32 + lane + 64 * j) = v[j] * rstd * g; }
}

#define GAS __attribute__((address_space(1)))
typedef GAS unsigned gu32;
#define RLX_AGENT __ATOMIC_RELAXED, __HIP_MEMORY_SCOPE_AGENT
#define XB_TMO      128
#define XB_XCNT(j)  (256  + 64 * (j))
#define XB_XSUB(j)  (1280 + 64 * (j))
#define XB_XGEN(j)  (2304 + 64 * (j))
#define XB_TOP      3328
#define XB_TOPGEN   3392
#define XCD_BAR_WORDS 3456
#define XB_SPIN_CAP (1u << 18)

__device__ __forceinline__ unsigned xb_ld(unsigned* p)              { return __hip_atomic_load(p, __ATOMIC_RELAXED, __HIP_MEMORY_SCOPE_AGENT); }
__device__ __forceinline__ unsigned xb_add(unsigned* p, unsigned v) { return __hip_atomic_fetch_add(p, v, __ATOMIC_RELAXED, __HIP_MEMORY_SCOPE_AGENT); }
__device__ __forceinline__ unsigned xb_xcc_id() { return (unsigned)__builtin_amdgcn_s_getreg((3 << 11) | 20) & 0xFu; }
#define XB_SPIN(cond, bar) do { unsigned _sp = 0; while (cond) { __builtin_amdgcn_s_sleep(1); \
    if ((++_sp & 255u) == 0u) { if (xb_ld(&(bar)[XB_TMO])) break; if (_sp > XB_SPIN_CAP) { atomicAdd(&(bar)[XB_TMO], 1u); break; } } } } while (0)

struct XcdBarrier {
    unsigned* bar; unsigned x;
    volatile LAS unsigned* st;
};

__device__ __forceinline__ XcdBarrier xcd_barrier_post(unsigned* bar, volatile LAS unsigned* st) {
    XcdBarrier b; b.bar = bar; b.x = xb_xcc_id(); b.st = st;
    if (threadIdx.x == 0) (void)xb_add(&bar[XB_XCNT(b.x)], 1u);
    return b;
}
__device__ __forceinline__ void xcd_barrier_complete(unsigned* bar, unsigned x, unsigned& nloc, unsigned& nx) {
    const unsigned G = gridDim.x * gridDim.y * gridDim.z;
    unsigned sum, cnt, mine, sp = 0u;
    for (;;) {
        sum = 0u; cnt = 0u; mine = 0u;
#pragma unroll
        for (unsigned j = 0; j < 16; ++j) { const unsigned c = xb_ld(&bar[XB_XCNT(j)]); sum += c; cnt += (c > 0u) ? 1u : 0u; mine = (j == x) ? c : mine; }
        if (sum == G) break;
        __builtin_amdgcn_s_sleep(1);
        if ((++sp & 255u) == 0u) { if (xb_ld(&bar[XB_TMO])) break; if (sp > XB_SPIN_CAP) { atomicAdd(&bar[XB_TMO], 1u); break; } }
    }
    nloc = mine > 0u ? mine : 1u; nx = cnt > 0u ? cnt : 1u;
}

__device__ __forceinline__ void xcd_barrier(const XcdBarrier& b) {
    asm volatile("s_waitcnt vmcnt(0)" ::: "memory");
    __syncthreads();
    if (threadIdx.x == 0) {
        unsigned* bar = b.bar;
        __builtin_amdgcn_s_waitcnt(0);
        unsigned nloc = b.st[0], nx = b.st[1];
        if (nloc == 0u) { xcd_barrier_complete(bar, b.x, nloc, nx); b.st[0] = nloc; b.st[1] = nx; }
        const unsigned old = xb_add(&bar[XB_XSUB(b.x)], 1u);
        const unsigned gen = old / nloc;
        if (old + 1u == (gen + 1u) * nloc) {
            __builtin_amdgcn_fence(__ATOMIC_RELEASE, "agent");
            asm volatile("s_waitcnt vmcnt(0)" ::: "memory");
            const unsigned og = xb_add(&bar[XB_TOP], 1u);
            const unsigned tg = og / nx;
            if (og + 1u == (tg + 1u) * nx) xb_add(&bar[XB_TOPGEN], 1u);
            else XB_SPIN(xb_ld(&bar[XB_TOPGEN]) == tg, bar);
            __builtin_amdgcn_fence(__ATOMIC_ACQUIRE, "agent");
            xb_add(&bar[XB_XGEN(b.x)], 1u);
            asm volatile("s_waitcnt vmcnt(0)" ::: "memory");
        } else {
            XB_SPIN(xb_ld(&bar[XB_XGEN(b.x)]) == gen, bar);
            __builtin_amdgcn_fence(__ATOMIC_ACQUIRE, "agent");
            asm volatile("s_waitcnt vmcnt(0)" ::: "memory");
        }
    }
    __syncthreads();
}


__global__ void __launch_bounds__(512, 2) mk_fwd(Args a) {
    extern __shared__ __attribute__((aligned(16))) unsigned char lds_raw[];
    LAS unsigned char* lds = (LAS unsigned char*)lds_raw;
    const int tid = threadIdx.x, lane = tid & 63, wave = __builtin_amdgcn_readfirstlane(tid >> 6);
    const int G = gridDim.x, bid = blockIdx.x;
    const int gw = bid * 8 + wave, NGW = G * 8;
    unsigned char* ws = a.ws;
    const int lo = a.ph_lo, hi = a.ph_hi;
#ifndef PHASE_MASK
#define PHASE_MASK 0xFFF
#endif
#define IN(k) ((((PHASE_MASK) >> (k)) & 1) && lo <= (k) && (k) < hi)
#if MK_ONE_LAUNCH
    for (int u = tid; u < (LDS_BYTES - LDSCTL_OFF) / 4; u += 512) ((LAS unsigned*)(lds + LDSCTL_OFF))[u] = 0u;
    __syncthreads();
    if (hi > NPH) cg::this_grid().sync();
    XcdBarrier bar = xcd_barrier_post((unsigned*)(ws + WS_CTL) + CW_BAR, (volatile LAS unsigned*)(lds + MISC_OFF) + 8);
#define SEAM(k) do { if (IN(k) && IN((k) + 1)) xcd_barrier(bar); } while (0)
#else
#define SEAM(k) do { } while (0)
#endif
#ifndef DUPMASK
#define DUPMASK 0
#endif
#ifndef GREP
#define GREP 0
#endif
#define GR(k) ((((GREP) >> (k)) & 1) ? 2 : 1)
#define REPS(k) for (int rep_ = 0; rep_ < ((((DUPMASK) >> (k)) & 1) ? 2 : 1); ++rep_)
    if (IN(0)) REPS(0) { p0_prep(a, lds, gw, NGW, wave, lane); __syncthreads(); } SEAM(0);
    if (IN(1)) REPS(1) { pg8::Gemm g{(const pg8::bf16_t*)(ws + WS_XN), (const pg8::bf16_t*)(ws + WS_WIN), MP, NZ, DM, DM, DM, 0}; pg8::StaticOrder S; S.init(MP, NZ, G, bid);
        pg8::EpiIn E{a.out, ws};
        pg8::gemm_phase<pg8::EpiIn, pg8::StaticOrder, PG8_ALIGN, PG8_SP2>(lds, g, S, E); } SEAM(2);
#ifndef SUB3
#define SUB3 7
#endif
#ifndef SUB3DUP
#define SUB3DUP 0
#endif
#ifndef PMODE2
#define PMODE2 0
#endif
    if (IN(3)) {         p3_indexer_prompt<0>(a, lds, bid, G, tid, wave, lane, true); __syncthreads();
        if (SUB3DUP & 1) { p3_indexer_prompt<PMODE2>(a, lds, bid, G, tid, wave, lane, false); __syncthreads(); }
        for (int r3 = 0; r3 < ((SUB3DUP & 2) ? 2 : 1); ++r3) { p3_indexer_sample(a, lds, gw, NGW, wave, lane); }
        for (int r3 = 0; r3 < ((SUB3DUP & 4) ? 2 : 1); ++r3) p5_dpool(a, bid, G, tid); __syncthreads(); } SEAM(3);
    if (IN(4)) REPS(4) {
        { pg8::Gemm g{(const pg8::bf16_t*)(ws + WS_DPOOL), (const pg8::bf16_t*)(ws + WS_WPOOL), MP, 1024, 256, 1024, 256, 256}; pg8::StaticOrder S; S.init(MP, 1024, G, bid, GR(6));
          pg8::EpiBf16<0> E{(pg8::bf16_t*)(ws + WS_CAT), 2048, 1024, a.in[11]};
          pg8::gemm_phase<pg8::EpiBf16<0>, pg8::StaticOrder, PG8_ALIGN, PG8_SP2>(lds, g, S, E); }
        p4_topk(a, lds, gw, NGW, wave, lane); __syncthreads(); } SEAM(4);
#ifndef APROBE2
#define APROBE2 0
#endif
    if (IN(5)) { p5_attn<0>(a, lds, bid, G, wave, lane); __syncthreads(); if (APROBE2) { p5_attn<APROBE2>(a, lds, bid, G, wave, lane); __syncthreads(); } } SEAM(6);
    constexpr int R0 = NMETA;
    if (IN(7)) REPS(7) { pg8::Gemm g{(const pg8::bf16_t*)(ws + WS_CAT) + (size_t)R0 * DM, (const pg8::bf16_t*)(ws + WS_WOUT), SEQ, DM, DM, DM, DM, 0}; pg8::StaticOrder S; S.init(SEQ, DM, G, bid, GR(7));
        pg8::EpiResB<false> E{(pg8::bf16_t*)(ws + WS_H1) + (size_t)R0 * DM, a.in[0]};
        pg8::gemm_phase<pg8::EpiResB<false>, pg8::StaticOrder, PG8_ALIGN, PG8_SP2>(lds, g, S, E);
        for (int it = bid; it < 256; it += G) { const int ct = it & 63, sp = it >> 6;
            small_gemm_ksplit<512, 0>((const bf16*)(ws + WS_CAT) + (size_t)TP * DM, DM, (const bf16*)(ws + WS_WOUT), DM, 32 * ct, 512 * sp, (float*)(ws + WS_PS1) + (size_t)sp * DB * DM, nullptr, DM, lds, tid, wave, lane); }
    } SEAM(7);
    if (IN(8)) REPS(8) { float* H1 = (float*)(ws + WS_H1); bf16* XN = (bf16*)(ws + WS_XN);
        for (int m = gw; m < SEQ + DB; m += NGW) { const int r = R0 + m;
            if (m < SEQ) rms_rowbf<true>((const bf16*)(ws + WS_H1) + (size_t)r * DM, a.in[13], XN + (size_t)r * DM, nullptr, lane);
            else rms_row_slabs<true>(a.in[1] + (size_t)(m - SEQ) * DM, (const float*)(ws + WS_PS1), m - SEQ, a.in[13], H1 + (size_t)r * DM, XN + (size_t)r * DM, nullptr, lane); } } SEAM(8);
    if (IN(9)) REPS(9) { pg8::Gemm g{(const pg8::bf16_t*)(ws + WS_XN) + (size_t)R0 * DM, (const pg8::bf16_t*)(ws + WS_WUP), SEQ, DFF, DM, DM, DM, 0}; pg8::StaticOrder S; S.init(SEQ, DFF, G, bid, GR(9));
        pg8::EpiBf16<1> E{(pg8::bf16_t*)(ws + WS_ACT) + (size_t)R0 * DFF, DFF, 0, nullptr};
        pg8::gemm_phase<pg8::EpiBf16<1>, pg8::StaticOrder, PG8_ALIGN, PG8_SP2>(lds, g, S, E);
        for (int it = bid; it < 256; it += G)
            small_gemm_ksplit<2048, 1>((const bf16*)(ws + WS_XN) + (size_t)TP * DM, DM, (const bf16*)(ws + WS_WUP), DM, 32 * it, 0, nullptr, (bf16*)(ws + WS_ACT) + (size_t)TP * DFF, DFF, lds, tid, wave, lane);
    } SEAM(9);
    if (IN(10)) REPS(10) { pg8::Gemm g{(const pg8::bf16_t*)(ws + WS_ACT) + (size_t)R0 * DFF, (const pg8::bf16_t*)(ws + WS_WDN), SEQ, DM, DFF, DFF, DFF, 0}; pg8::StaticOrder S; S.init(SEQ, DM, G, bid, GR(10));
        pg8::EpiResB<true> E{(pg8::bf16_t*)(ws + WS_H2) + (size_t)R0 * DM, (const pg8::bf16_t*)(ws + WS_H1) + (size_t)R0 * DM};
        pg8::gemm_phase<pg8::EpiResB<true>, pg8::StaticOrder, PG8_ALIGN, PG8_SP2>(lds, g, S, E);
        for (int it = bid; it < 256; it += G) { const int ct = it & 63, sp = it >> 6;
            small_gemm_ksplit<2048, 0>((const bf16*)(ws + WS_ACT) + (size_t)TP * DFF, DFF, (const bf16*)(ws + WS_WDN), DFF, 32 * ct, 2048 * sp, (float*)(ws + WS_PS2) + (size_t)sp * DB * DM, nullptr, DM, lds, tid, wave, lane); }
    } SEAM(10);
    if (IN(11)) REPS(11) { const float* H2 = (const float*)(ws + WS_H2); const float* H1 = (const float*)(ws + WS_H1);
        for (int m = gw; m < SEQ + DB; m += NGW) { const int r = R0 + m;
            if (m < SEQ) rms_rowbf<false>((const bf16*)(ws + WS_H2) + (size_t)r * DM, a.in[16], nullptr, a.out + O_YP + (size_t)m * DM, lane);
            else rms_row_slabs<false>(H1 + (size_t)r * DM, (const float*)(ws + WS_PS2), m - SEQ, a.in[16], nullptr, nullptr, a.out + O_YS + (size_t)(m - SEQ) * DM, lane); } }
#undef IN
#undef SEAM
}

extern "C" void kernel_launch(void* const* d_in, const int* in_sizes, int n_in, void* d_out, int out_size, void* d_ws, size_t ws_size, hipStream_t stream) {
    static int grid = 0;
    if (grid == 0) {
        if (n_in != 17 || (size_t)out_size != O_END || ws_size < WS_END) { fprintf(stderr, "kernel_launch: unexpected shapes: n_in %d out_size %d (want %zu) ws %zu (want >= %zu)\n", n_in, out_size, (size_t)O_END, ws_size, (size_t)WS_END); grid = -1; return; }
        int dev = 0, cus = 0, per_cu = 0;
        if (hipGetDevice(&dev) != hipSuccess || hipDeviceGetAttribute(&cus, hipDeviceAttributeMultiprocessorCount, dev) != hipSuccess) { grid = -1; return; }
        if (hipFuncSetAttribute((const void*)mk_fwd, hipFuncAttributeMaxDynamicSharedMemorySize, LDS_BYTES) != hipSuccess) { fprintf(stderr, "kernel_launch: hipFuncSetAttribute failed\n"); grid = -1; return; }
        if (hipOccupancyMaxActiveBlocksPerMultiprocessor(&per_cu, (const void*)mk_fwd, 512, LDS_BYTES) != hipSuccess || per_cu < 1) { fprintf(stderr, "kernel_launch: occupancy query says %d\n", per_cu); grid = -1; return; }
        grid = cus;
        fprintf(stderr, "kernel_launch: grid %d (cus %d, per_cu %d)\n", grid, cus, per_cu);
    }
    if (grid < 0) return;
    Args a{};
    for (int i = 0; i < 17; ++i) a.in[i] = (const float*)d_in[i];
    a.out = (float*)d_out; a.ws = (unsigned char*)d_ws;
#if MK_ONE_LAUNCH
    a.ph_lo = 0; a.ph_hi = NPH;
    if (hipMemsetAsync((char*)d_ws + WS_CTL, 0, 65536, stream) != hipSuccess) { fprintf(stderr, "kernel_launch: memset failed\n"); return; }
    void* args[] = {&a};
    hipError_t e = hipLaunchCooperativeKernel((const void*)mk_fwd, dim3(grid), dim3(512), args, LDS_BYTES, stream);
    if (e != hipSuccess) fprintf(stderr, "kernel_launch: cooperative launch failed: %s (grid %d)\n", hipGetErrorString(e), grid);
#else
    for (int p = 0; p < NPH; ++p) { a.ph_lo = p; a.ph_hi = p + 1; hipLaunchKernelGGL(mk_fwd, dim3(grid), dim3(512), LDS_BYTES, stream, a); }
#endif
}
```

```cpp
#include <hip/hip_runtime.h>
#include <hip/hip_cooperative_groups.h>
#include <cstdio>
#include <cstdint>
namespace cg = cooperative_groups;

namespace pg8 {
#define PG8_LAS __attribute__((address_space(3)))
typedef unsigned short bf16_t;
typedef short bf16x8 __attribute__((ext_vector_type(8)));
typedef float f32x4 __attribute__((ext_vector_type(4)));
typedef unsigned u32x4 __attribute__((ext_vector_type(4)));
constexpr int BM = 256, BK = 64, HALF = 128, HTB = HALF * BK * 2  , STAGE_BYTES = 8 * HTB, NXCD = 8, WGM = 8;

__host__ __device__ __forceinline__ int lds_byte(int r, int c) { const int st = (r >> 4) * 2 + (c >> 5), rr = r & 15, cc = c & 31, ob = rr * 64 + cc * 2; return st * 1024 + (ob ^ (((ob >> 9) & 1) << 5)); }
__host__ __device__ __forceinline__ void stage_rc(int b, int& R, int& C) { const int st = b / 1024, sb = b % 1024, swz = sb ^ (((sb >> 9) & 1) << 5); R = (st >> 1) * 16 + swz / 64; C = (st & 1) * 32 + (swz % 64) / 2; }
__host__ __device__ __forceinline__ int perm32(int rho) { const int n = rho >> 4, i = rho & 15; return 8 * (i >> 2) + 4 * n + (i & 3); }

struct Unit { int pm, pn; };
struct Gemm { const bf16_t* A; const bf16_t* Bt; int M, N, K, lda, ldb, acs; };

struct StaticOrder {
    int nM, nN, nwg, G, c, rep;
    __host__ __device__ void init(int M, int N, int G_, int c_, int rep_ = 1) { nM = M / BM; nN = N / BM; nwg = nM * nN; G = G_; c = c_; rep = rep_; }
    __host__ __device__ bool next(int i, Unit& u) const {
        const int R = (nwg + G - 1) / G;
        if (i >= R * rep) return false;
        const long L = (long)(i % R) * G + c; if (L >= nwg) return (i + 1 < R * rep) ? next(i + 1, u) : false;
        int wgid = (int)L; { const int q = nwg / NXCD, r = nwg % NXCD, xcd = wgid % NXCD, off = wgid / NXCD; wgid = (xcd < r ? xcd * (q + 1) : r * (q + 1) + (xcd - r) * q) + off; }
        const int nig = WGM * nN, gid = wgid / nig, fm = gid * WGM, gsz = (nM - fm) < WGM ? (nM - fm) : WGM;
        u.pm = fm + ((wgid % nig) % gsz); u.pn = (wgid % nig) / gsz; return true;
    }
    __device__ __forceinline__ void a_ready(const Unit&) const {}
    __device__ __forceinline__ void done(const Unit&) const {}
};


__device__ __forceinline__ unsigned cvt_pk_bf16(float lo, float hi) { unsigned r; asm volatile("v_cvt_pk_bf16_f32 %0, %1, %2" : "=v"(r) : "v"(lo), "v"(hi)); return r; }

struct EpiF32 {
    static constexpr bool PERM = false, AFTER_DRAIN = false;
    float* C; int ldc;
    __device__ __forceinline__ void operator()(const f32x4 (&acc)[2][2][4][2], const Unit& u, int wr, int wc, int fr, int fq) const {
        const int row0 = u.pm * BM + wr * 64 + fr, col0 = u.pn * BM + wc * 32 + 4 * fq;
#pragma unroll
        for (int ai = 0; ai < 2; ++ai)
#pragma unroll
            for (int m = 0; m < 4; ++m) { float* rowp = C + (size_t)(row0 + ai * HALF + m * 16) * ldc + col0;
#pragma unroll
                for (int bj = 0; bj < 2; ++bj)
#pragma unroll
                    for (int n = 0; n < 2; ++n) *(f32x4*)(rowp + bj * HALF + n * 16) = acc[ai][bj][m][n]; }
    }
};
template <int ACT> struct EpiBf16 {
    static constexpr bool PERM = true, AFTER_DRAIN = false;
    bf16_t* O; int ldc; int col_off; const float* colscale;
    __device__ __forceinline__ void operator()(const f32x4 (&acc)[2][2][4][2], const Unit& u, int wr, int wc, int fr, int fq) const {
        const int row0 = u.pm * BM + wr * 64 + fr; const int col0 = u.pn * BM + wc * 32 + 8 * fq;
#pragma unroll
        for (int bj = 0; bj < 2; ++bj) {
            f32x4 sv0 = (f32x4){1.f, 1.f, 1.f, 1.f}, sv1 = sv0;
            if (ACT == 0) { sv0 = *(const f32x4*)(colscale + col0 + bj * HALF); sv1 = *(const f32x4*)(colscale + col0 + bj * HALF + 4); }
#pragma unroll
            for (int ai = 0; ai < 2; ++ai)
#pragma unroll
                for (int m = 0; m < 4; ++m) { bf16_t* rowp = O + (size_t)(row0 + ai * HALF + m * 16) * ldc + col_off + col0;
                    f32x4 v0 = acc[ai][bj][m][0], v1 = acc[ai][bj][m][1];
                    if (ACT == 0) { v0 = v0 * sv0; v1 = v1 * sv1; }
                    if (ACT == 1) {
#pragma unroll
                        for (int j = 0; j < 4; ++j) { const float a = fmaxf(v0[j], 0.f), b = fmaxf(v1[j], 0.f); v0[j] = a * a; v1[j] = b * b; } }
                    u32x4 w; w.x = cvt_pk_bf16(v0[0], v0[1]); w.y = cvt_pk_bf16(v0[2], v0[3]); w.z = cvt_pk_bf16(v1[0], v1[1]); w.w = cvt_pk_bf16(v1[2], v1[3]);
                    *(u32x4*)(rowp + bj * HALF) = w; }
        }
    }
};
struct EpiRes {
    static constexpr bool PERM = false, AFTER_DRAIN = false;
    float* C; const float* R;
    __device__ __forceinline__ void operator()(const f32x4 (&acc)[2][2][4][2], const Unit& u, int wr, int wc, int fr, int fq) const {
        const int row0 = u.pm * BM + wr * 64 + fr, col0 = u.pn * BM + wc * 32 + 4 * fq;
#pragma unroll
        for (int ai = 0; ai < 2; ++ai)
#pragma unroll
            for (int m = 0; m < 4; ++m) { const size_t off = (size_t)(row0 + ai * HALF + m * 16) * 2048 + col0;
#pragma unroll
                for (int bj = 0; bj < 2; ++bj)
#pragma unroll
                    for (int n = 0; n < 2; ++n) { const f32x4 rv = *(const f32x4*)(R + off + bj * HALF + n * 16);
                        *(f32x4*)(C + off + bj * HALF + n * 16) = acc[ai][bj][m][n] + rv; } }
    }
};


template <class Epi, class Sched, bool ALIGN_EPI = false, bool SP2 = false>
__device__ __forceinline__ void gemm_phase(PG8_LAS unsigned char* lds, const Gemm g, const Sched& S, const Epi& E) {
    const int tid = threadIdx.x, wid = __builtin_amdgcn_readfirstlane(tid >> 6), lane = tid & 63, wr = wid >> 2, wc = wid & 3, fr = lane & 15, fq = lane >> 4;
    const int K = g.K, nt = K / BK;
    unsigned voffA[2], voffB[2];
#pragma unroll
    for (int i = 0; i < 2; ++i) { int R, C; stage_rc(tid * 16 + i * 8192, R, C); const int Rb = Epi::PERM ? ((R & ~31) + perm32(R & 31)) : R;
        voffA[i] = (unsigned)(R * g.lda + C) * 2u; voffB[i] = (unsigned)(Rb * g.ldb + C) * 2u; }
    const size_t kstep = (size_t)(BK * 2);
    const size_t hstepA = (size_t)HALF * g.lda * 2, hstepB = (size_t)HALF * g.ldb * 2;
    const size_t tstepA = 2 * hstepA, tstepB = 2 * hstepB;
    const size_t acs2 = (size_t)g.acs * 2;
    const unsigned ldsw = (unsigned)wid * 1024u;
    const int aoff = lds_byte(wr * 64 + fr, fq * 8), boff = lds_byte(wc * 32 + fr, fq * 8);
#define PG8_SA(b, h) (((b) * 2 + (h)) * HTB)
#define PG8_SB(b, h) ((4 + (b) * 2 + (h)) * HTB)
#define PG8_STAGE(bufoff, gbase, voff) do { _Pragma("unroll") for (int _i = 0; _i < 2; ++_i) \
        __builtin_amdgcn_global_load_lds((const unsigned*)((const char*)(gbase) + (voff)[_i]), (PG8_LAS unsigned*)(lds + (bufoff) + ldsw + _i * 8192), 16, 0, 0); } while (0)
#define PG8_LDA(dst, b, h) do { _Pragma("unroll") for (int m = 0; m < 4; ++m) _Pragma("unroll") for (int k = 0; k < 2; ++k) dst[m][k] = *(const PG8_LAS bf16x8*)(lds + PG8_SA(b, h) + aoff + m * 2048 + k * 1024); } while (0)
#define PG8_LDB(dst, b, h) do { _Pragma("unroll") for (int n = 0; n < 2; ++n) _Pragma("unroll") for (int k = 0; k < 2; ++k) dst[n][k] = *(const PG8_LAS bf16x8*)(lds + PG8_SB(b, h) + boff + n * 2048 + k * 1024); } while (0)
#define PG8_MMA(ai, bj, At, Bt) do { __builtin_amdgcn_s_setprio(1); _Pragma("unroll") for (int m = 0; m < 4; ++m) _Pragma("unroll") for (int n = 0; n < 2; ++n) _Pragma("unroll") for (int k = 0; k < 2; ++k) \
        acc[ai][bj][m][n] = __builtin_amdgcn_mfma_f32_16x16x32_bf16(Bt[n][k], At[m][k], acc[ai][bj][m][n], 0, 0, 0); __builtin_amdgcn_s_setprio(0); } while (0)
#define PG8_WAIT_V(n) asm volatile("s_waitcnt vmcnt(" #n ")" ::: "memory")
#define PG8_WAIT_L(n) asm volatile("s_waitcnt lgkmcnt(" #n ")" ::: "memory")
#define PG8_BAR __builtin_amdgcn_s_barrier()
#define PG8_SCHED __builtin_amdgcn_sched_barrier(0)
    Unit cur, nxt; int ui = 0;
    if (!S.next(0, cur)) return;
    f32x4 acc[2][2][4][2];
#pragma unroll
    for (int a = 0; a < 2; ++a)
#pragma unroll
        for (int b = 0; b < 2; ++b)
#pragma unroll
            for (int m = 0; m < 4; ++m)
#pragma unroll
                for (int n = 0; n < 2; ++n) acc[a][b][m][n] = (f32x4){0.f, 0.f, 0.f, 0.f};
    bf16x8 At[4][2], B0[2][2], B1[2][2];
    const char* cA = (const char*)g.A + (size_t)cur.pm * tstepA + (size_t)cur.pn * acs2; const char* cB = (const char*)g.Bt + (size_t)cur.pn * tstepB;
    S.a_ready(cur);
    if constexpr (SP2) {
        PG8_STAGE(PG8_SB(0, 0), cB, voffB); PG8_STAGE(PG8_SB(0, 1), cB + hstepB, voffB); PG8_STAGE(PG8_SA(0, 0), cA, voffA); PG8_STAGE(PG8_SA(0, 1), cA + hstepA, voffA);
        if (wr == 1) PG8_BAR;
        PG8_WAIT_V(2); PG8_BAR;
        PG8_STAGE(PG8_SB(1, 0), cB + kstep, voffB); PG8_STAGE(PG8_SA(1, 0), cA + kstep, voffA); PG8_STAGE(PG8_SB(1, 1), cB + hstepB + kstep, voffB);
        PG8_WAIT_V(6); PG8_BAR;
    } else {
        PG8_STAGE(PG8_SB(0, 0), cB, voffB); PG8_STAGE(PG8_SA(0, 0), cA, voffA); PG8_STAGE(PG8_SB(0, 1), cB + hstepB, voffB); PG8_STAGE(PG8_SA(0, 1), cA + hstepA, voffA);
        if (wr == 1) PG8_BAR;
        PG8_WAIT_V(4); PG8_BAR;
        PG8_STAGE(PG8_SB(1, 0), cB + kstep, voffB); PG8_STAGE(PG8_SA(1, 0), cA + kstep, voffA); PG8_STAGE(PG8_SB(1, 1), cB + hstepB + kstep, voffB);
        PG8_WAIT_V(6); PG8_BAR;
    }
    for (;;) {
        const bool has_next = S.next(ui + 1, nxt);
        const char* nA = has_next ? (const char*)g.A + (size_t)nxt.pm * tstepA + (size_t)nxt.pn * acs2 : cA; const char* nB = has_next ? (const char*)g.Bt + (size_t)nxt.pn * tstepB : cB;
        for (int t = 0; t < nt; t += 2) {
            const bool last = (t == nt - 2);
            const char* a1 = cA + (size_t)(t + 1) * kstep;
            const char* a2 = last ? nA : cA + (size_t)(t + 2) * kstep; const char* b2 = last ? nB : cB + (size_t)(t + 2) * kstep;
            const char* a3 = a2 + kstep; const char* b3 = b2 + kstep;
            if (last && has_next) S.a_ready(nxt);
            if constexpr (SP2) {
            PG8_LDB(B0, 0, 0); PG8_LDB(B1, 0, 1); PG8_SCHED; PG8_LDA(At, 0, 0); PG8_STAGE(PG8_SA(1, 1), a1 + hstepA, voffA);
            PG8_WAIT_V(8); PG8_WAIT_L(0); PG8_BAR; PG8_MMA(0, 0, At, B0); PG8_MMA(0, 1, At, B1); PG8_BAR; PG8_SCHED;
            PG8_LDA(At, 0, 1); PG8_STAGE(PG8_SB(0, 0), b2, voffB); PG8_STAGE(PG8_SB(0, 1), b2 + hstepB, voffB); PG8_STAGE(PG8_SA(0, 0), a2, voffA);
            PG8_WAIT_V(8); PG8_WAIT_L(0); PG8_BAR; PG8_MMA(1, 0, At, B0); PG8_MMA(1, 1, At, B1); PG8_BAR; PG8_SCHED;
            PG8_LDB(B0, 1, 0); PG8_LDB(B1, 1, 1); PG8_SCHED; PG8_LDA(At, 1, 0); PG8_STAGE(PG8_SA(0, 1), a2 + hstepA, voffA);
            PG8_WAIT_V(8); PG8_WAIT_L(0); PG8_BAR; PG8_MMA(0, 0, At, B0); PG8_MMA(0, 1, At, B1); PG8_BAR; PG8_SCHED;
            PG8_LDA(At, 1, 1); PG8_STAGE(PG8_SB(1, 0), b3, voffB); PG8_STAGE(PG8_SB(1, 1), b3 + hstepB, voffB); PG8_STAGE(PG8_SA(1, 0), a3, voffA);
            PG8_WAIT_V(8); PG8_WAIT_L(0); PG8_BAR; PG8_MMA(1, 0, At, B0); PG8_MMA(1, 1, At, B1); PG8_BAR; PG8_SCHED;
            } else {
            PG8_LDB(B0, 0, 0); PG8_SCHED; PG8_LDA(At, 0, 0); PG8_STAGE(PG8_SA(1, 1), a1 + hstepA, voffA);
            PG8_WAIT_L(8); PG8_BAR; PG8_WAIT_L(0); PG8_MMA(0, 0, At, B0); PG8_BAR; PG8_SCHED;
            PG8_LDB(B1, 0, 1); PG8_STAGE(PG8_SB(0, 0), b2, voffB);
            PG8_BAR; PG8_WAIT_L(0); PG8_MMA(0, 1, At, B1); PG8_BAR;
            PG8_LDA(At, 0, 1); PG8_STAGE(PG8_SA(0, 0), a2, voffA);
            PG8_BAR; PG8_WAIT_L(0); PG8_MMA(1, 0, At, B0); PG8_BAR; PG8_SCHED;
            PG8_STAGE(PG8_SB(0, 1), b2 + hstepB, voffB);
            PG8_WAIT_V(6); PG8_BAR; PG8_MMA(1, 1, At, B1); PG8_BAR;
            PG8_LDB(B0, 1, 0); PG8_SCHED; PG8_LDA(At, 1, 0); PG8_STAGE(PG8_SA(0, 1), a2 + hstepA, voffA);
            PG8_WAIT_L(8); PG8_BAR; PG8_WAIT_L(0); PG8_MMA(0, 0, At, B0); PG8_BAR; PG8_SCHED;
            PG8_LDB(B1, 1, 1); PG8_STAGE(PG8_SB(1, 0), b3, voffB);
            PG8_BAR; PG8_WAIT_L(0); PG8_MMA(0, 1, At, B1); PG8_BAR;
            PG8_LDA(At, 1, 1); PG8_STAGE(PG8_SA(1, 0), a3, voffA);
            PG8_BAR; PG8_WAIT_L(0); PG8_MMA(1, 0, At, B0); PG8_BAR; PG8_SCHED;
            PG8_STAGE(PG8_SB(1, 1), b3 + hstepB, voffB);
            PG8_WAIT_V(6); PG8_BAR; PG8_MMA(1, 1, At, B1); PG8_BAR;
            }
        }
        if constexpr (ALIGN_EPI) { if (wr == 0) PG8_BAR; }
        if constexpr (!Epi::AFTER_DRAIN) { E(acc, cur, wr, wc, fr, fq); S.done(cur); }
        if (!has_next) break;
#pragma unroll
        for (int a = 0; a < 2; ++a)
#pragma unroll
            for (int b = 0; b < 2; ++b)
#pragma unroll
                for (int m = 0; m < 4; ++m)
#pragma unroll
                    for (int n = 0; n < 2; ++n) acc[a][b][m][n] = (f32x4){0.f, 0.f, 0.f, 0.f};
        cur = nxt; cA = nA; cB = nB; ++ui;
        if constexpr (ALIGN_EPI) { if (wr == 1) PG8_BAR; }
    }
    PG8_WAIT_V(0);
    if constexpr (!ALIGN_EPI) { if (wr == 0) PG8_BAR; }
    PG8_BAR;
    if constexpr (Epi::AFTER_DRAIN) { E.fused(acc, cur, wr, wc, fr, fq, lds, wid, lane); S.done(cur); }
#undef PG8_SA
#undef PG8_SB
#undef PG8_STAGE
#undef PG8_LDA
#undef PG8_LDB
#undef PG8_MMA
#undef PG8_WAIT_V
#undef PG8_WAIT_L
#undef PG8_BAR
#undef PG8_SCHED
}
}

#ifndef PG8_SP2
#define PG8_SP2 true
#endif
#ifndef PG8_ALIGN
#define PG8_ALIGN true
#endif
#ifndef MK_ONE_LAUNCH
#define MK_ONE_LAUNCH 1
#endif

constexpr int DM = 2048, SEQ = 8192, NMETA = 16, TP = SEQ + NMETA, DB = 128, MR = TP + DB, MP = 8448;
constexpr int HD = 128, NH = 8, NKV = 2, NIH = 16, IDD = 64, TOPK = 256, NZR = 3664, NZ = 3840, DFF = 8192;
constexpr int PAST = 2048, PAGE = 128, NPAGES = 16, LS = PAST + 1;
constexpr int ZQ = 0, ZK = 1024, ZV = 1280, ZQI = 1536, ZKI = 2560, ZWI = 2624, ZU = 2640;
constexpr float EPS = 1e-6f;
constexpr int SCLD = 8704, SCROWS = 8224, SCSLD = 2560;
constexpr size_t O_YP = 0, O_YS = O_YP + (size_t)SEQ * DM, O_KP = O_YS + (size_t)DB * DM, O_VP = O_KP + (size_t)TP * 256, O_KIP = O_VP + (size_t)TP * 256,
                 O_PP = O_KIP + (size_t)TP * 64, O_KS = O_PP + 15 * 1024, O_VS = O_KS + DB * 256, O_KIS = O_VS + DB * 256, O_PS = O_KIS + DB * 64, O_END = O_PS + (size_t)DB * 15 * 1024;
constexpr size_t MiB = 1u << 20;
constexpr size_t WS_CTL = 0, WS_WIN = 2 * MiB, WS_WOUT = 18 * MiB, WS_WUP = 26 * MiB, WS_WDN = 58 * MiB, WS_WPOOL = 90 * MiB, WS_XN = 92 * MiB, WS_Z = 126 * MiB,
                 WS_QF = 250 * MiB, WS_QI = 284 * MiB, WS_KI = 302 * MiB, WS_WI = 304 * MiB, WS_U = 306 * MiB, WS_QI32 = 340 * MiB, WS_SCS = 341 * MiB, WS_SEL = 344 * MiB,
                 WS_DPOOL = 356 * MiB, WS_CAT = 374 * MiB, WS_H1 = 408 * MiB, WS_ACT = 476 * MiB, WS_H2 = 608 * MiB, WS_SC = 676 * MiB, WS_PS1 = 936 * MiB, WS_PS2 = 944 * MiB, WS_QB = 952 * MiB, WS_KB = 970 * MiB, WS_VB = 975 * MiB, WS_QL = 980 * MiB, WS_CS = 984 * MiB, WS_END = 992 * MiB;
static_assert(WS_Z + (size_t)MP * NZ * 4 <= WS_QF && WS_SC + (size_t)SCROWS * SCLD * 2 <= WS_PS1 && WS_ACT + (size_t)MP * DFF * 2 <= WS_H2, "ws map");
constexpr int LDS_BYTES = 163840;
constexpr int NPH = 12;

#define LAS __attribute__((address_space(3)))
typedef unsigned short bf16;
typedef unsigned v4u __attribute__((ext_vector_type(4)));
typedef float f32x4 __attribute__((ext_vector_type(4)));
typedef float f32x16 __attribute__((ext_vector_type(16)));
typedef _Float16 f16x8 __attribute__((ext_vector_type(8)));
typedef _Float16 f16;
__device__ __forceinline__ unsigned pkh2(float a, float b) { typedef _Float16 h2v __attribute__((ext_vector_type(2))); const h2v v = {(_Float16)a, (_Float16)b}; return __builtin_bit_cast(unsigned, v); }
typedef short bf16x8_t __attribute__((ext_vector_type(8)));

__device__ const double INV_FREQ[64] = { 1.00000000000000000e+00, 8.65964323360065347e-01, 7.49894209332455874e-01, 6.49381631576211316e-01, 5.62341325190349073e-01, 4.86967525165863113e-01, 4.21696503428582226e-01, 3.65174127254837722e-01, 3.16227766016837941e-01, 2.73841963426436130e-01, 2.37137370566165517e-01, 2.05352502645714613e-01, 1.77827941003892293e-01, 1.53992652605949187e-01, 1.33352143216332403e-01, 1.15478198468945817e-01, 1.00000000000000006e-01, 8.65964323360065291e-02, 7.49894209332455791e-02, 6.49381631576211316e-02, 5.62341325190349114e-02, 4.86967525165863113e-02, 4.21696503428582239e-02, 3.65174127254837694e-02, 3.16227766016837913e-02, 2.73841963426436144e-02, 2.37137370566165538e-02, 2.05352502645714599e-02, 1.77827941003892293e-02, 1.53992652605949194e-02, 1.33352143216332406e-02, 1.15478198468945813e-02, 1.00000000000000002e-02, 8.65964323360065430e-03, 7.49894209332455791e-03, 6.49381631576211298e-03, 5.62341325190349097e-03, 4.86967525165863096e-03, 4.21696503428582292e-03, 3.65174127254837711e-03, 3.16227766016837939e-03, 2.73841963426436127e-03, 2.37137370566165538e-03, 2.05352502645714599e-03, 1.77827941003892275e-03, 1.53992652605949203e-03, 1.33352143216332406e-03, 1.15478198468945813e-03, 1.00000000000000002e-03, 8.65964323360065387e-04, 7.49894209332455856e-04, 6.49381631576211342e-04, 5.62341325190349097e-04, 4.86967525165863096e-04, 4.21696503428582237e-04, 3.65174127254837700e-04, 3.16227766016837939e-04, 2.73841963426436105e-04, 2.37137370566165538e-04, 2.05352502645714610e-04, 1.77827941003892270e-04, 1.53992652605949192e-04, 1.33352143216332395e-04, 1.15478198468945822e-04 };

struct Args { const float* in[17]; float* out; unsigned char* ws; int ph_lo, ph_hi; };
constexpr int CW_BAR = 4096;
constexpr int LDSCTL_OFF = 159744, MISC_OFF = LDSCTL_OFF + 320;

#define LDS_WAIT() asm volatile("s_waitcnt lgkmcnt(0)" ::: "memory")
__device__ __forceinline__ unsigned f2bf(float f) { unsigned u = __builtin_bit_cast(unsigned, f); return (u + 0x7fffu + ((u >> 16) & 1u)) >> 16; }
__device__ __forceinline__ unsigned pk2(float lo, float hi) { unsigned r; asm("v_cvt_pk_bf16_f32 %0, %1, %2" : "=v"(r) : "v"(lo), "v"(hi)); return r; }
template <int CTRL, int ROWMASK> __device__ __forceinline__ float dpp_f0(float v) { return __builtin_bit_cast(float, __builtin_amdgcn_update_dpp(0, __builtin_bit_cast(int, v), CTRL, ROWMASK, 0xf, false)); }
__device__ __forceinline__ float wave_sum(float v) {
    v += dpp_f0<0x111, 0xf>(v); v += dpp_f0<0x112, 0xf>(v); v += dpp_f0<0x114, 0xf>(v); v += dpp_f0<0x118, 0xf>(v); v += dpp_f0<0x142, 0xa>(v); v += dpp_f0<0x143, 0xc>(v);
    return __builtin_bit_cast(float, __builtin_amdgcn_readlane(__builtin_bit_cast(int, v), 63));
}
__device__ __forceinline__ const float* in_row(const Args& a, int r) {
    return r < NMETA ? a.in[7] + (size_t)r * DM : r < TP ? a.in[0] + (size_t)(r - NMETA) * DM : r < MR ? a.in[1] + (size_t)(r - TP) * DM : (const float*)nullptr;
}

__device__ __forceinline__ int win_src_col(int n) {
    const int pn = n >> 8, c = n & 255, half = c >> 7, cc = c & 127;
    if (pn < 4) return ZQ + (2 * pn + (cc >> 6)) * 128 + half * 64 + (cc & 63);
    if (pn == 4) return ZK + (cc >> 6) * 128 + half * 64 + (cc & 63);
    if (pn == 5) return ZV + c;
    if (pn < 10) return ZQI + (4 * (pn - 6) + (cc >> 5)) * 64 + half * 32 + (cc & 31);
    if (pn == 10) return c < 32 ? ZKI + c : c < 48 ? ZWI + (c - 32) : (c >= 128 && c < 160) ? ZKI + 32 + (c - 128) : -1;
    return ZU + (pn - 11) * 256 + c;
}
template <bool WIN = false>
__device__ __forceinline__ void p0_transpose_item(const float* W, int K, int N, bf16* WT, LAS float* scr, int item, int nblk, int lane) {
    const int kb = item / nblk, nb = item % nblk, k0 = 64 * kb, n0 = 32 * nb;
    const int n_rd = WIN ? win_src_col(n0 + (lane & 31)) : ((n0 + (lane & 31)) < N ? n0 + (lane & 31) : -1);
    float rv[32];
#pragma unroll
    for (int i = 0; i < 32; ++i) { const int kk = 2 * i + (lane >> 5); rv[i] = n_rd >= 0 ? W[(size_t)(k0 + kk) * N + n_rd] : 0.f; }
#pragma unroll
    for (int i = 0; i < 32; ++i) { const int kk = 2 * i + (lane >> 5); scr[kk * 33 + (lane & 31)] = rv[i]; }
    LDS_WAIT();
    const int c = lane & 7;
#pragma unroll
    for (int j = 0; j < 4; ++j) { const int n = (lane >> 3) + 8 * j; const LAS float* s = scr + (8 * c) * 33 + n;
        v4u o; o.x = pk2(s[0 * 33], s[1 * 33]); o.y = pk2(s[2 * 33], s[3 * 33]); o.z = pk2(s[4 * 33], s[5 * 33]); o.w = pk2(s[6 * 33], s[7 * 33]);
        *(v4u*)(WT + (size_t)(n0 + n) * K + k0 + 8 * c) = o; }
    LDS_WAIT();
}
#ifndef CONV_IN_ATTN
#define CONV_IN_ATTN 1
#endif
constexpr int CV_OUT = 32 * 64, CV_UP = 32 * 256, CV_DN = 128 * 64, CV_N = CV_OUT + CV_UP + CV_DN;
__device__ __forceinline__ void conv_item(const Args& a, LAS float* scr, int it, int lane) {
    unsigned char* ws = a.ws;
    if (it < CV_OUT) { p0_transpose_item(a.in[12], DM, DM, (bf16*)(ws + WS_WOUT), scr, it, 64, lane); return; } it -= CV_OUT;
    if (it < CV_UP) { p0_transpose_item(a.in[14], DM, DFF, (bf16*)(ws + WS_WUP), scr, it, 256, lane); return; } it -= CV_UP;
    p0_transpose_item(a.in[15], DFF, DM, (bf16*)(ws + WS_WDN), scr, it, 64, lane);
}
__device__ __forceinline__ void p0_transpose_pair(const float* W, int K, int N, bf16* WT, LAS float* scrA, LAS float* scrB, int itemA, int itemB, int nblk, int lane) {
    const int k0a = 64 * (itemA / nblk), n0a = 32 * (itemA % nblk), k0b = 64 * (itemB / nblk), n0b = 32 * (itemB % nblk);
    const int na = n0a + (lane & 31), nb = n0b + (lane & 31);
    float ra[32], rb[32];
#pragma unroll
    for (int i = 0; i < 32; ++i) { const int kk = 2 * i + (lane >> 5); ra[i] = W[(size_t)(k0a + kk) * N + na]; rb[i] = W[(size_t)(k0b + kk) * N + nb]; }
#pragma unroll
    for (int i = 0; i < 32; ++i) { const int kk = 2 * i + (lane >> 5); scrA[kk * 33 + (lane & 31)] = ra[i]; scrB[kk * 33 + (lane & 31)] = rb[i]; }
    LDS_WAIT();
    const int c = lane & 7;
#pragma unroll
    for (int j = 0; j < 4; ++j) { const int n = (lane >> 3) + 8 * j; const LAS float* sa = scrA + (8 * c) * 33 + n; const LAS float* sb = scrB + (8 * c) * 33 + n;
        v4u o; o.x = pk2(sa[0 * 33], sa[1 * 33]); o.y = pk2(sa[2 * 33], sa[3 * 33]); o.z = pk2(sa[4 * 33], sa[5 * 33]); o.w = pk2(sa[6 * 33], sa[7 * 33]);
        *(v4u*)(WT + (size_t)(n0a + n) * K + k0a + 8 * c) = o;
        v4u q; q.x = pk2(sb[0 * 33], sb[1 * 33]); q.y = pk2(sb[2 * 33], sb[3 * 33]); q.z = pk2(sb[4 * 33], sb[5 * 33]); q.w = pk2(sb[6 * 33], sb[7 * 33]);
        *(v4u*)(WT + (size_t)(n0b + n) * K + k0b + 8 * c) = q; }
    LDS_WAIT();
}
__device__ __forceinline__ void conv_pair(const Args& a, LAS float* scrA, LAS float* scrB, int itA, int itB, int lane) {
    unsigned char* ws = a.ws;
    if (itB < CV_OUT) { p0_transpose_pair(a.in[12], DM, DM, (bf16*)(ws + WS_WOUT), scrA, scrB, itA, itB, 64, lane); return; }
    if (itA >= CV_OUT && itB < CV_OUT + CV_UP) { p0_transpose_pair(a.in[14], DM, DFF, (bf16*)(ws + WS_WUP), scrA, scrB, itA - CV_OUT, itB - CV_OUT, 256, lane); return; }
    if (itA >= CV_OUT + CV_UP) { p0_transpose_pair(a.in[15], DFF, DM, (bf16*)(ws + WS_WDN), scrA, scrB, itA - CV_OUT - CV_UP, itB - CV_OUT - CV_UP, 64, lane); return; }
    conv_item(a, scrA, itA, lane); conv_item(a, scrA, itB, lane);
}
struct CvTile { const float* src; bf16* dst; int K, N; };
__device__ __forceinline__ CvTile cv_decode(const Args& a, int it) {
    unsigned char* ws = a.ws; CvTile t; int nblk;
    if (it < CV_OUT) { t.src = a.in[12]; t.dst = (bf16*)(ws + WS_WOUT); t.K = DM; t.N = DM; nblk = 64; }
    else if (it < CV_OUT + CV_UP) { it -= CV_OUT; t.src = a.in[14]; t.dst = (bf16*)(ws + WS_WUP); t.K = DM; t.N = DFF; nblk = 256; }
    else { it -= CV_OUT + CV_UP; t.src = a.in[15]; t.dst = (bf16*)(ws + WS_WDN); t.K = DFF; t.N = DM; nblk = 64; }
    const int k0 = 64 * (it / nblk), n0 = 32 * (it % nblk);
    t.src += (size_t)k0 * t.N + n0; t.dst += (size_t)n0 * t.K + k0; return t;
}
__device__ __forceinline__ void cv_load(f32x4 (&r)[8], const CvTile& t, int lane) {
#pragma unroll
    for (int i = 0; i < 8; ++i) r[i] = *(const f32x4*)(t.src + (size_t)(8 * i + (lane >> 3)) * t.N + 4 * (lane & 7));
}
__device__ __forceinline__ void cv_store(const f32x4 (&r)[8], const CvTile& t, LAS float* scr, int lane) {
#pragma unroll
    for (int i = 0; i < 8; ++i) { LAS float* w = scr + (8 * i + (lane >> 3)) * 33 + 4 * (lane & 7); w[0] = r[i].x; w[1] = r[i].y; w[2] = r[i].z; w[3] = r[i].w; }
    LDS_WAIT();
    const int c = lane & 7;
#pragma unroll
    for (int j = 0; j < 4; ++j) { const int n = (lane >> 3) + 8 * j; const LAS float* sp = scr + (8 * c) * 33 + n;
        v4u o; o.x = pk2(sp[0 * 33], sp[1 * 33]); o.y = pk2(sp[2 * 33], sp[3 * 33]); o.z = pk2(sp[4 * 33], sp[5 * 33]); o.w = pk2(sp[6 * 33], sp[7 * 33]);
        *(v4u*)(t.dst + (size_t)n * t.K + 8 * c) = o; }
    LDS_WAIT();
}
__device__ __forceinline__ void cv_stream(const Args& a, LAS float* scrA, LAS float* scrB, int first, int step, int lane) {
    if (first >= CV_N) return;
    f32x4 rA[8], rB[8], rC[8], rD[8];
    int it = first;
    CvTile tA = cv_decode(a, it), tB = cv_decode(a, it + step < CV_N ? it + step : it); bool vB = it + step < CV_N;
    cv_load(rA, tA, lane); cv_load(rB, tB, lane);
    for (;;) {
        const int i2 = it + 2 * step; const bool vC = i2 < CV_N, vD = i2 + step < CV_N;
        const CvTile tC = cv_decode(a, vC ? i2 : it), tD = cv_decode(a, vD ? i2 + step : it);
        cv_load(rC, tC, lane); cv_load(rD, tD, lane);
        cv_store(rA, tA, scrA, lane); if (vB) cv_store(rB, tB, scrB, lane);
        if (!vC) break;
        const int i4 = it + 4 * step; const bool vA = i4 < CV_N; vB = i4 + step < CV_N;
        tA = cv_decode(a, vA ? i4 : i2); tB = cv_decode(a, vB ? i4 + step : i2);
        cv_load(rA, tA, lane); cv_load(rB, tB, lane);
        cv_store(rC, tC, scrA, lane); if (vD) cv_store(rD, tD, scrB, lane);
        if (!vA) break;
        it = i4;
    }
}
__device__ __forceinline__ void rms_row_to_bf16(const float* xrow, const float* gain, bf16* orow, int lane) {
    const f32x4* xr = (const f32x4*)xrow + lane; const f32x4* gr = (const f32x4*)gain + lane;
    f32x4 v[8]; float s = 0.f;
#pragma unroll
    for (int j = 0; j < 8; ++j) { v[j] = xr[64 * j]; s += (v[j].x * v[j].x + v[j].y * v[j].y) + (v[j].z * v[j].z + v[j].w * v[j].w); }
    const float rstd = 1.f / sqrtf(wave_sum(s) * (1.f / DM) + EPS);
    unsigned long long* o8 = (unsigned long long*)orow + lane;
#pragma unroll
    for (int j = 0; j < 8; ++j) { const f32x4 g = gr[64 * j]; o8[64 * j] = (unsigned long long)pk2(v[j].x * rstd * g.x, v[j].y * rstd * g.y) | ((unsigned long long)pk2(v[j].z * rstd * g.z, v[j].w * rstd * g.w) << 32); }
}
__device__ __forceinline__ void rms_load(f32x4 (&v)[8], const float* xrow, int lane) {
#pragma unroll
    for (int j = 0; j < 8; ++j) v[j] = *((const f32x4*)xrow + lane + 64 * j);
}
__device__ __forceinline__ void rms_finish(const f32x4 (&v)[8], bool real, const float* gain, bf16* orow, int lane) {
    float s = 0.f;
#pragma unroll
    for (int j = 0; j < 8; ++j) s += (v[j].x * v[j].x + v[j].y * v[j].y) + (v[j].z * v[j].z + v[j].w * v[j].w);
    const float rstd = real ? 1.f / sqrtf(wave_sum(s) * (1.f / DM) + EPS) : 0.f;
    const f32x4* gr = (const f32x4*)gain + lane; unsigned long long* o8 = (unsigned long long*)orow + lane;
#pragma unroll
    for (int j = 0; j < 8; ++j) { const f32x4 g = gr[64 * j]; o8[64 * j] = (unsigned long long)pk2(v[j].x * rstd * g.x, v[j].y * rstd * g.y) | ((unsigned long long)pk2(v[j].z * rstd * g.z, v[j].w * rstd * g.w) << 32); }
}
__device__ __forceinline__ void rope_cs(int pos, int j, float& c, float& s) {
    const double rev = (double)pos * INV_FREQ[j] * 0.15915494309189535;
    const float fr = (float)(rev - __builtin_rint(rev)); c = __builtin_amdgcn_cosf(fr); s = __builtin_amdgcn_sinf(fr);
}
__device__ __forceinline__ void p0_prep(const Args& a, LAS unsigned char* lds, int gw, int NGW, int wave, int lane) {
    LAS float* scr = (LAS float*)(lds + wave * 16384);
    unsigned char* ws = a.ws;
    constexpr int I_IN = 32 * 120, I_PL = 4 * 32;
    for (int it = gw; it < I_IN + I_PL + (CONV_IN_ATTN ? 0 : CV_N); it += NGW) {
        if (it < I_IN) p0_transpose_item<true>(a.in[9], DM, NZR, (bf16*)(ws + WS_WIN), scr, it, 120, lane);
        else if (it < I_IN + I_PL) { const int r = it - I_IN, g = r >> 5; p0_transpose_item(a.in[10] + (size_t)g * 65536, 256, 256, (bf16*)(ws + WS_WPOOL) + (size_t)g * 65536, scr, r & 31, 8, lane); }
        else conv_item(a, scr, it - I_IN - I_PL, lane);
    }
    bf16* XN = (bf16*)(ws + WS_XN);
    {
        f32x4 va[8], vb[8];
        const bool remap = NGW == 2048 && MP == 4 * 2048 + 256; const int e_ = gw - (NGW - 128);
#define ROWK(k) (!remap ? (gw + (k) * NGW < MP ? gw + (k) * NGW : MP) : ((k) < 4 ? gw + (k) * NGW : ((e_ >= 0 && (k) < 6) ? 8192 + 2 * e_ + ((k) - 4) : MP)))
        int k = 0, m = ROWK(0); { const float* p0_ = m < MP ? in_row(a, m) : nullptr; rms_load(va, p0_ ? p0_ : a.in[0], lane); }
#pragma unroll 1
        for (;;) {
            const int m1 = ROWK(k + 1); { const float* p_ = m1 < MP ? in_row(a, m1) : nullptr; rms_load(vb, p_ ? p_ : a.in[0], lane); }
            if (m < MP) rms_finish(va, in_row(a, m) != nullptr, a.in[8], XN + (size_t)m * DM, lane);
            if (m1 >= MP) break;
            const int m2 = ROWK(k + 2); { const float* p_ = m2 < MP ? in_row(a, m2) : nullptr; rms_load(va, p_ ? p_ : a.in[0], lane); }
            rms_finish(vb, in_row(a, m1) != nullptr, a.in[8], XN + (size_t)m1 * DM, lane);
            if (m2 >= MP) break;
            m = m2; k += 2;
        }
#undef ROWK
    }
    float* CS = (float*)(ws + WS_CS);
    const bool cs_remap = NGW == 2048 && TP == 4 * 2048 + 16;
    for (int kk = 0; ; ++kk) { int pos = gw + kk * NGW; if (cs_remap && kk == 4) pos = gw >= NGW - 16 ? 8192 + (gw - (NGW - 16)) : TP; if (pos >= TP) break;
        float c1, s1; rope_cs(pos, lane, c1, s1); CS[(size_t)pos * 192 + lane] = c1; CS[(size_t)pos * 192 + 64 + lane] = s1;
        if (lane < 32) { float c2, s2; rope_cs(pos, 2 * lane, c2, s2); CS[(size_t)pos * 192 + 128 + lane] = c2; CS[(size_t)pos * 192 + 160 + lane] = s2; } }
}
__device__ __forceinline__ void pool_state_copy(const Args& a, int w, int nw, int lane) {
    constexpr int NE = DB * 14 * 256;
    for (int i0 = w * 64 + lane; i0 < NE; i0 += 8 * nw * 64) { f32x4 v[8];
#pragma unroll
        for (int j = 0; j < 8; ++j) { const int i = i0 + j * nw * 64; const int ic = i < NE ? i : 0; const int b = ic / (14 * 256), rem = ic % (14 * 256); v[j] = *((const f32x4*)(a.in[5] + ((size_t)b * 15 + 1) * 1024) + rem); }
#pragma unroll
        for (int j = 0; j < 8; ++j) { const int i = i0 + j * nw * 64; if (i < NE) { const int b = i / (14 * 256), rem = i % (14 * 256); *((f32x4*)(a.out + O_PS + (size_t)b * 15 * 1024) + rem) = v[j]; } } }
}

namespace pg8 {
struct EpiIn {
    static constexpr bool PERM = true, AFTER_DRAIN = false;
    float* out; unsigned char* ws;
    __device__ __forceinline__ void operator()(const f32x4 (&acc)[2][2][4][2], const Unit& u, int wr, int wc, int fr, int fq) const {
        constexpr float QSCALE = 0.12751743074602957f;
        typedef _Float16 f16x8v __attribute__((ext_vector_type(8)));
        const float* CS = (const float*)(ws + WS_CS);
        const int pn = u.pn;
        const int c0 = 32 * wc + 8 * fq;
#pragma unroll
        for (int ai = 0; ai < 2; ++ai)
#pragma unroll
            for (int m = 0; m < 4; ++m) {
                const int r = u.pm * BM + ai * HALF + wr * 64 + m * 16 + fr;
                if (r >= MR) continue;
                const bool smp = r >= TP; const int b = r - TP; const float* cs = CS + (size_t)(smp ? PAST : r) * 192;
                if (pn < 5) {
                    const int hd = c0 >> 6, j0 = c0 & 63;
                    f32x4 o1[2], o2[2];
#pragma unroll
                    for (int n = 0; n < 2; ++n) { const f32x4 co = *(const f32x4*)(cs + j0 + 4 * n), si = *(const f32x4*)(cs + 64 + j0 + 4 * n), x1 = acc[ai][0][m][n], x2 = acc[ai][1][m][n];
                        o1[n] = x1 * co - x2 * si; o2[n] = x1 * si + x2 * co; }
                    if (pn < 4) { ::bf16* q = (::bf16*)(ws + WS_QB) + (size_t)r * 1024 + (2 * pn + hd) * 128 + j0;
                        v4u a_, b_; a_.x = pk2(o1[0].x * QSCALE, o1[0].y * QSCALE); a_.y = pk2(o1[0].z * QSCALE, o1[0].w * QSCALE); a_.z = pk2(o1[1].x * QSCALE, o1[1].y * QSCALE); a_.w = pk2(o1[1].z * QSCALE, o1[1].w * QSCALE);
                        b_.x = pk2(o2[0].x * QSCALE, o2[0].y * QSCALE); b_.y = pk2(o2[0].z * QSCALE, o2[0].w * QSCALE); b_.z = pk2(o2[1].x * QSCALE, o2[1].y * QSCALE); b_.w = pk2(o2[1].z * QSCALE, o2[1].w * QSCALE);
                        *(v4u*)q = a_; *(v4u*)(q + 64) = b_; }
                    else { float* ko = (smp ? out + O_KS + (size_t)b * 256 : out + O_KP + (size_t)r * 256) + hd * 128 + j0;
                        *(f32x4*)ko = o1[0]; *(f32x4*)(ko + 4) = o1[1]; *(f32x4*)(ko + 64) = o2[0]; *(f32x4*)(ko + 68) = o2[1];
                        ::bf16* kb = (::bf16*)(ws + WS_KB) + (size_t)r * 256 + hd * 128 + j0;
                        v4u a_, b_; a_.x = pk2(o1[0].x, o1[0].y); a_.y = pk2(o1[0].z, o1[0].w); a_.z = pk2(o1[1].x, o1[1].y); a_.w = pk2(o1[1].z, o1[1].w);
                        b_.x = pk2(o2[0].x, o2[0].y); b_.y = pk2(o2[0].z, o2[0].w); b_.z = pk2(o2[1].x, o2[1].y); b_.w = pk2(o2[1].z, o2[1].w);
                        *(v4u*)kb = a_; *(v4u*)(kb + 64) = b_; }
                } else if (pn == 5) {
#pragma unroll
                    for (int bj = 0; bj < 2; ++bj) { const int c = 128 * bj + c0; const f32x4 v0 = acc[ai][bj][m][0], v1 = acc[ai][bj][m][1];
                        float* vo = (smp ? out + O_VS + (size_t)b * 256 : out + O_VP + (size_t)r * 256) + c; *(f32x4*)vo = v0; *(f32x4*)(vo + 4) = v1;
                        v4u a_; a_.x = pk2(v0.x, v0.y); a_.y = pk2(v0.z, v0.w); a_.z = pk2(v1.x, v1.y); a_.w = pk2(v1.z, v1.w);
                        *(v4u*)((::bf16*)(ws + WS_VB) + (size_t)r * 256 + c) = a_; }
                } else if (pn < 10) {
                    const int hd = 4 * (pn - 6) + (c0 >> 5), j0 = c0 & 31;
                    f32x4 o1[2], o2[2];
#pragma unroll
                    for (int n = 0; n < 2; ++n) { const f32x4 co = *(const f32x4*)(cs + 128 + j0 + 4 * n), si = *(const f32x4*)(cs + 160 + j0 + 4 * n), x1 = acc[ai][0][m][n], x2 = acc[ai][1][m][n];
                        o1[n] = x1 * co - x2 * si; o2[n] = x1 * si + x2 * co; }
                    f16* qi = (f16*)(ws + WS_QI) + (size_t)r * 1024 + hd * 64 + j0;
                    *(f16x8v*)qi = (f16x8v){(f16)o1[0].x, (f16)o1[0].y, (f16)o1[0].z, (f16)o1[0].w, (f16)o1[1].x, (f16)o1[1].y, (f16)o1[1].z, (f16)o1[1].w};
                    *(f16x8v*)(qi + 32) = (f16x8v){(f16)o2[0].x, (f16)o2[0].y, (f16)o2[0].z, (f16)o2[0].w, (f16)o2[1].x, (f16)o2[1].y, (f16)o2[1].z, (f16)o2[1].w};
                    if (smp) { float* q32 = (float*)(ws + WS_QI32) + (size_t)b * 1024 + hd * 64 + j0; *(f32x4*)q32 = o1[0]; *(f32x4*)(q32 + 4) = o1[1]; *(f32x4*)(q32 + 32) = o2[0]; *(f32x4*)(q32 + 36) = o2[1]; }
                } else if (pn == 10) {
                    if (wc == 0) { const int j0 = c0;
                        f32x4 o1[2], o2[2];
#pragma unroll
                        for (int n = 0; n < 2; ++n) { const f32x4 co = *(const f32x4*)(cs + 128 + j0 + 4 * n), si = *(const f32x4*)(cs + 160 + j0 + 4 * n), x1 = acc[ai][0][m][n], x2 = acc[ai][1][m][n];
                            o1[n] = x1 * co - x2 * si; o2[n] = x1 * si + x2 * co; }
                        float* kio = (smp ? out + O_KIS + (size_t)b * 64 : out + O_KIP + (size_t)r * 64) + j0; *(f32x4*)kio = o1[0]; *(f32x4*)(kio + 4) = o1[1]; *(f32x4*)(kio + 32) = o2[0]; *(f32x4*)(kio + 36) = o2[1];
                        f16* ki = (f16*)(ws + WS_KI) + (size_t)r * 64 + j0;
                        *(f16x8v*)ki = (f16x8v){(f16)o1[0].x, (f16)o1[0].y, (f16)o1[0].z, (f16)o1[0].w, (f16)o1[1].x, (f16)o1[1].y, (f16)o1[1].z, (f16)o1[1].w};
                        *(f16x8v*)(ki + 32) = (f16x8v){(f16)o2[0].x, (f16)o2[0].y, (f16)o2[0].z, (f16)o2[0].w, (f16)o2[1].x, (f16)o2[1].y, (f16)o2[1].z, (f16)o2[1].w};
                    } else if (wc == 1 && fq < 2) { float* wo = (float*)(ws + WS_WI) + (size_t)r * 16 + 8 * fq; *(f32x4*)wo = acc[ai][0][m][0] * 0.25f; *(f32x4*)(wo + 4) = acc[ai][0][m][1] * 0.25f; }
                } else {
#pragma unroll
                    for (int bj = 0; bj < 2; ++bj) { const int c = (pn - 11) * 256 + 128 * bj + c0; const f32x4 v0 = acc[ai][bj][m][0], v1 = acc[ai][bj][m][1];
                        { v4u ub_; ub_.x = pk2(v0.x, v0.y); ub_.y = pk2(v0.z, v0.w); ub_.z = pk2(v1.x, v1.y); ub_.w = pk2(v1.z, v1.w); *(v4u*)((::bf16*)(ws + WS_U) + (size_t)r * 1024 + c) = ub_; }
                        if (!smp && r >= TP - 15) { float* po = out + O_PP + (size_t)(r - (TP - 15)) * 1024 + c; *(f32x4*)po = v0; *(f32x4*)(po + 4) = v1; }
                        if (smp) { float* po = out + O_PS + ((size_t)b * 15 + 14) * 1024 + c; *(f32x4*)po = v0; *(f32x4*)(po + 4) = v1; } }
                }
            }
    }
};
template <bool RBF> struct EpiResB {
    static constexpr bool PERM = true, AFTER_DRAIN = false;
    bf16_t* C; const void* R;
    __device__ __forceinline__ void operator()(const f32x4 (&acc)[2][2][4][2], const Unit& u, int wr, int wc, int fr, int fq) const {
        const int row0 = u.pm * BM + wr * 64 + fr, col0 = u.pn * BM + wc * 32 + 8 * fq;
#pragma unroll
        for (int ai = 0; ai < 2; ++ai)
#pragma unroll
            for (int m = 0; m < 4; ++m) { const size_t off = (size_t)(row0 + ai * HALF + m * 16) * 2048 + col0;
#pragma unroll
                for (int bj = 0; bj < 2; ++bj) { f32x4 r0, r1;
                    if (RBF) { const u32x4 rb = *(const u32x4*)((const bf16_t*)R + off + bj * HALF);
                        r0 = (f32x4){__builtin_bit_cast(float, rb.x << 16), __builtin_bit_cast(float, rb.x & 0xffff0000u), __builtin_bit_cast(float, rb.y << 16), __builtin_bit_cast(float, rb.y & 0xffff0000u)};
                        r1 = (f32x4){__builtin_bit_cast(float, rb.z << 16), __builtin_bit_cast(float, rb.z & 0xffff0000u), __builtin_bit_cast(float, rb.w << 16), __builtin_bit_cast(float, rb.w & 0xffff0000u)}; }
                    else { r0 = *(const f32x4*)((const float*)R + off + bj * HALF); r1 = *(const f32x4*)((const float*)R + off + bj * HALF + 4); }
                    const f32x4 h0 = acc[ai][bj][m][0] + r0, h1 = acc[ai][bj][m][1] + r1;
                    u32x4 w; w.x = cvt_pk_bf16(h0[0], h0[1]); w.y = cvt_pk_bf16(h0[2], h0[3]); w.z = cvt_pk_bf16(h1[0], h1[1]); w.w = cvt_pk_bf16(h1[2], h1[3]);
                    *(u32x4*)(C + off + bj * HALF) = w; } }
    }
};
struct PanelSq {
    unsigned* xbuf;
    unsigned* cnt;
    unsigned* tmo;
    __device__ __forceinline__ void publish(const f32x4 (&v)[2][2][4][2], const Unit& u, int wr, int wc, int fr, int fq, PG8_LAS unsigned char* lds, int wid, int lane) const {
        PG8_LAS float* P = (PG8_LAS float*)lds;
#pragma unroll
        for (int ai = 0; ai < 2; ++ai)
#pragma unroll
            for (int m = 0; m < 4; ++m) { float s = 0.f;
#pragma unroll
                for (int bj = 0; bj < 2; ++bj)
#pragma unroll
                    for (int n = 0; n < 2; ++n) { const f32x4 x = v[ai][bj][m][n]; s += (x[0] * x[0] + x[1] * x[1]) + (x[2] * x[2] + x[3] * x[3]); }
                s += __shfl_xor(s, 16); s += __shfl_xor(s, 32);
                if (fq == 0) P[(ai * HALF + wr * 64 + m * 16 + fr) * 4 + wc] = s; }
        asm volatile("s_waitcnt lgkmcnt(0)" ::: "memory"); __builtin_amdgcn_s_barrier(); asm volatile("" ::: "memory");
        const int row = wid * 32 + (lane & 31);
        if (lane < 32) { const float tot = (P[row * 4 + 0] + P[row * 4 + 1]) + (P[row * 4 + 2] + P[row * 4 + 3]);
            __hip_atomic_store(xbuf + (size_t)(u.pm * BM + row) * 8 + u.pn, __builtin_bit_cast(unsigned, tot), __ATOMIC_RELAXED, __HIP_MEMORY_SCOPE_AGENT); }
        asm volatile("s_waitcnt vmcnt(0)" ::: "memory");
        if (lane == 0) __hip_atomic_fetch_add(cnt + 16 * u.pm, 1u, __ATOMIC_RELAXED, __HIP_MEMORY_SCOPE_AGENT);
    }
    __device__ __forceinline__ void finish(const Unit& u, PG8_LAS unsigned char* lds, int wid, int lane) const {
        PG8_LAS float* S = (PG8_LAS float*)(lds + 8192);
        if (wid == 0) { unsigned sp = 0u;
            while ((unsigned)__builtin_amdgcn_readfirstlane(__hip_atomic_load(cnt + 16 * u.pm, __ATOMIC_RELAXED, __HIP_MEMORY_SCOPE_AGENT)) < 64u) { __builtin_amdgcn_s_sleep(1);
                if ((++sp & 255u) == 0u) { if (__hip_atomic_load(tmo, __ATOMIC_RELAXED, __HIP_MEMORY_SCOPE_AGENT)) break; if (sp > (1u << 18)) { if (lane == 0) atomicAdd(tmo, 1u); break; } } }
            __builtin_amdgcn_fence(__ATOMIC_ACQUIRE, "agent"); }
        asm volatile("s_waitcnt vmcnt(0) lgkmcnt(0)" ::: "memory"); __builtin_amdgcn_s_barrier(); asm volatile("" ::: "memory");
        const int row = wid * 32 + (lane & 31);
        if (lane < 32) { float q = 0.f;
#pragma unroll
            for (int t = 0; t < 8; ++t) q += __builtin_bit_cast(float, __hip_atomic_load(xbuf + (size_t)(u.pm * BM + row) * 8 + t, __ATOMIC_RELAXED, __HIP_MEMORY_SCOPE_AGENT));
            S[row] = 1.0f / sqrtf(q * (1.0f / 2048.0f) + 1e-6f); }
        asm volatile("s_waitcnt lgkmcnt(0)" ::: "memory"); __builtin_amdgcn_s_barrier(); asm volatile("" ::: "memory");
    }
};
struct EpiNorm7 {
    static constexpr bool PERM = true, AFTER_DRAIN = true;
    bf16_t* H; const float* X; bf16_t* XN; const float* gain; PanelSq st;
    __device__ __forceinline__ void operator()(const f32x4 (&)[2][2][4][2], const Unit&, int, int, int, int) const {}
    __device__ __forceinline__ void fused(f32x4 (&acc)[2][2][4][2], const Unit& u, int wr, int wc, int fr, int fq, PG8_LAS unsigned char* lds, int wid, int lane) const {
        const int row0 = u.pm * BM + wr * 64 + fr, col0 = u.pn * BM + wc * 32 + 8 * fq;
#pragma unroll
        for (int ai = 0; ai < 2; ++ai)
#pragma unroll
            for (int m = 0; m < 4; ++m) { const size_t off = (size_t)(row0 + ai * HALF + m * 16) * 2048 + col0;
#pragma unroll
                for (int bj = 0; bj < 2; ++bj) { acc[ai][bj][m][0] += *(const f32x4*)(X + off + bj * HALF); acc[ai][bj][m][1] += *(const f32x4*)(X + off + bj * HALF + 4); }
                asm volatile("" : "+v"(acc[ai][0][m][0]), "+v"(acc[ai][0][m][1]), "+v"(acc[ai][1][m][0]), "+v"(acc[ai][1][m][1]));
                if (m & 1) asm volatile("" ::: "memory"); }
        st.publish(acc, u, wr, wc, fr, fq, lds, wid, lane);
#pragma unroll
        for (int ai = 0; ai < 2; ++ai)
#pragma unroll
            for (int m = 0; m < 4; ++m) { const size_t off = (size_t)(row0 + ai * HALF + m * 16) * 2048 + col0;
#pragma unroll
                for (int bj = 0; bj < 2; ++bj) { const f32x4 h0 = acc[ai][bj][m][0], h1 = acc[ai][bj][m][1];
                    u32x4 w; w.x = cvt_pk_bf16(h0[0], h0[1]); w.y = cvt_pk_bf16(h0[2], h0[3]); w.z = cvt_pk_bf16(h1[0], h1[1]); w.w = cvt_pk_bf16(h1[2], h1[3]);
                    *(u32x4*)(H + off + bj * HALF) = w; } }
        st.finish(u, lds, wid, lane);
        const PG8_LAS float* S = (const PG8_LAS float*)(lds + 8192);
        f32x4 g[2][2];
#pragma unroll
        for (int bj = 0; bj < 2; ++bj) { g[bj][0] = *(const f32x4*)(gain + col0 + bj * HALF); g[bj][1] = *(const f32x4*)(gain + col0 + bj * HALF + 4); }
#pragma unroll
        for (int ai = 0; ai < 2; ++ai)
#pragma unroll
            for (int m = 0; m < 4; ++m) { const float sr = S[ai * HALF + wr * 64 + m * 16 + fr]; const size_t off = (size_t)(row0 + ai * HALF + m * 16) * 2048 + col0;
#pragma unroll
                for (int bj = 0; bj < 2; ++bj) { const f32x4 h0 = acc[ai][bj][m][0] * sr * g[bj][0], h1 = acc[ai][bj][m][1] * sr * g[bj][1];
                    u32x4 w; w.x = cvt_pk_bf16(h0[0], h0[1]); w.y = cvt_pk_bf16(h0[2], h0[3]); w.z = cvt_pk_bf16(h1[0], h1[1]); w.w = cvt_pk_bf16(h1[2], h1[3]);
                    *(u32x4*)(XN + off + bj * HALF) = w; } }
    }
};
struct EpiNorm10 {
    static constexpr bool PERM = true, AFTER_DRAIN = true;
    const bf16_t* H; float* Y; const float* gain; PanelSq st;
    __device__ __forceinline__ void operator()(const f32x4 (&)[2][2][4][2], const Unit&, int, int, int, int) const {}
    __device__ __forceinline__ void fused(f32x4 (&acc)[2][2][4][2], const Unit& u, int wr, int wc, int fr, int fq, PG8_LAS unsigned char* lds, int wid, int lane) const {
        const int row0 = u.pm * BM + wr * 64 + fr, col0 = u.pn * BM + wc * 32 + 8 * fq;
#pragma unroll
        for (int ai = 0; ai < 2; ++ai)
#pragma unroll
            for (int m = 0; m < 4; ++m) { const size_t off = (size_t)(row0 + ai * HALF + m * 16) * 2048 + col0;
#pragma unroll
                for (int bj = 0; bj < 2; ++bj) { const u32x4 rb = *(const u32x4*)(H + off + bj * HALF);
                    acc[ai][bj][m][0] += (f32x4){__builtin_bit_cast(float, rb.x << 16), __builtin_bit_cast(float, rb.x & 0xffff0000u), __builtin_bit_cast(float, rb.y << 16), __builtin_bit_cast(float, rb.y & 0xffff0000u)};
                    acc[ai][bj][m][1] += (f32x4){__builtin_bit_cast(float, rb.z << 16), __builtin_bit_cast(float, rb.z & 0xffff0000u), __builtin_bit_cast(float, rb.w << 16), __builtin_bit_cast(float, rb.w & 0xffff0000u)}; } }
        st.publish(acc, u, wr, wc, fr, fq, lds, wid, lane);
        st.finish(u, lds, wid, lane);
        const PG8_LAS float* S = (const PG8_LAS float*)(lds + 8192);
        f32x4 g[2][2];
#pragma unroll
        for (int bj = 0; bj < 2; ++bj) { g[bj][0] = *(const f32x4*)(gain + col0 + bj * HALF); g[bj][1] = *(const f32x4*)(gain + col0 + bj * HALF + 4); }
#pragma unroll
        for (int ai = 0; ai < 2; ++ai)
#pragma unroll
            for (int m = 0; m < 4; ++m) { const float sr = S[ai * HALF + wr * 64 + m * 16 + fr]; const size_t off = (size_t)(row0 + ai * HALF + m * 16) * 2048 + col0;
#pragma unroll
                for (int bj = 0; bj < 2; ++bj) { *(f32x4*)(Y + off + bj * HALF) = acc[ai][bj][m][0] * sr * g[bj][0]; *(f32x4*)(Y + off + bj * HALF + 4) = acc[ai][bj][m][1] * sr * g[bj][1]; } }
    }
};
}

template <int PMODE = 0> __device__ __forceinline__ void p3_indexer_prompt(const Args& a, LAS unsigned char* lds, int bid, int G, int tid, int wave, int lane, bool dostore = true) {
    unsigned char* ws = a.ws;
    const f16* QI = (const f16*)(ws + WS_QI); const f16* KI = (const f16*)(ws + WS_KI); const float* WI = (const float*)(ws + WS_WI); f16* SC = (f16*)(ws + WS_SC);
    const int r = lane & 31, hh = lane >> 5;
    constexpr int WOFF = 18 * 4096;
    constexpr int CB = 20, T = 129 * 129 + 257 * CB;
    const int lo = (int)((long)bid * T / G), hi = (int)((long)(bid + 1) * T / G);
    int q = 0, P = 0;
    while (P + CB + (q >> 1) + 1 <= lo) { P += CB + (q >> 1) + 1; ++q; }
    for (; q <= 256 && P < hi; P += CB + (q >> 1) + 1, ++q) {
        const int t0 = q * 32; const int nkb = (q >> 1) + 1;
        const int kb_lo = lo - (P + CB) > 0 ? lo - (P + CB) : 0; const int kb_end = hi - (P + CB) < nkb ? hi - (P + CB) : nkb;
        if (kb_lo >= kb_end) continue;
        {
            __syncthreads();
            int tidv = tid; asm volatile("" : "+v"(tidv));
#pragma unroll
            for (int i = 0; i < 8; ++i) { const int rr = tidv & 31, c = 2 * (8 * i + (tidv >> 6)) + ((tidv >> 5) & 1);
                const v4u v = *(const v4u*)(QI + (size_t)(t0 + rr) * 1024 + c * 8);
                *(LAS v4u*)(lds + (c * 32 + rr) * 16) = v; }
            { const float wx = WI[(size_t)(t0 + (tidv & 31)) * 16 + (tidv >> 5)]; *(LAS float*)(lds + WOFF + ((tidv >> 5) * 32 + (tidv & 31)) * 4) = wx * 0.0625f; }
            __syncthreads();
            {
                const int rr = tidv & 31, dg = tidv >> 5; const int ks = dg >> 2, h2 = (dg >> 1) & 1, e0 = (dg & 1) * 4;
                float qa[4] = {0.f, 0.f, 0.f, 0.f};
#pragma unroll 4
                for (int h = 0; h < 16; ++h) { const float wh = *(const LAS float*)(lds + WOFF + (h * 32 + rr) * 4);
                    typedef _Float16 f16x4 __attribute__((ext_vector_type(4)));
                    const f16x4 qv = *(const LAS f16x4*)(lds + ((((h * 4 + ks) * 2 + h2) * 32) + rr) * 16 + e0 * 2);
                    qa[0] = fmaf(wh, (float)qv[0], qa[0]); qa[1] = fmaf(wh, (float)qv[1], qa[1]); qa[2] = fmaf(wh, (float)qv[2], qa[2]); qa[3] = fmaf(wh, (float)qv[3], qa[3]); }
                typedef _Float16 f16x4 __attribute__((ext_vector_type(4)));
                f16x4 hi, lo;
#pragma unroll
                for (int e = 0; e < 4; ++e) { hi[e] = (f16)qa[e]; lo[e] = (f16)(qa[e] - (float)hi[e]); }
                *(LAS f16x4*)(lds + ((((16 * 4 + ks) * 2 + h2) * 32) + rr) * 16 + e0 * 2) = hi;
                *(LAS f16x4*)(lds + ((((17 * 4 + ks) * 2 + h2) * 32) + rr) * 16 + e0 * 2) = lo;
            }
            __syncthreads();
            f16x8 afn[2][4];
            if (kb_lo + wave < kb_end) {
#pragma unroll
                for (int blk = 0; blk < 2; ++blk)
#pragma unroll
                    for (int ks = 0; ks < 4; ++ks) afn[blk][ks] = *(const f16x8*)(KI + (size_t)((kb_lo + wave) * 64 + blk * 32 + r) * 64 + ks * 16 + hh * 8); }
            for (int kb = kb_lo + wave; kb < kb_end; kb += 8) {
                const int s0 = kb * 64;
                f16x8 af[2][4];
#pragma unroll
                for (int blk = 0; blk < 2; ++blk)
#pragma unroll
                    for (int ks = 0; ks < 4; ++ks) af[blk][ks] = afn[blk][ks];
                if (kb + 8 < kb_end) {
#pragma unroll
                    for (int blk = 0; blk < 2; ++blk)
#pragma unroll
                        for (int ks = 0; ks < 4; ++ks) afn[blk][ks] = *(const f16x8*)(KI + (size_t)(s0 + 512 + blk * 32 + r) * 64 + ks * 16 + hh * 8); }
                float sa0[16], sa1[16];
#pragma unroll
                for (int i = 0; i < 16; ++i) { sa0[i] = 0.f; sa1[i] = 0.f; }
#define IDX_FRAG(h, ks) (*(const LAS f16x8*)(lds + (((((h) * 4 + (ks)) * 2 + hh) * 32) + r) * 16))
#define IDX_W(h) (*(const LAS float*)(lds + WOFF + ((h) * 32 + r) * 4))
#define IDX_STEP(m, D0, D1, Bc, P0, P1, Bn, DOVALU, DOLOAD, WCUR, WNXT) do { const float wP_ = WCUR; \
        WNXT = IDX_W(m);                                      \
        __builtin_amdgcn_sched_barrier(0); \
        if (DOLOAD && PMODE != 2) { _Pragma("unroll") for (int ks = 0; ks < 4; ++ks) Bn[ks] = IDX_FRAG((m) + 1, ks); } \
        _Pragma("unroll") for (int ks = 0; ks < 4; ++ks) { \
            if (PMODE != 4) { \
            if (ks == 0) { D0 = __builtin_amdgcn_mfma_f32_32x32x16_f16(af[0][0], Bc[0], (f32x16){}, 0, 0, 0); D1 = __builtin_amdgcn_mfma_f32_32x32x16_f16(af[1][0], Bc[0], (f32x16){}, 0, 0, 0); } \
            else { D0 = __builtin_amdgcn_mfma_f32_32x32x16_f16(af[0][ks], Bc[ks], D0, 0, 0, 0); D1 = __builtin_amdgcn_mfma_f32_32x32x16_f16(af[1][ks], Bc[ks], D1, 0, 0, 0); } } \
            else if (ks == 0) { _Pragma("unroll") for (int i_ = 0; i_ < 16; ++i_) { D0[i_] = (float)Bc[0][0] * (float)i_; D1[i_] = D0[i_]; } } \
            __builtin_amdgcn_sched_barrier(0); \
            if (DOVALU && PMODE != 1) { if (ks == 0) asm volatile("s_nop 7" : "+v"(P0), "+v"(P1)); \
                _Pragma("unroll") for (int i = 4 * ks; i < 4 * ks + 4; ++i) { if (PMODE == 3) { asm volatile("v_fma_f32 %0, %1, |%1|, %0" : "+v"(sa0[i]) : "v"(wP_)); asm volatile("v_fma_f32 %0, %1, |%1|, %0" : "+v"(sa1[i]) : "v"(wP_)); } else { \
                    asm volatile("v_fma_f32 %0, %1, |%2|, %0" : "+v"(sa0[(i + 1) & 15]) : "v"(wP_), "v"(P0[i])); asm volatile("v_fma_f32 %0, %1, |%2|, %0" : "+v"(sa1[(i + 1) & 15]) : "v"(wP_), "v"(P1[i])); } } } \
            __builtin_amdgcn_sched_barrier(0); } } while (0)
                {
                    f16x8 bA[4], bB[4]; f32x16 dA0, dA1, dB0, dB1;
#pragma unroll
                    for (int ks = 0; ks < 4; ++ks) { bA[ks] = IDX_FRAG(0, ks); if (PMODE == 2) bB[ks] = IDX_FRAG(1, ks); }
                    float wA = 0.f, wB = 0.f;
                    IDX_STEP(0, dA0, dA1, bA, dB0, dB1, bB, false, true, wB, wA);
#pragma unroll 1
                    for (int m = 1; m < 15; m += 2) {
                        IDX_STEP(m, dB0, dB1, bB, dA0, dA1, bA, true, true, wA, wB);
                        IDX_STEP(m + 1, dA0, dA1, bA, dB0, dB1, bB, true, true, wB, wA);
                    }
                    IDX_STEP(15, dB0, dB1, bB, dA0, dA1, bA, true, false, wA, wB);
                    { const float wP_ = wB; asm volatile("s_nop 15" : "+v"(dB0), "+v"(dB1));
#pragma unroll
                      for (int i = 0; i < 16; ++i) { asm volatile("v_fma_f32 %0, %1, |%2|, %0" : "+v"(sa0[(i + 1) & 15]) : "v"(wP_), "v"(dB0[i])); asm volatile("v_fma_f32 %0, %1, |%2|, %0" : "+v"(sa1[(i + 1) & 15]) : "v"(wP_), "v"(dB1[i])); } }
                }
#undef IDX_STEP
                f32x16 sc0, sc1;
#pragma unroll
                for (int i = 0; i < 16; ++i) { sc0[i] = sa0[(i + 1) & 15]; sc1[i] = sa1[(i + 1) & 15]; }
#pragma unroll
                for (int h = 16; h < 18; ++h)
#pragma unroll
                    for (int ks = 0; ks < 4; ++ks) { const f16x8 bfr = IDX_FRAG(h, ks);
                        sc0 = __builtin_amdgcn_mfma_f32_32x32x16_f16(af[0][ks], bfr, sc0, 0, 0, 0); sc1 = __builtin_amdgcn_mfma_f32_32x32x16_f16(af[1][ks], bfr, sc1, 0, 0, 0); }
#undef IDX_FRAG
#undef IDX_W
                f16* row = SC + (size_t)(t0 + r) * SCLD + s0 + 8 * hh;
                if (!dostore) { if (sc0[0] + sc1[3] != 12345.678f) continue; }
                if (s0 + 63 > t0) {
                    const int tq = t0 + r;
#pragma unroll
                    for (int i = 0; i < 16; ++i) { const int sk = s0 + (i & 3) + 8 * (i >> 2) + 4 * hh; if (sk > tq) sc0[i] = -INFINITY; if (sk + 32 > tq) sc1[i] = -INFINITY; } }
#pragma unroll
                for (int pr = 0; pr < 2; ++pr)
#pragma unroll
                    for (int hf = 0; hf < 2; ++hf) {
                        const unsigned x0 = hf ? pkh2(sc1[8 * pr], sc1[8 * pr + 1]) : pkh2(sc0[8 * pr], sc0[8 * pr + 1]), x1 = hf ? pkh2(sc1[8 * pr + 2], sc1[8 * pr + 3]) : pkh2(sc0[8 * pr + 2], sc0[8 * pr + 3]);
                        const unsigned y0 = hf ? pkh2(sc1[8 * pr + 4], sc1[8 * pr + 5]) : pkh2(sc0[8 * pr + 4], sc0[8 * pr + 5]), y1 = hf ? pkh2(sc1[8 * pr + 6], sc1[8 * pr + 7]) : pkh2(sc0[8 * pr + 6], sc0[8 * pr + 7]);
                        const unsigned r0 = (unsigned)__shfl_xor((int)(hh ? x0 : y0), 32), r1 = (unsigned)__shfl_xor((int)(hh ? x1 : y1), 32);
                        v4u w; if (hh) { w.x = r0; w.y = r1; w.z = y0; w.w = y1; } else { w.x = x0; w.y = x1; w.z = r0; w.w = r1; }
                        *(v4u*)(row + 32 * hf + 16 * pr) = w; }
                if (kb == nkb - 1) {
                    const int pend = ((t0 + 32 + 511) >> 9) << 9; f16* prow = SC + (size_t)(t0 + r) * SCLD;
                    for (int sp = 64 * nkb + 8 * hh; sp < pend; sp += 16) *(v4u*)(prow + sp) = (v4u){0xFC00FC00u, 0xFC00FC00u, 0xFC00FC00u, 0xFC00FC00u}; }
            }
        }
    }
}
__device__ __forceinline__ void p3_indexer_sample(const Args& a, LAS unsigned char* lds, int gw, int NGW, int wave, int lane) {
    unsigned char* ws = a.ws;
    const f16* QI = (const f16*)(ws + WS_QI); const float* QI32 = (const float*)(ws + WS_QI32); const float* WI = (const float*)(ws + WS_WI); f16* SCS = (f16*)(ws + WS_SCS);
    const float* ckidx = a.in[4]; const int* pt = (const int*)a.in[6];
    const int l16 = lane & 15, c = lane >> 4;
    const int tqi = gw & 63; unsigned* tq = (unsigned*)(a.ws + WS_CTL) + 9216 + 16 * tqi;
    for (;;) {
        unsigned tk = 0u; if (lane == 0) tk = __hip_atomic_fetch_add(tq, 1u, __ATOMIC_RELAXED, __HIP_MEMORY_SCOPE_AGENT);
        const int it = __builtin_amdgcn_readfirstlane((int)tk) * 64 + tqi;
        if (it >= DB * 16) break;
        const int b = it >> 4, p = it & 15;
        const float* w = WI + (size_t)(TP + b) * 16;
        const float* kb = ckidx + ((size_t)pt[b * NPAGES + p] * PAGE + l16) * IDD + 8 * c;
        f32x4 kr[8][2][2];
#pragma unroll
        for (int blk = 0; blk < 8; ++blk)
#pragma unroll
            for (int ks = 0; ks < 2; ++ks) { const float* kp = kb + (size_t)(16 * blk) * IDD + 32 * ks; kr[blk][ks][0] = *(const f32x4*)kp; kr[blk][ks][1] = *(const f32x4*)(kp + 4); }
        f16x8 qf[2];
#pragma unroll
        for (int ks = 0; ks < 2; ++ks) qf[ks] = *(const f16x8*)(QI + (size_t)(TP + b) * 1024 + l16 * 64 + 32 * ks + 8 * c);
        const float wh = w[l16] * 0.125f;
#pragma unroll
        for (int blk = 0; blk < 8; ++blk) { f32x4 acc = {0.f, 0.f, 0.f, 0.f};
#pragma unroll
            for (int ks = 0; ks < 2; ++ks) { const f32x4 x0 = kr[blk][ks][0], x1 = kr[blk][ks][1];
                const f16x8 kf = {(f16)x0.x, (f16)x0.y, (f16)x0.z, (f16)x0.w, (f16)x1.x, (f16)x1.y, (f16)x1.z, (f16)x1.w};
                acc = __builtin_amdgcn_mfma_f32_16x16x32_f16(kf, qf[ks], acc, 0, 0, 0); }
            f32x4 sv = {wh * fmaxf(acc.x, 0.f), wh * fmaxf(acc.y, 0.f), wh * fmaxf(acc.z, 0.f), wh * fmaxf(acc.w, 0.f)};
#pragma unroll
            for (int e = 0; e < 4; ++e) { float v = sv[e]; v += dpp_f0<0xB1, 0xf>(v); v += dpp_f0<0x4E, 0xf>(v); v += dpp_f0<0x124, 0xf>(v); v += dpp_f0<0x128, 0xf>(v); sv[e] = v; }
            const float v = l16 == 0 ? sv.x : l16 == 1 ? sv.y : l16 == 2 ? sv.z : sv.w;
            if (l16 < 4) SCS[(size_t)b * SCSLD + p * PAGE + 16 * blk + 4 * c + l16] = (f16)v; }
        if (p == 15) {
            const float* kn = a.out + O_KIS + (size_t)b * IDD; const int h = lane >> 2, qd = lane & 3; const float* qn = QI32 + (size_t)b * 1024 + h * 64 + qd * 16;
            float d = 0.f;
#pragma unroll
            for (int j = 0; j < 4; ++j) { const f32x4 q4 = *((const f32x4*)qn + j); const f32x4 k4 = *((const f32x4*)(kn + qd * 16) + j);
                d = fmaf(q4.x, k4.x, d); d = fmaf(q4.y, k4.y, d); d = fmaf(q4.z, k4.z, d); d = fmaf(q4.w, k4.w, d); }
            d += __shfl_xor(d, 1); d += __shfl_xor(d, 2);
            const float sn = wave_sum(qd == 0 ? w[h] * fmaxf(d, 0.f) : 0.f);
            if (lane == 0) SCS[(size_t)b * SCSLD + PAST] = (f16)(sn * 0.125f);
            for (int sp = LS + lane; sp < SCSLD; sp += 64) SCS[(size_t)b * SCSLD + sp] = (f16)(-INFINITY); }
    }
}

__device__ __forceinline__ unsigned tokey(float x) { const unsigned u = __builtin_bit_cast(unsigned, x); return u ^ (((unsigned)((int)u >> 31)) | 0x80000000u); }
template <int CTRL, int ROWMASK> __device__ __forceinline__ unsigned dpp_u(unsigned v) { return (unsigned)__builtin_amdgcn_update_dpp(0, (int)v, CTRL, ROWMASK, 0xf, false); }
__device__ __forceinline__ unsigned wave_scan_incl(unsigned s) {
    s += dpp_u<0x111, 0xf>(s); s += dpp_u<0x112, 0xf>(s); s += dpp_u<0x114, 0xf>(s); s += dpp_u<0x118, 0xf>(s);
    s += dpp_u<0x142, 0xa>(s);
    s += dpp_u<0x143, 0xc>(s);
    return s;
}
__device__ __forceinline__ void hist_find(LAS unsigned* hist, int need, int lane, unsigned& digit, unsigned& above, unsigned& inbin) {
    unsigned tot = 0u;
#pragma unroll 8
    for (int j = 0; j < 32; ++j) tot += hist[32 * lane + ((j + lane) & 31)];
    const unsigned pin = wave_scan_incl(tot);
    const unsigned all = (unsigned)__builtin_amdgcn_readlane((int)pin, 63);
    const unsigned s = all - pin + tot, s_excl = s - tot;
    const bool found = (s_excl < (unsigned)need) && ((unsigned)need <= s);
    const unsigned long long bal = __ballot(found);
    const int L = bal ? (int)__builtin_ctzll(bal) : 0;
    const unsigned sxL = (unsigned)__builtin_amdgcn_readlane((int)s_excl, L);
    const unsigned hb = lane < 32 ? hist[32 * L + lane] : 0u;
    const unsigned p2 = wave_scan_incl(hb);
    const unsigned all2 = (unsigned)__builtin_amdgcn_readlane((int)p2, 31);
    const unsigned s2 = all2 - p2 + hb;
    const unsigned tot2 = sxL + s2, ex2 = tot2 - hb;
    const bool f2 = lane < 32 && ex2 < (unsigned)need && (unsigned)need <= tot2;
    const unsigned long long b2 = __ballot(f2);
    const int L2 = b2 ? (int)__builtin_ctzll(b2) : 0;
    digit = 32u * L + L2; above = (unsigned)__builtin_amdgcn_readlane((int)ex2, L2); inbin = (unsigned)__builtin_amdgcn_readlane((int)hb, L2);
}
constexpr int KB0 = 22785;
__device__ __forceinline__ int coarse_bin(unsigned k) { const int v = (int)(k >> 17) - KB0; return v < 0 ? 0 : (v > 2047 ? 2047 : v); }
static_assert(TP <= 5 * 2048, "topk_row keeps at most five chunks in registers");
#define TOPK_LOAD(v, base) do { _Pragma("unroll") for (int j = 0; j < 4; ++j) { v[j] = (v4u){0u, 0u, 0u, 0u}; if ((base) + 512 * j < n) v[j] = *(const v4u*)(row + (base) + 512 * j + 8 * lane); } } while (0)
__device__ __forceinline__ unsigned bins2(unsigned w) { typedef short s16x2 __attribute__((ext_vector_type(2))); typedef unsigned short u16x2 __attribute__((ext_vector_type(2)));
    const s16x2 v = __builtin_elementwise_max(__builtin_bit_cast(s16x2, w), (s16x2){0, 0}); return __builtin_bit_cast(unsigned, (u16x2)(__builtin_bit_cast(u16x2, v) >> (u16x2){4, 4})); }
typedef short s16x2_t __attribute__((ext_vector_type(2))); typedef unsigned short u16x2_t __attribute__((ext_vector_type(2)));
__device__ __forceinline__ unsigned pk_sub16(unsigned a, unsigned b) { return __builtin_bit_cast(unsigned, (u16x2_t)(__builtin_bit_cast(u16x2_t, a) - __builtin_bit_cast(u16x2_t, b))); }
__device__ __forceinline__ unsigned tokey16(unsigned h) { return (h ^ ((h & 0x8000u) ? 0xFFFFu : 0x8000u)) & 0xFFFFu; }
__device__ __forceinline__ float h2f(unsigned w, int hi) { return (float)__builtin_bit_cast(_Float16, (unsigned short)(hi ? (w >> 16) : (w & 0xffffu))); }
__device__ __forceinline__ void topk_row(const f16* row, int n, int* sel, LAS unsigned* hist, int lane, unsigned* tq, unsigned& tknext) {
    unsigned nx_ = 0u; if (lane == 0) nx_ = __hip_atomic_fetch_add(tq, 1u, __ATOMIC_RELAXED, __HIP_MEMORY_SCOPE_AGENT);
    if (n <= TOPK) { for (int i = lane; i < TOPK; i += 64) sel[i] = i < n ? i : 0; tknext = (unsigned)__builtin_amdgcn_readfirstlane((int)nx_); return; }
    int need = TOPK; unsigned digit, above, inbin;
    for (int i = lane; i < 2048; i += 64) hist[i] = 0u;
    LDS_WAIT();
    v4u R[5][4], nxt[4];
#pragma unroll
    for (int s_ = 0; s_ < 5; ++s_)
#pragma unroll
        for (int j = 0; j < 4; ++j) R[s_][j] = (v4u){0u, 0u, 0u, 0u};
    TOPK_LOAD(nxt, 0);
#pragma unroll 1
    for (int base = 0; base < n; base += 2048) {
#pragma unroll
        for (int j = 0; j < 4; ++j) { R[4][j] = R[3][j]; R[3][j] = R[2][j]; R[2][j] = R[1][j]; R[1][j] = R[0][j]; R[0][j] = nxt[j]; }
        if (base + 2048 < n) TOPK_LOAD(nxt, base + 2048);
#pragma unroll
        for (int j = 0; j < 4; ++j) if (base + 512 * j < n) {
#pragma unroll
            for (int wd = 0; wd < 4; ++wd) { const unsigned b2 = bins2(R[0][j][wd]);
#pragma unroll
                for (int hf = 0; hf < 2; ++hf) { const unsigned cb = hf ? b2 >> 16 : b2 & 0xffffu;
                    if (cb != 0u) __hip_atomic_fetch_add(hist + cb, 1u, __ATOMIC_RELAXED, __HIP_MEMORY_SCOPE_WORKGROUP); } } } }
    tknext = (unsigned)__builtin_amdgcn_readfirstlane((int)nx_);
    if (lane == 0) hist[0] = 0xFFFFu;
    const int nch = (n + 2047) >> 11;
    LDS_WAIT();
    hist_find(hist, need, lane, digit, above, inbin); need -= (int)above;
    const unsigned b1 = digit;
    const bool fast = inbin <= 64u; const int m = (int)inbin;
    LDS_WAIT();
    const unsigned long long lt = (1ull << lane) - 1ull;
    LAS unsigned* lkey = hist; LAS unsigned* lidx = hist + 64; LAS int* lout = (LAS int*)(hist + 256);
    if (fast) {
        unsigned lfill = 0u;
        const unsigned b1x2 = b1 * 0x10001u;
        int outbase = need;
#pragma unroll 1
        for (int ci = nch - 1; ci >= 0; --ci) { const int base = ci * 2048;
            unsigned mask = 0u, inmask = 0u;
#pragma unroll
            for (int j = 0; j < 4; ++j)
#pragma unroll
                for (int wd = 0; wd < 4; ++wd) { const unsigned b2 = bins2(R[0][j][wd]);
                    mask = (mask >> 1) | (pk_sub16(b1x2, b2) & 0x80008000u);
                    const unsigned d_ = b2 ^ b1x2; inmask = (inmask >> 1) | (pk_sub16(d_, 0x00010001u) & ~d_ & 0x80008000u); }
            while (__ballot(inmask != 0u)) {
                const bool act = inmask != 0u; const int bpos = act ? __builtin_ctz(inmask) : 0; inmask &= inmask - 1u;
                const int w = bpos & 15, hf = bpos >> 4;
                unsigned wv = R[0][0][0];
#pragma unroll
                for (int ww = 1; ww < 16; ++ww) wv = (w == ww) ? R[0][ww >> 2][ww & 3] : wv;
                const unsigned long long bi = __ballot(act); const unsigned p_ = lfill + (unsigned)__builtin_popcountll(bi & lt);
                if (act && p_ < 64u) { lkey[p_] = tokey16(hf ? wv >> 16 : wv & 0xffffu); lidx[p_] = (unsigned)(base + 512 * (w >> 2) + 8 * lane + 2 * (w & 3) + hf); }
                lfill += (unsigned)__builtin_popcountll(bi); }
            const int cnt = __builtin_popcount(mask);
            const int pre = (int)wave_scan_incl((unsigned)cnt);
            int pos = outbase + pre - cnt; outbase += __builtin_amdgcn_readlane(pre, 63);
            while (mask) { const int bpos = __builtin_ctz(mask); mask &= mask - 1u; const int w = bpos & 15; if (pos < TOPK) lout[pos] = base + 512 * (w >> 2) + 8 * lane + 2 * (w & 3) + (bpos >> 4); ++pos; }
#pragma unroll
            for (int j = 0; j < 4; ++j) { R[0][j] = R[1][j]; R[1][j] = R[2][j]; R[2][j] = R[3][j]; R[3][j] = R[4][j]; }
        }
        LDS_WAIT();
        const unsigned mykey = lane < m ? lkey[lane] : 0u; const int myidx = lane < m ? (int)lidx[lane] : 0x7fffffff;
        int rk = 0;
        for (int j = 0; j < m; ++j) { const unsigned kj = (unsigned)__builtin_amdgcn_readlane((int)mykey, j); const int ij = __builtin_amdgcn_readlane(myidx, j); rk += (kj > mykey || (kj == mykey && ij < myidx)) ? 1 : 0; }
        if (lane < m && rk < need) lout[rk] = myidx;
        LDS_WAIT();
        *((v4u*)sel + lane) = *((const LAS v4u*)lout + lane);
    } else {
        const unsigned klo = b1 == 0u ? 0u : tokey(h2f(16u * b1, 0)), kspan = tokey(h2f(16u * b1 + 15u, 0)) - klo + 1u;
        unsigned prefix = 0u; int toteq = 0;
        TOPK_LOAD(nxt, 0);
#pragma unroll 1
        for (int pass = 0; pass < 3; ++pass) {
            const int shift = pass == 0 ? 21 : pass == 1 ? 10 : 0; const unsigned mask = pass == 2 ? 1023u : 2047u; const int pshift = pass == 1 ? 21 : 10;
            for (int i = lane; i < 2048; i += 64) hist[i] = 0u;
            LDS_WAIT();
#pragma unroll 1
            for (int base = 0; base < n; base += 2048) {
#pragma unroll
                for (int j = 0; j < 4; ++j) R[0][j] = nxt[j];
                TOPK_LOAD(nxt, (base + 2048 < n) ? base + 2048 : 0);
#pragma unroll
                for (int j = 0; j < 4; ++j) if (base + 512 * j < n)
#pragma unroll
                    for (int e = 0; e < 8; ++e) { const unsigned k = tokey(h2f(R[0][j][e >> 1], e & 1));
                        if (k >= klo && (k - klo) < kspan && (pass == 0 || (k >> pshift) == prefix)) __hip_atomic_fetch_add(hist + ((k >> shift) & mask), 1u, __ATOMIC_RELAXED, __HIP_MEMORY_SCOPE_WORKGROUP); } }
            LDS_WAIT();
            hist_find(hist, need, lane, digit, above, inbin);
            need -= (int)above; toteq = (int)inbin;
            prefix = pass == 2 ? ((prefix << 10) | digit) : ((prefix << 11) | digit);
            LDS_WAIT();
        }
        const unsigned thr = prefix; const int need_eq = need; const bool ties = toteq != need_eq;
        int outbase = 0, eqtaken = 0;
#pragma unroll 1
        for (int base = 0; base < n; base += 2048) {
#pragma unroll
            for (int j = 0; j < 4; ++j) R[0][j] = nxt[j];
            if (base + 2048 < n) TOPK_LOAD(nxt, base + 2048);
            unsigned mask = 0u;
#pragma unroll
            for (int j = 0; j < 4; ++j) if (base + 512 * j < n) {
                bool eq[8];
#pragma unroll
                for (int e = 0; e < 8; ++e) { const unsigned kk = tokey(h2f(R[0][j][e >> 1], e & 1));
                    const bool take = kk > thr || (kk == thr && !ties); eq[e] = ties && kk == thr;
                    mask |= take ? (1u << (8 * j + e)) : 0u; }
                if (ties) {
                    int lower = 0, tot = 0, own = 0;
#pragma unroll
                    for (int e = 0; e < 8; ++e) { const unsigned long long be = __ballot(eq[e]); lower += __builtin_popcountll(be & lt); tot += __builtin_popcountll(be); }
#pragma unroll
                    for (int e = 0; e < 8; ++e) { if (eq[e]) { if (eqtaken + lower + own < need_eq) mask |= 1u << (8 * j + e); ++own; } }
                    eqtaken += tot; }
            }
            const int cnt = __builtin_popcount(mask);
            const int pre = (int)wave_scan_incl((unsigned)cnt);
            int pos = outbase + pre - cnt; outbase += __builtin_amdgcn_readlane(pre, 63);
            while (mask) { const int bpos = __builtin_ctz(mask); mask &= mask - 1u; if (pos < TOPK) sel[pos] = base + 512 * (bpos >> 3) + 8 * lane + (bpos & 7); ++pos; }
        }
    }
    LDS_WAIT();
}
#undef TOPK_LOAD
__device__ __forceinline__ void p4_topk(const Args& a, LAS unsigned char* lds, int gw, int NGW, int wave, int lane) {
    unsigned char* ws = a.ws;
    const f16* SC = (const f16*)(ws + WS_SC); const f16* SCS = (const f16*)(ws + WS_SCS); int* SEL = (int*)(ws + WS_SEL);
    LAS unsigned* hist = (LAS unsigned*)(lds + wave * 16896); LAS float* scr = (LAS float*)(lds + wave * 16896 + 8192);
#ifndef TOPK_REP
#define TOPK_REP 1
#endif
    for (int rep_ = 0; rep_ < TOPK_REP; ++rep_) {
    const int q = gw & 63; unsigned* tq = (unsigned*)(a.ws + WS_CTL) + (rep_ ? 11264 : 8192) + 16 * q;
    constexpr int NROW = SEQ + DB, SPOS = TP - 1 - PAST;
    unsigned tk = 0u; if (lane == 0) tk = __hip_atomic_fetch_add(tq, 1u, __ATOMIC_RELAXED, __HIP_MEMORY_SCOPE_AGENT);
    tk = (unsigned)__builtin_amdgcn_readfirstlane((int)tk);
    while ((int)tk * 64 + q < NROW) {
        unsigned nx = 0u;
        const int sp = (int)tk * 64 + q;
        if (sp >= SPOS && sp < SPOS + DB) { const int b = sp - SPOS; topk_row(SCS + (size_t)b * SCSLD, LS, SEL + (size_t)(TP + b) * TOPK, hist, lane, tq, nx); }
        else { const int t = TP - 1 - (sp < SPOS ? sp : sp - DB); topk_row(SC + (size_t)t * SCLD, t + 1, SEL + (size_t)t * TOPK, hist, lane, tq, nx); }
        tk = nx;
    }
    }
}

template <int CTRL> __device__ __forceinline__ float dpp_f(float v) { return __builtin_bit_cast(float, __builtin_amdgcn_update_dpp(0, __builtin_bit_cast(int, v), CTRL, 0xf, 0xf, false)); }
__device__ __forceinline__ float row16_sum(float v) {
    v += dpp_f<0xB1>(v);
    v += dpp_f<0x4E>(v);
    v += dpp_f<0x124>(v);
    v += dpp_f<0x128>(v);
    return v;
}
typedef short s16x4 __attribute__((ext_vector_type(4)));
__device__ __forceinline__ s16x4 vtr(LAS unsigned char* p) { return __builtin_bit_cast(s16x4, __builtin_amdgcn_ds_read_tr16_b64_v4i16((LAS s16x4*)p)); }
constexpr int VROW = 288;
constexpr int ATT_WAVE_LDS = 1024 + 4096 + 32 * VROW;
struct AttnPre { int sel[4]; bf16x8_t qf[4]; };
__device__ __forceinline__ void attn_prefetch(const Args& a, AttnPre& P, int t, int kvh, int lane) {
    unsigned char* ws = a.ws; const int* SEL = (const int*)(ws + WS_SEL); const bf16* QB = (const bf16*)(ws + WS_QB);
    const bool smp = t >= TP; const int b = t - TP; const int cnt = smp ? TOPK : (t + 1 < TOPK ? t + 1 : TOPK);
    const int l16 = lane & 15, c = lane >> 4;
#pragma unroll
    for (int j = 0; j < 4; ++j) { const int kidx = 64 * j + lane; int sv = SEL[(size_t)t * TOPK + kidx];
        if (smp) sv = sv < PAST ? ((const int*)a.in[6])[b * NPAGES + (sv >> 7)] * PAGE + (sv & 127) : -1;
        P.sel[j] = kidx < cnt ? sv : 0; }
#pragma unroll
    for (int ks = 0; ks < 4; ++ks) { P.qf[ks] = (bf16x8_t){0, 0, 0, 0, 0, 0, 0, 0}; if (l16 < 4) P.qf[ks] = *(const bf16x8_t*)(QB + (size_t)t * 1024 + (kvh * 4 + l16) * 128 + 32 * ks + 8 * c); }
}
template <bool SMP, int APROBE = 0> __device__ __forceinline__ void attn_unit_mfma(const Args& a, LAS unsigned char* wl, int t, int kvh, int lane, const AttnPre& P) {
    unsigned char* ws = a.ws;
    const bf16* KB = (const bf16*)(ws + WS_KB); const bf16* VB = (const bf16*)(ws + WS_VB); bf16* CAT = (bf16*)(ws + (APROBE ? WS_Z : WS_CAT));
    LAS int* lsel = (LAS int*)wl; LAS float* lsc = (LAS float*)(wl + 1024); LAS unsigned char* vst = wl + 5120;
    const int cnt = SMP ? TOPK : (t + 1 < TOPK ? t + 1 : TOPK);
    const int l16 = lane & 15, c = lane >> 4;
    const int b = t - TP;
#pragma unroll
    for (int j = 0; j < 4; ++j) { const int kidx_ = 64 * j + lane, w_ = kidx_ & 31; lsel[(kidx_ & ~31) + 8 * (w_ & 3) + (w_ >> 2)] = P.sel[j]; }
    const float* ck = a.in[2] + kvh * 128; const float* cv = a.in[3] + kvh * 128;
    const float* nk = a.out + O_KS + (size_t)b * 256 + kvh * 128; const float* nv = a.out + O_VS + (size_t)b * 256 + kvh * 128;
    const char* ckb = (const char*)ck; const char* cvb = (const char*)cv;
    const long long dnk = (long long)((uintptr_t)nk - (uintptr_t)ck), dnv = (long long)((uintptr_t)nv - (uintptr_t)cv);
    bf16x8_t qf[4];
#pragma unroll
    for (int ks = 0; ks < 4; ++ks) qf[ks] = P.qf[ks];
    LDS_WAIT();
    const bf16* kbase = KB + kvh * 128 + 8 * c;
#define ATT_LOADK(kf, gp) do { _Pragma("unroll") for (int bb = 0; bb < 4; ++bb) { const int k_ = 16 * (4 * (gp) + bb) + l16, w_ = k_ & 31; const int s_ = lsel[(k_ & ~31) + 8 * (w_ & 3) + (w_ >> 2)]; \
        if (!SMP) { const bf16* kr_ = kbase + (size_t)s_ * 256; _Pragma("unroll") for (int ks = 0; ks < 4; ++ks) kf[bb][ks] = *(const bf16x8_t*)(kr_ + 32 * ks); } \
        else { const float* kr_ = (const float*)(ckb + (s_ >= 0 ? (long long)s_ * 1024 : dnk)) + 8 * c; \
            _Pragma("unroll") for (int ks = 0; ks < 4; ++ks) { const f32x4 x_ = *(const f32x4*)(kr_ + 32 * ks), y_ = *(const f32x4*)(kr_ + 32 * ks + 4); \
                v4u pk_; pk_.x = pk2(x_.x, x_.y); pk_.y = pk2(x_.z, x_.w); pk_.z = pk2(y_.x, y_.y); pk_.w = pk2(y_.z, y_.w); kf[bb][ks] = __builtin_bit_cast(bf16x8_t, pk_); } } } } while (0)
#define ATT_QK(kf, gp) do { _Pragma("unroll") for (int bb = 0; bb < 4; ++bb) { f32x4 acc_ = {0.f, 0.f, 0.f, 0.f}; \
        _Pragma("unroll") for (int ks = 0; ks < 4; ++ks) acc_ = __builtin_amdgcn_mfma_f32_16x16x32_bf16(kf[bb][ks], qf[ks], acc_, 0, 0, 0); \
        const int k0_ = 16 * (4 * (gp) + bb) + 4 * c; \
        acc_.x = k0_ < cnt ? acc_.x : -INFINITY; acc_.y = k0_ + 1 < cnt ? acc_.y : -INFINITY; acc_.z = k0_ + 2 < cnt ? acc_.z : -INFINITY; acc_.w = k0_ + 3 < cnt ? acc_.w : -INFINITY; \
        if (l16 < 4) *(LAS f32x4*)(lsc + l16 * 256 + k0_) = acc_; } } while (0)
    const char* vb_u = (const char*)(VB + kvh * 128); const unsigned lo16 = 16u * (unsigned)l16;
#define ATT_LOADV(vr, st_) do { _Pragma("unroll") for (int i = 0; i < 8; ++i) { const int s_ = lsel[32 * (st_) + 8 * c + i]; \
        if (!SMP) vr[i] = *(const bf16x8_t*)(vb_u + ((unsigned)s_ * 512u + lo16)); \
        else { const float* vp_ = (const float*)(cvb + (s_ >= 0 ? (long long)s_ * 1024 : dnv)) + 8 * l16; const f32x4 x_ = *(const f32x4*)vp_, y_ = *(const f32x4*)(vp_ + 4); \
            v4u pk_; pk_.x = pk2(x_.x, x_.y); pk_.y = pk2(x_.z, x_.w); pk_.z = pk2(y_.x, y_.y); pk_.w = pk2(y_.z, y_.w); vr[i] = __builtin_bit_cast(bf16x8_t, pk_); } } } while (0)
    bf16x8_t vr0[8], vr1[8];
    if constexpr (!SMP && APROBE == 3) { ATT_LOADV(vr0, 0); ATT_LOADV(vr1, 1); }
    else if constexpr (!SMP) {
      const char* kb_u = (const char*)(KB + kvh * 128);
#define ATT_LOADKR(kr, st_) do { _Pragma("unroll") for (int i = 0; i < 8; ++i) { const int s_ = lsel[32 * (st_) + 8 * c + i]; kr[i] = *(const bf16x8_t*)(kb_u + ((unsigned)s_ * 512u + lo16)); } } while (0)
#define ATT_QKS(kr, st_, DOLOAD) do { \
        _Pragma("unroll") for (int i = 0; i < 8; ++i) *(LAS bf16x8_t*)(vst + (c + 4 * i) * VROW + 16 * l16) = kr[i]; \
        if (DOLOAD) ATT_LOADKR(kr, (st_) + 2); \
        LDS_WAIT(); \
        { f32x4 acc0_ = {0.f, 0.f, 0.f, 0.f}, acc1_ = acc0_;                       \
            _Pragma("unroll") for (int ks = 0; ks < 4; ++ks) { const bf16x8_t af0_ = *(const LAS bf16x8_t*)(vst + l16 * VROW + 64 * ks + 16 * c), af1_ = *(const LAS bf16x8_t*)(vst + (16 + l16) * VROW + 64 * ks + 16 * c); \
                acc0_ = __builtin_amdgcn_mfma_f32_16x16x32_bf16(af0_, qf[ks], acc0_, 0, 0, 0); acc1_ = __builtin_amdgcn_mfma_f32_16x16x32_bf16(af1_, qf[ks], acc1_, 0, 0, 0); } \
            const int k0_ = 32 * (st_) + 4 * c; \
            if (cnt < TOPK) {                                                        \
                acc0_.x = k0_ < cnt ? acc0_.x : -INFINITY; acc0_.y = k0_ + 1 < cnt ? acc0_.y : -INFINITY; acc0_.z = k0_ + 2 < cnt ? acc0_.z : -INFINITY; acc0_.w = k0_ + 3 < cnt ? acc0_.w : -INFINITY; \
                acc1_.x = k0_ + 16 < cnt ? acc1_.x : -INFINITY; acc1_.y = k0_ + 17 < cnt ? acc1_.y : -INFINITY; acc1_.z = k0_ + 18 < cnt ? acc1_.z : -INFINITY; acc1_.w = k0_ + 19 < cnt ? acc1_.w : -INFINITY; } \
            if (l16 < 4) { *(LAS f32x4*)(lsc + l16 * 256 + k0_) = acc0_; *(LAS f32x4*)(lsc + l16 * 256 + k0_ + 16) = acc1_; } } \
        LDS_WAIT(); } while (0)
      bf16x8_t kr0[8], kr1[8];
      ATT_LOADKR(kr0, 0); ATT_LOADKR(kr1, 1);
#pragma unroll 1
      for (int st = 0; st < 8; st += 2) {
          if (st == 6) { ATT_LOADV(vr0, 0); ATT_LOADV(vr1, 1); }
          ATT_QKS(kr0, st, st + 2 < 8);
          ATT_QKS(kr1, st + 1, st + 3 < 8); }
#undef ATT_LOADKR
#undef ATT_QKS
    }
    else {
#pragma unroll 1
      for (int gp = 0; gp < 4; ++gp) { bf16x8_t kfA[4][4]; ATT_LOADK(kfA, gp); ATT_QK(kfA, gp); }
      ATT_LOADV(vr0, 0); ATT_LOADV(vr1, 1); }
#undef ATT_LOADK
#undef ATT_QK
    LDS_WAIT();
    float lsum[4];
    { const int g = lane >> 4, i16 = lane & 15; LAS f32x4* ps = (LAS f32x4*)(lsc + g * 256 + 16 * i16);
      f32x4 pv[4]; float m = -INFINITY;
#pragma unroll
      for (int j = 0; j < 4; ++j) { pv[j] = ps[j]; m = fmaxf(m, fmaxf(fmaxf(pv[j].x, pv[j].y), fmaxf(pv[j].z, pv[j].w))); }
      m = fmaxf(m, dpp_f<0xB1>(m)); m = fmaxf(m, dpp_f<0x4E>(m)); m = fmaxf(m, dpp_f<0x124>(m)); m = fmaxf(m, dpp_f<0x128>(m));
      float l = 0.f;
#pragma unroll
      for (int j = 0; j < 4; ++j) { pv[j].x = __builtin_amdgcn_exp2f(pv[j].x - m); pv[j].y = __builtin_amdgcn_exp2f(pv[j].y - m); pv[j].z = __builtin_amdgcn_exp2f(pv[j].z - m); pv[j].w = __builtin_amdgcn_exp2f(pv[j].w - m);
          l += (pv[j].x + pv[j].y) + (pv[j].z + pv[j].w); ps[j] = pv[j]; }
      l = row16_sum(l);
#pragma unroll
      for (int gg = 0; gg < 4; ++gg) lsum[gg] = __builtin_bit_cast(float, __builtin_amdgcn_readlane(__builtin_bit_cast(int, l), 16 * gg)); }
    LDS_WAIT();
    f32x4 oacc[8];
#pragma unroll
    for (int db = 0; db < 8; ++db) oacc[db] = (f32x4){0.f, 0.f, 0.f, 0.f};
    LAS unsigned char* trp = vst + (4 * c + (l16 >> 2)) * VROW + 8 * (l16 & 3);
#define ATT_PV(vr, st, vnext, DOLOAD) do { \
        _Pragma("unroll") for (int i = 0; i < 8; ++i) *(LAS bf16x8_t*)(vst + (c + 4 * i) * VROW + 16 * l16) = vr[i]; \
        if (DOLOAD) ATT_LOADV(vnext, (st) + 2); \
        bf16x8_t pf = (bf16x8_t){0, 0, 0, 0, 0, 0, 0, 0}; \
        if (l16 < 4) { const f32x4 p0 = *(const LAS f32x4*)(lsc + l16 * 256 + 32 * (st) + 4 * c), p1 = *(const LAS f32x4*)(lsc + l16 * 256 + 32 * (st) + 16 + 4 * c); \
            v4u pk; pk.x = pk2(p0.x, p0.y); pk.y = pk2(p0.z, p0.w); pk.z = pk2(p1.x, p1.y); pk.w = pk2(p1.z, p1.w); pf = __builtin_bit_cast(bf16x8_t, pk); } \
        LDS_WAIT(); \
        _Pragma("unroll") for (int db = 0; db < 8; ++db) { const s16x4 lo = vtr(trp + 32 * db), hi = vtr(trp + 16 * VROW + 32 * db); \
            const bf16x8_t vf = (bf16x8_t){lo[0], lo[1], lo[2], lo[3], hi[0], hi[1], hi[2], hi[3]}; \
            oacc[db] = __builtin_amdgcn_mfma_f32_16x16x32_bf16(pf, vf, oacc[db], 0, 0, 0); } \
        LDS_WAIT(); } while (0)
#pragma unroll 1
    for (int st = 0; st < (APROBE == 4 ? 2 : 8); st += 2) {
        ATT_PV(vr0, st, vr0, st + 2 < 8);
        ATT_PV(vr1, st + 1, vr1, st + 3 < 8);
    }
#undef ATT_PV
#undef ATT_LOADV
    LAS float* obuf = lsc;
    if (c == 0) {
#pragma unroll
        for (int db = 0; db < 8; ++db) { obuf[0 * 128 + 16 * db + l16] = oacc[db].x; obuf[1 * 128 + 16 * db + l16] = oacc[db].y; obuf[2 * 128 + 16 * db + l16] = oacc[db].z; obuf[3 * 128 + 16 * db + l16] = oacc[db].w; } }
    LDS_WAIT();
    { const float inv = 1.f / (c == 0 ? lsum[0] : c == 1 ? lsum[1] : c == 2 ? lsum[2] : lsum[3]);
      const f32x4 a0 = *(const LAS f32x4*)(obuf + c * 128 + 8 * l16) * inv, a1 = *(const LAS f32x4*)(obuf + c * 128 + 8 * l16 + 4) * inv;
      v4u o; o.x = pk2(a0.x, a0.y); o.y = pk2(a0.z, a0.w); o.z = pk2(a1.x, a1.y); o.w = pk2(a1.z, a1.w);
      *(v4u*)(CAT + (size_t)t * 2048 + (kvh * 4 + c) * 128 + 8 * l16) = o; }
    LDS_WAIT();
}
template <int APROBE = 0> __device__ __forceinline__ void p5_attn(const Args& a, LAS unsigned char* lds, int bid, int G, int wave, int lane) {
    LAS unsigned char* wl = lds + wave * ATT_WAVE_LDS;
#ifndef CONVW_
#define CONVW_ 1
#endif
    constexpr int CONVW = CONV_IN_ATTN ? CONVW_ : 0, AW = 8 - CONVW;
    int kvh, hw, nhw;
    if ((G & 7) == 0) { kvh = (bid >> 2) & 1; hw = ((bid >> 3) * 4 + (bid & 3)) * AW + wave; nhw = (G / 2) * AW; }
    else { kvh = bid & 1; hw = (bid >> 1) * AW + wave; nhw = ((G + 1 - kvh) >> 1) * AW; if (nhw == 0) { nhw = 1; } }
#ifndef DYN_ROUNDS
#define DYN_ROUNDS 6
#endif
    const int NSTAT = ((SEQ + DB) / nhw - DYN_ROUNDS) * nhw;
    unsigned* ticket = (unsigned*)(a.ws + WS_CTL) + 2048 + 64 * kvh;
#define ATT_ROW(i) (((i) >= DB && (i) < 2 * DB) ? TP + ((i) - DB) : NMETA + ((i) < DB ? (i) : (i) - DB))
    if (wave >= AW) {
        const int cw = wave - AW;
        LAS float* scr = (LAS float*)(lds + 8 * ATT_WAVE_LDS + cw * 2 * 8448); LAS float* scr2 = scr + 64 * 33;
        cv_stream(a, scr, scr2, bid + G * cw, G * CONVW, lane);
    } else {
        AttnPre P;
        if (hw < NSTAT) attn_prefetch(a, P, ATT_ROW(hw), kvh, lane);
        for (int it = hw; it < NSTAT; it += nhw) {
            const int t = ATT_ROW(it);
            const AttnPre C = P; const int nx = it + nhw;
            if (nx < NSTAT) attn_prefetch(a, P, ATT_ROW(nx), kvh, lane);
            if (t >= TP) attn_unit_mfma<true, APROBE>(a, wl, t, kvh, lane, C); else attn_unit_mfma<false, APROBE>(a, wl, t, kvh, lane, C); }
    }
    for (;;) {
        unsigned tk = 0u; if (lane == 0) tk = __hip_atomic_fetch_add(ticket, 1u, __ATOMIC_RELAXED, __HIP_MEMORY_SCOPE_AGENT);
        const int it = NSTAT + (int)__builtin_amdgcn_readfirstlane(tk);
        if (it >= SEQ + DB) break;
        const int t = ATT_ROW(it); AttnPre C; attn_prefetch(a, C, t, kvh, lane);
        if (t >= TP) attn_unit_mfma<true, APROBE>(a, wl, t, kvh, lane, C); else attn_unit_mfma<false, APROBE>(a, wl, t, kvh, lane, C); }
#undef ATT_ROW
}
__device__ __forceinline__ f32x4 ld_u4(const bf16* U, size_t row, int c4) {
    const unsigned long long w = *((const unsigned long long*)(U + row * 1024) + c4); const unsigned lo = (unsigned)w, hi = (unsigned)(w >> 32);
    return (f32x4){__builtin_bit_cast(float, lo << 16), __builtin_bit_cast(float, lo & 0xffff0000u), __builtin_bit_cast(float, hi << 16), __builtin_bit_cast(float, hi & 0xffff0000u)}; }
template <int W> __device__ __forceinline__ void dpool_block16(const bf16* U, bf16* DP, int r0, int c4) {
    f32x4 v[31], P[32];
#pragma unroll
    for (int i = 0; i < 31; ++i) v[i] = (i >= 16 - W) ? ld_u4(U, (size_t)(r0 - 15 + i), c4) : (f32x4){0.f, 0.f, 0.f, 0.f};
    P[0] = (f32x4){0.f, 0.f, 0.f, 0.f};
#pragma unroll
    for (int i = 0; i < 31; ++i) P[i + 1] = P[i] + v[i];
#pragma unroll
    for (int t = 0; t < 16; ++t) { const f32x4 d = (P[16 + t] - P[16 + t - W]) * (1.0f / W) - v[15 + t];
        *((unsigned long long*)(DP + (size_t)(r0 + t) * 1024) + c4) = (unsigned long long)pk2(d.x, d.y) | ((unsigned long long)pk2(d.z, d.w) << 32); }
}
__device__ __forceinline__ void p5_dpool(const Args& a, int gw, int lane) {
    unsigned char* ws = a.ws;
    const bf16* U = (const bf16*)(ws + WS_U); bf16* DP = (bf16*)(ws + WS_DPOOL); const float* SP = a.in[5];
    constexpr int NI_P = (SEQ / 16) * 4, NI_S = (MP - TP) * 4;
    const int q = gw & 63; unsigned* tq = (unsigned*)(ws + WS_CTL) + 12288 + 16 * q;
    for (;;) {
        unsigned tk = 0u; if (lane == 0) tk = __hip_atomic_fetch_add(tq, 1u, __ATOMIC_RELAXED, __HIP_MEMORY_SCOPE_AGENT);
        const int it = __builtin_amdgcn_readfirstlane((int)tk) * 64 + q;
        if (it >= NI_P + NI_S) break;
        if (it < NI_P) { const int rb = it >> 2, grp = it & 3, c4 = 64 * grp + lane; const int r0 = NMETA + 16 * rb;
            if (grp == 0) dpool_block16<2>(U, DP, r0, c4); else if (grp == 1) dpool_block16<4>(U, DP, r0, c4); else if (grp == 2) dpool_block16<8>(U, DP, r0, c4); else dpool_block16<16>(U, DP, r0, c4); }
        else { const int e = it - NI_P; const int r = TP + (e >> 2), grp = e & 3, c4 = 64 * grp + lane; const int w = 2 << grp;
            f32x4 d = {0.f, 0.f, 0.f, 0.f};
            if (r < MR) { const int b = r - TP; const f32x4 cur = ld_u4(U, (size_t)r, c4); f32x4 sum = cur;
                for (int j = 1; j < w; ++j) sum += *((const f32x4*)(SP + ((size_t)b * 15 + (15 - j)) * 1024) + c4);
                d = sum / (float)w - cur; }
            *((unsigned long long*)(DP + (size_t)r * 1024) + c4) = (unsigned long long)pk2(d.x, d.y) | ((unsigned long long)pk2(d.z, d.w) << 32); }
    }
}
template <bool OUT_BF16>
__device__ __forceinline__ void rms_rowbf(const bf16* xrow, const float* gain, bf16* obf, float* of32, int lane) {
    float v[4][8]; float s = 0.f;
#pragma unroll
    for (int j = 0; j < 4; ++j) { const v4u rb = *((const v4u*)xrow + lane + 64 * j);
        v[j][0] = __builtin_bit_cast(float, rb.x << 16); v[j][1] = __builtin_bit_cast(float, rb.x & 0xffff0000u); v[j][2] = __builtin_bit_cast(float, rb.y << 16); v[j][3] = __builtin_bit_cast(float, rb.y & 0xffff0000u);
        v[j][4] = __builtin_bit_cast(float, rb.z << 16); v[j][5] = __builtin_bit_cast(float, rb.z & 0xffff0000u); v[j][6] = __builtin_bit_cast(float, rb.w << 16); v[j][7] = __builtin_bit_cast(float, rb.w & 0xffff0000u);
#pragma unroll
        for (int e = 0; e < 8; ++e) s += v[j][e] * v[j][e]; }
    const float rstd = 1.f / sqrtf(wave_sum(s) * (1.f / DM) + EPS);
#pragma unroll
    for (int j = 0; j < 4; ++j) { const f32x4 g0 = *((const f32x4*)gain + 2 * (lane + 64 * j)), g1 = *((const f32x4*)gain + 2 * (lane + 64 * j) + 1);
        const float o0 = v[j][0] * rstd * g0.x, o1 = v[j][1] * rstd * g0.y, o2 = v[j][2] * rstd * g0.z, o3 = v[j][3] * rstd * g0.w, o4 = v[j][4] * rstd * g1.x, o5 = v[j][5] * rstd * g1.y, o6 = v[j][6] * rstd * g1.z, o7 = v[j][7] * rstd * g1.w;
        if (OUT_BF16) { v4u o; o.x = pk2(o0, o1); o.y = pk2(o2, o3); o.z = pk2(o4, o5); o.w = pk2(o6, o7); *((v4u*)obf + lane + 64 * j) = o; }
        else { *((f32x4*)of32 + 2 * (lane + 64 * j)) = (f32x4){o0, o1, o2, o3}; *((f32x4*)of32 + 2 * (lane + 64 * j) + 1) = (f32x4){o4, o5, o6, o7}; } }
}
__device__ __forceinline__ void rms_row_to_f32(const float* xrow, const float* gain, float* orow, int lane) {
    const f32x4* xr = (const f32x4*)xrow + lane; const f32x4* gr = (const f32x4*)gain + lane;
    f32x4 v[8]; float s = 0.f;
#pragma unroll
    for (int j = 0; j < 8; ++j) { v[j] = xr[64 * j]; s += (v[j].x * v[j].x + v[j].y * v[j].y) + (v[j].z * v[j].z + v[j].w * v[j].w); }
    const float rstd = 1.f / sqrtf(wave_sum(s) * (1.f / DM) + EPS);
#pragma unroll
    for (int j = 0; j < 8; ++j) { const f32x4 g = gr[64 * j]; *((f32x4*)orow + lane + 64 * j) = v[j] * rstd * g; }
}

template <int NB, int MODE  >
__device__ __forceinline__ void small_gemm_item(const bf16* A, int lda, const bf16* Bt, int ldb, int n0, int k_lo, int k_hi, float* outF, bf16* outH, int ldo, int wave, int lane) {
    const int fr = lane & 15, fq = lane >> 4;
    const bf16* ap = A + (size_t)(16 * wave + fr) * lda + k_lo + 8 * fq;
    const bf16* bp = Bt + (size_t)(n0 + fr) * ldb + k_lo + 8 * fq;
    f32x4 acc[NB];
#pragma unroll
    for (int c = 0; c < NB; ++c) acc[c] = (f32x4){0.f, 0.f, 0.f, 0.f};
#pragma unroll 8
    for (int k = k_lo; k < k_hi; k += 32) {
        const bf16x8_t af = *(const bf16x8_t*)ap; ap += 32;
#pragma unroll
        for (int c = 0; c < NB; ++c) { const bf16x8_t bfv = *(const bf16x8_t*)(bp + (size_t)16 * c * ldb); acc[c] = __builtin_amdgcn_mfma_f32_16x16x32_bf16(bfv, af, acc[c], 0, 0, 0); }
        bp += 32;
    }
    const int row = 16 * wave + fr;
#pragma unroll
    for (int c = 0; c < NB; ++c) { const int col = n0 + 16 * c + 4 * fq;
        if (MODE == 0) *(f32x4*)(outF + (size_t)row * ldo + col) = acc[c];
        else { float v0 = fmaxf(acc[c].x, 0.f), v1 = fmaxf(acc[c].y, 0.f), v2 = fmaxf(acc[c].z, 0.f), v3 = fmaxf(acc[c].w, 0.f);
            unsigned long long o = (unsigned long long)pk2(v0 * v0, v1 * v1) | ((unsigned long long)pk2(v2 * v2, v3 * v3) << 32);
            *(unsigned long long*)(outH + (size_t)row * ldo + col) = o; } }
}
__device__ __forceinline__ void st16_wt(float* p, f32x4 v) { asm volatile("global_store_dwordx4 %0, %1, off sc1" :: "v"(p), "v"(v) : "memory"); }
template <int KLEN, int MODE  >
__device__ __forceinline__ void small_gemm_ksplit(const bf16* A, int lda, const bf16* Bt, int ldb, int n0, int k_lo, float* outF, bf16* outH, int ldo, LAS unsigned char* lds, int tid, int wave, int lane) {
    constexpr int KW = KLEN / 8, NS = KW / 32;
    static_assert(KW % 32 == 0 && NS >= 1, "small_gemm_ksplit: KLEN must be a multiple of 256");
    const int fr = lane & 15, fq = lane >> 4;
    const bf16* ap = A + (size_t)fr * lda + k_lo + wave * KW + 8 * fq;
    const bf16* bp = Bt + (size_t)(n0 + fr) * ldb + k_lo + wave * KW + 8 * fq;
    f32x4 acc[8][2];
#pragma unroll
    for (int rb = 0; rb < 8; ++rb) { acc[rb][0] = (f32x4){0.f, 0.f, 0.f, 0.f}; acc[rb][1] = acc[rb][0]; }
    constexpr int SB = NS < 4 ? NS : 4;
#pragma unroll 1
    for (int s0 = 0; s0 < NS; s0 += SB) {
        bf16x8_t af[SB][8], bfv[SB][2];
#pragma unroll
        for (int ss = 0; ss < SB; ++ss) {
#pragma unroll
            for (int rb = 0; rb < 8; ++rb) af[ss][rb] = *(const bf16x8_t*)(ap + (size_t)(16 * rb) * lda + 32 * (s0 + ss));
            bfv[ss][0] = *(const bf16x8_t*)(bp + 32 * (s0 + ss)); bfv[ss][1] = *(const bf16x8_t*)(bp + (size_t)16 * ldb + 32 * (s0 + ss)); }
#pragma unroll
        for (int ss = 0; ss < SB; ++ss)
#pragma unroll
            for (int rb = 0; rb < 8; ++rb) { acc[rb][0] = __builtin_amdgcn_mfma_f32_16x16x32_bf16(bfv[ss][0], af[ss][rb], acc[rb][0], 0, 0, 0); acc[rb][1] = __builtin_amdgcn_mfma_f32_16x16x32_bf16(bfv[ss][1], af[ss][rb], acc[rb][1], 0, 0, 0); }
    }
    LAS float* part = (LAS float*)lds;
#pragma unroll
    for (int rb = 0; rb < 8; ++rb)
#pragma unroll
        for (int cb = 0; cb < 2; ++cb) *(LAS f32x4*)(part + ((size_t)(wave * 128 + 16 * rb + fr) * 32 + 16 * cb + 4 * fq)) = acc[rb][cb];
    __syncthreads();
    { const int row = tid >> 2, c0 = (tid & 3) * 8;
      f32x4 s0 = {0.f, 0.f, 0.f, 0.f}, s1 = s0;
#pragma unroll
      for (int w = 0; w < 8; ++w) { s0 += *(const LAS f32x4*)(part + ((size_t)(w * 128 + row) * 32 + c0)); s1 += *(const LAS f32x4*)(part + ((size_t)(w * 128 + row) * 32 + c0 + 4)); }
      if (MODE == 0) { float* o = outF + (size_t)row * ldo + n0 + c0; st16_wt(o, s0); st16_wt(o + 4, s1); }
      else { v4u o; float a0 = fmaxf(s0.x, 0.f), a1 = fmaxf(s0.y, 0.f), a2 = fmaxf(s0.z, 0.f), a3 = fmaxf(s0.w, 0.f), b0 = fmaxf(s1.x, 0.f), b1 = fmaxf(s1.y, 0.f), b2 = fmaxf(s1.z, 0.f), b3 = fmaxf(s1.w, 0.f);
          o.x = pk2(a0 * a0, a1 * a1); o.y = pk2(a2 * a2, a3 * a3); o.z = pk2(b0 * b0, b1 * b1); o.w = pk2(b2 * b2, b3 * b3);
          *(v4u*)(outH + (size_t)row * ldo + n0 + c0) = o; } }
    __syncthreads();
}
template <bool OUT_BF16>
__device__ __forceinline__ void rms_row_slabs(const float* base, const float* slab  , int b, const float* gain, float* xstore, bf16* obf, float* of32, int lane) {
    const f32x4* xr = (const f32x4*)base + lane; const f32x4* gr = (const f32x4*)gain + lane;
    f32x4 v[8]; float s = 0.f;
#pragma unroll
    for (int j = 0; j < 8; ++j) { v[j] = xr[64 * j];
#pragma unroll
        for (int sp = 0; sp < 4; ++sp) v[j] += *((const f32x4*)(slab + ((size_t)sp * DB + b) * DM) + lane + 64 * j);
        s += (v[j].x * v[j].x + v[j].y * v[j].y) + (v[j].z * v[j].z + v[j].w * v[j].w);
        if (xstore) *((f32x4*)xstore + lane + 64 * j) = v[j]; }
    const float rstd = 1.f / sqrtf(wave_sum(s) * (1.f / DM) + EPS);
#pragma unroll
    for (int j = 0; j < 8; ++j) { const f32x4 g = gr[64 * j];
        if (OUT_BF16) *((unsigned long long*)obf + lane + 64 * j) = (unsigned long long)pk2(v[j].x * rstd * g.x, v[j].y * rstd * g.y) | ((unsigned long long)pk2(v[j].z * rstd * g.z, v[j].w * rstd * g.w) << 32);
        else *((f32x4*)of32 + lane + 64 * j) = v[j] * rstd * g; }
}

#define GAS __attribute__((address_space(1)))
typedef GAS unsigned gu32;
#define RLX_AGENT __ATOMIC_RELAXED, __HIP_MEMORY_SCOPE_AGENT
#define XB_TMO      128
#define XB_XCNT(j)  (256  + 64 * (j))
#define XB_XSUB(j)  (1280 + 64 * (j))
#define XB_XGEN(j)  (2304 + 64 * (j))
#define XB_TOP      3328
#define XB_TOPGEN   3392
#define XCD_BAR_WORDS 3456
#define XB_SPIN_CAP (1u << 18)

__device__ __forceinline__ unsigned xb_ld(unsigned* p)              { return __hip_atomic_load(p, __ATOMIC_RELAXED, __HIP_MEMORY_SCOPE_AGENT); }
__device__ __forceinline__ unsigned xb_add(unsigned* p, unsigned v) { return __hip_atomic_fetch_add(p, v, __ATOMIC_RELAXED, __HIP_MEMORY_SCOPE_AGENT); }
__device__ __forceinline__ unsigned xb_xcc_id() { return (unsigned)__builtin_amdgcn_s_getreg((3 << 11) | 20) & 0xFu; }
#define XB_SPIN(cond, bar) do { unsigned _sp = 0; while (cond) { __builtin_amdgcn_s_sleep(1); \
    if ((++_sp & 255u) == 0u) { if (xb_ld(&(bar)[XB_TMO])) break; if (_sp > XB_SPIN_CAP) { atomicAdd(&(bar)[XB_TMO], 1u); break; } } } } while (0)

struct XcdBarrier {
    unsigned* bar; unsigned x;
    volatile LAS unsigned* st;
};

__device__ __forceinline__ XcdBarrier xcd_barrier_post(unsigned* bar, volatile LAS unsigned* st) {
    XcdBarrier b; b.bar = bar; b.x = xb_xcc_id(); b.st = st;
    if (threadIdx.x == 0) (void)xb_add(&bar[XB_XCNT(b.x)], 1u);
    return b;
}
__device__ __forceinline__ void xcd_barrier_complete(unsigned* bar, unsigned x, unsigned& nloc, unsigned& nx) {
    const unsigned G = gridDim.x * gridDim.y * gridDim.z;
    unsigned sum, cnt, mine, sp = 0u;
    for (;;) {
        sum = 0u; cnt = 0u; mine = 0u;
#pragma unroll
        for (unsigned j = 0; j < 16; ++j) { const unsigned c = xb_ld(&bar[XB_XCNT(j)]); sum += c; cnt += (c > 0u) ? 1u : 0u; mine = (j == x) ? c : mine; }
        if (sum == G) break;
        __builtin_amdgcn_s_sleep(1);
        if ((++sp & 255u) == 0u) { if (xb_ld(&bar[XB_TMO])) break; if (sp > XB_SPIN_CAP) { atomicAdd(&bar[XB_TMO], 1u); break; } }
    }
    nloc = mine > 0u ? mine : 1u; nx = cnt > 0u ? cnt : 1u;
}

__device__ __forceinline__ void xcd_barrier(const XcdBarrier& b) {
    asm volatile("s_waitcnt vmcnt(0)" ::: "memory");
    __syncthreads();
    if (threadIdx.x == 0) {
        unsigned* bar = b.bar;
        __builtin_amdgcn_s_waitcnt(0);
        unsigned nloc = b.st[0], nx = b.st[1];
        if (nloc == 0u) { xcd_barrier_complete(bar, b.x, nloc, nx); b.st[0] = nloc; b.st[1] = nx; }
        const unsigned old = xb_add(&bar[XB_XSUB(b.x)], 1u);
        const unsigned gen = old / nloc;
        if (old + 1u == (gen + 1u) * nloc) {
            __builtin_amdgcn_fence(__ATOMIC_RELEASE, "agent");
            asm volatile("s_waitcnt vmcnt(0)" ::: "memory");
            const unsigned og = xb_add(&bar[XB_TOP], 1u);
            const unsigned tg = og / nx;
            if (og + 1u == (tg + 1u) * nx) xb_add(&bar[XB_TOPGEN], 1u);
            else XB_SPIN(xb_ld(&bar[XB_TOPGEN]) == tg, bar);
            __builtin_amdgcn_fence(__ATOMIC_ACQUIRE, "agent");
            xb_add(&bar[XB_XGEN(b.x)], 1u);
            asm volatile("s_waitcnt vmcnt(0)" ::: "memory");
        } else {
            XB_SPIN(xb_ld(&bar[XB_XGEN(b.x)]) == gen, bar);
            __builtin_amdgcn_fence(__ATOMIC_ACQUIRE, "agent");
            asm volatile("s_waitcnt vmcnt(0)" ::: "memory");
        }
    }
    __syncthreads();
}


__device__ __forceinline__ int first_unit_pm(int nM, int nN, int c) {
    const int nwg = nM * nN; int wgid = c < nwg ? c : 0;
    { const int q = nwg / pg8::NXCD, r = nwg % pg8::NXCD, xcd = wgid % pg8::NXCD, off = wgid / pg8::NXCD; wgid = (xcd < r ? xcd * (q + 1) : r * (q + 1) + (xcd - r) * q) + off; }
    const int nig = pg8::WGM * nN, gid = wgid / nig, fm = gid * pg8::WGM, gsz = (nM - fm) < pg8::WGM ? (nM - fm) : pg8::WGM;
    return fm + ((wgid % nig) % gsz);
}

__global__ void __launch_bounds__(512, 2) mk_fwd(Args a) {
    extern __shared__ __attribute__((aligned(16))) unsigned char lds_raw[];
    LAS unsigned char* lds = (LAS unsigned char*)lds_raw;
    const int tid = threadIdx.x, lane = tid & 63, wave = __builtin_amdgcn_readfirstlane(tid >> 6);
    const int G = gridDim.x, bid = blockIdx.x;
    const int gw = bid * 8 + wave, NGW = G * 8;
    unsigned char* ws = a.ws;
    const int lo = a.ph_lo, hi = a.ph_hi;
#ifndef PHASE_MASK
#define PHASE_MASK 0xFFF
#endif
#define IN(k) ((((PHASE_MASK) >> (k)) & 1) && lo <= (k) && (k) < hi)
#if MK_ONE_LAUNCH
    for (int u = tid; u < (LDS_BYTES - LDSCTL_OFF) / 4; u += 512) ((LAS unsigned*)(lds + LDSCTL_OFF))[u] = 0u;
    __syncthreads();
    if (hi > NPH) cg::this_grid().sync();
    XcdBarrier bar = xcd_barrier_post((unsigned*)(ws + WS_CTL) + CW_BAR, (volatile LAS unsigned*)(lds + MISC_OFF) + 8);
#define SEAM(k) do { if (IN(k) && IN((k) + 1)) xcd_barrier(bar); } while (0)
#else
#define SEAM(k) do { } while (0)
#endif
#ifndef DUPMASK
#define DUPMASK 0
#endif
#ifndef GREP
#define GREP 0
#endif
#define GR(k) ((((GREP) >> (k)) & 1) ? 2 : 1)
#define REPS(k) for (int rep_ = 0; rep_ < ((((DUPMASK) >> (k)) & 1) ? 2 : 1); ++rep_)
    if (IN(0)) REPS(0) { p0_prep(a, lds, gw, NGW, wave, lane); __syncthreads(); } SEAM(0);
    if (IN(1)) REPS(1) { pg8::Gemm g{(const pg8::bf16_t*)(ws + WS_XN), (const pg8::bf16_t*)(ws + WS_WIN), MP, NZ, DM, DM, DM, 0}; pg8::StaticOrder S; S.init(MP, NZ, G, bid);
        pg8::EpiIn E{a.out, ws};
        pg8::gemm_phase<pg8::EpiIn, pg8::StaticOrder, PG8_ALIGN, PG8_SP2>(lds, g, S, E);
        { constexpr int NU1 = (MP / 256) * (NZ / 256); const int nidle = 2 * G - NU1;
          if (nidle > 0 && nidle <= G) { if (bid >= G - nidle) pool_state_copy(a, (bid - (G - nidle)) * 8 + wave, nidle * 8, lane); }
          else pool_state_copy(a, gw, NGW, lane); } } SEAM(2);
#ifndef SUB3
#define SUB3 7
#endif
#ifndef SUB3DUP
#define SUB3DUP 0
#endif
#ifndef PMODE2
#define PMODE2 0
#endif
#ifndef P3_NS
#define P3_NS 20
#endif
    if (IN(3)) {         if (bid >= P3_NS) p3_indexer_prompt<0>(a, lds, bid - P3_NS, G - P3_NS, tid, wave, lane, true); __syncthreads();
        if (SUB3DUP & 1) { p3_indexer_prompt<PMODE2>(a, lds, bid, G, tid, wave, lane, false); __syncthreads(); }
        for (int r3 = 0; r3 < ((SUB3DUP & 2) ? 2 : 1); ++r3) { p3_indexer_sample(a, lds, gw, NGW, wave, lane); }
        p5_dpool(a, gw, lane); __syncthreads(); } SEAM(3);
    if (IN(4)) REPS(4) {
        { pg8::Gemm g{(const pg8::bf16_t*)(ws + WS_DPOOL), (const pg8::bf16_t*)(ws + WS_WPOOL), MP, 1024, 256, 1024, 256, 256}; pg8::StaticOrder S; S.init(MP, 1024, G, bid, GR(6));
          pg8::EpiBf16<0> E{(pg8::bf16_t*)(ws + WS_CAT), 2048, 1024, a.in[11]};
          pg8::gemm_phase<pg8::EpiBf16<0>, pg8::StaticOrder, PG8_ALIGN, PG8_SP2>(lds, g, S, E); }
        p4_topk(a, lds, gw, NGW, wave, lane); __syncthreads(); } SEAM(4);
#ifndef APROBE2
#define APROBE2 0
#endif
    if (IN(5)) { p5_attn<0>(a, lds, bid, G, wave, lane); __syncthreads(); if (APROBE2) { p5_attn<APROBE2>(a, lds, bid, G, wave, lane); __syncthreads(); } } SEAM(6);
    constexpr int R0 = NMETA;
    if (IN(7)) REPS(7) { pg8::Gemm g{(const pg8::bf16_t*)(ws + WS_CAT) + (size_t)R0 * DM, (const pg8::bf16_t*)(ws + WS_WOUT), SEQ, DM, DM, DM, DM, 0}; pg8::StaticOrder S; S.init(SEQ, DM, G, bid, GR(7));
        pg8::PanelSq st{(unsigned*)(ws + WS_Z), (unsigned*)(ws + WS_CTL) + 2560, (unsigned*)(ws + WS_CTL) + CW_BAR + XB_TMO};
        pg8::EpiNorm7 E{(pg8::bf16_t*)(ws + WS_H1) + (size_t)R0 * DM, a.in[0], (pg8::bf16_t*)(ws + WS_XN) + (size_t)R0 * DM, a.in[13], st};
        const bool item_first = (first_unit_pm(SEQ / 256, DM / 256, bid) & 1) != 0;
#define P7_ITEM() for (int it = bid; it < 256; it += G) { const int ct = it & 63, sp = it >> 6;     \
            small_gemm_ksplit<512, 0>((const bf16*)(ws + WS_CAT) + (size_t)TP * DM, DM, (const bf16*)(ws + WS_WOUT), DM, 32 * ct, 512 * sp, (float*)(ws + WS_PS1) + (size_t)sp * DB * DM, nullptr, DM, lds, tid, wave, lane); }
        if (item_first) P7_ITEM();
        pg8::gemm_phase<pg8::EpiNorm7, pg8::StaticOrder, PG8_ALIGN, PG8_SP2>(lds, g, S, E); __syncthreads();
        if (!item_first) P7_ITEM();
#undef P7_ITEM
    } SEAM(7);
    if (IN(9)) REPS(9) { pg8::Gemm g{(const pg8::bf16_t*)(ws + WS_XN) + (size_t)R0 * DM, (const pg8::bf16_t*)(ws + WS_WUP), SEQ, DFF, DM, DM, DM, 0}; pg8::StaticOrder S; S.init(SEQ, DFF, G, bid, GR(9));
        pg8::EpiBf16<1> E{(pg8::bf16_t*)(ws + WS_ACT) + (size_t)R0 * DFF, DFF, 0, nullptr};
        unsigned* xs_cnt = (unsigned*)(ws + WS_CTL) + 10240; unsigned* xs_tmo = (unsigned*)(ws + WS_CTL) + CW_BAR + XB_TMO;
        if (bid * 8 < DB) { const int b = bid * 8 + wave, r = TP + b;
            if (b < DB) rms_row_slabs<true>(a.in[1] + (size_t)b * DM, (const float*)(ws + WS_PS1), b, a.in[13], (float*)(ws + WS_H1) + (size_t)r * DM, (bf16*)(ws + WS_XN) + (size_t)r * DM, nullptr, lane);
            asm volatile("s_waitcnt vmcnt(0)" ::: "memory"); __syncthreads();
            if (tid == 0) { __builtin_amdgcn_fence(__ATOMIC_RELEASE, "agent"); asm volatile("s_waitcnt vmcnt(0)" ::: "memory"); (void)xb_add(xs_cnt, 1u); } }
        pg8::gemm_phase<pg8::EpiBf16<1>, pg8::StaticOrder, PG8_ALIGN, PG8_SP2>(lds, g, S, E);
        if (tid == 0) { unsigned sp = 0u; const unsigned want = (unsigned)((DB + 7) / 8 < G ? (DB + 7) / 8 : G);
            while (xb_ld(xs_cnt) < want) { __builtin_amdgcn_s_sleep(1); if ((++sp & 255u) == 0u) { if (xb_ld(xs_tmo)) break; if (sp > XB_SPIN_CAP) { atomicAdd(xs_tmo, 1u); break; } } }
            __builtin_amdgcn_fence(__ATOMIC_ACQUIRE, "agent"); asm volatile("s_waitcnt vmcnt(0)" ::: "memory"); }
        __syncthreads();
        for (int it = bid; it < 256; it += G)
            small_gemm_ksplit<2048, 1>((const bf16*)(ws + WS_XN) + (size_t)TP * DM, DM, (const bf16*)(ws + WS_WUP), DM, 32 * it, 0, nullptr, (bf16*)(ws + WS_ACT) + (size_t)TP * DFF, DFF, lds, tid, wave, lane);
    } SEAM(9);
    if (IN(10)) REPS(10) { pg8::Gemm g{(const pg8::bf16_t*)(ws + WS_ACT) + (size_t)R0 * DFF, (const pg8::bf16_t*)(ws + WS_WDN), SEQ, DM, DFF, DFF, DFF, 0}; pg8::StaticOrder S; S.init(SEQ, DM, G, bid, GR(10));
        pg8::PanelSq st{(unsigned*)(ws + WS_Z + MiB), (unsigned*)(ws + WS_CTL) + 3072, (unsigned*)(ws + WS_CTL) + CW_BAR + XB_TMO};
        pg8::EpiNorm10 E{(const pg8::bf16_t*)(ws + WS_H1) + (size_t)R0 * DM, a.out + O_YP, a.in[16], st};
        const bool item_first = (first_unit_pm(SEQ / 256, DM / 256, bid) & 1) != 0;
#define P10_ITEM() for (int it = bid; it < 256; it += G) { const int ct = it & 63, sp = it >> 6;     \
            small_gemm_ksplit<2048, 0>((const bf16*)(ws + WS_ACT) + (size_t)TP * DFF, DFF, (const bf16*)(ws + WS_WDN), DFF, 32 * ct, 2048 * sp, (float*)(ws + WS_PS2) + (size_t)sp * DB * DM, nullptr, DM, lds, tid, wave, lane); }
        if (item_first) P10_ITEM();
        pg8::gemm_phase<pg8::EpiNorm10, pg8::StaticOrder, PG8_ALIGN, PG8_SP2>(lds, g, S, E); __syncthreads();
        if (!item_first) P10_ITEM();
#undef P10_ITEM
        { unsigned* yc = (unsigned*)(ws + WS_CTL) + 10304; unsigned* ytmo = (unsigned*)(ws + WS_CTL) + CW_BAR + XB_TMO;
          asm volatile("s_waitcnt vmcnt(0)" ::: "memory"); __syncthreads();
          if (tid == 0) (void)xb_add(yc, 1u);
          if (bid * 8 < DB) {
              if (tid == 0) { unsigned sp = 0u;
                  while (xb_ld(yc) < (unsigned)G) { __builtin_amdgcn_s_sleep(1); if ((++sp & 255u) == 0u) { if (xb_ld(ytmo)) break; if (sp > XB_SPIN_CAP) { atomicAdd(ytmo, 1u); break; } } }
                  __builtin_amdgcn_fence(__ATOMIC_ACQUIRE, "agent"); asm volatile("s_waitcnt vmcnt(0)" ::: "memory"); }
              __syncthreads();
              const int b = bid * 8 + wave, r = TP + b;
              if (b < DB) rms_row_slabs<false>((const float*)(ws + WS_H1) + (size_t)r * DM, (const float*)(ws + WS_PS2), b, a.in[16], nullptr, nullptr, a.out + O_YS + (size_t)b * DM, lane); } }
    }
#undef IN
#undef SEAM
}

extern "C" void kernel_launch(void* const* d_in, const int* in_sizes, int n_in, void* d_out, int out_size, void* d_ws, size_t ws_size, hipStream_t stream) {
    static int grid = 0;
    if (grid == 0) {
        if (n_in != 17 || (size_t)out_size != O_END || ws_size < WS_END) { fprintf(stderr, "kernel_launch: unexpected shapes: n_in %d out_size %d (want %zu) ws %zu (want >= %zu)\n", n_in, out_size, (size_t)O_END, ws_size, (size_t)WS_END); grid = -1; return; }
        int dev = 0, cus = 0, per_cu = 0;
        if (hipGetDevice(&dev) != hipSuccess || hipDeviceGetAttribute(&cus, hipDeviceAttributeMultiprocessorCount, dev) != hipSuccess) { grid = -1; return; }
        if (hipFuncSetAttribute((const void*)mk_fwd, hipFuncAttributeMaxDynamicSharedMemorySize, LDS_BYTES) != hipSuccess) { fprintf(stderr, "kernel_launch: hipFuncSetAttribute failed\n"); grid = -1; return; }
        if (hipOccupancyMaxActiveBlocksPerMultiprocessor(&per_cu, (const void*)mk_fwd, 512, LDS_BYTES) != hipSuccess || per_cu < 1) { fprintf(stderr, "kernel_launch: occupancy query says %d\n", per_cu); grid = -1; return; }
        grid = cus;
        fprintf(stderr, "kernel_launch: grid %d (cus %d, per_cu %d)\n", grid, cus, per_cu);
    }
    if (grid < 0) return;
    Args a{};
    for (int i = 0; i < 17; ++i) a.in[i] = (const float*)d_in[i];
    a.out = (float*)d_out; a.ws = (unsigned char*)d_ws;
#if MK_ONE_LAUNCH
    a.ph_lo = 0; a.ph_hi = NPH;
    if (hipMemsetAsync((char*)d_ws + WS_CTL, 0, 65536, stream) != hipSuccess) { fprintf(stderr, "kernel_launch: memset failed\n"); return; }
    void* args[] = {&a};
    hipError_t e = hipLaunchCooperativeKernel((const void*)mk_fwd, dim3(grid), dim3(512), args, LDS_BYTES, stream);
    if (e != hipSuccess) fprintf(stderr, "kernel_launch: cooperative launch failed: %s (grid %d)\n", hipGetErrorString(e), grid);
#else
    for (int p = 0; p < NPH; ++p) { a.ph_lo = p; a.ph_hi = p + 1; hipLaunchKernelGGL(mk_fwd, dim3(grid), dim3(512), LDS_BYTES, stream, a); }
#endif
}
```
